# Optimizing an MI355X kernel written in HIP

```python
import jax, jax.numpy as jnp
from jax import lax
import numpy as np

D_MODEL = 1024
BATCH = 4
SEQ = 8192
DEPTH = 1

HEAD_DIM = 64
DIFF_HEADS = 4
DIFF_V_DIM = 2 * HEAD_DIM
SB_HEADS = 8
D_DIFF = DIFF_HEADS * DIFF_V_DIM
D_SB = SB_HEADS * HEAD_DIM
D_MIX = D_DIFF + D_SB
D_FF = 2816
BLOCK_Q = 128
N_MOD = 9
RMS_EPS = 1e-6
FFN_RES_WEIGHT = 0.5
MIX_RES_WEIGHT = 1.0

kernel_name = "hybrid_diffattn_stickbreaking_macaron"


def rms_norm(x, gain):
    xf = x.astype(jnp.float32)
    y = xf * lax.rsqrt(jnp.mean(xf * xf, axis=-1, keepdims=True) + RMS_EPS)
    return (y * gain.astype(jnp.float32)).astype(x.dtype)


def swiglu(h, w_gate, w_up, w_down):
    return (jax.nn.silu(h @ w_gate) * (h @ w_up)) @ w_down


def sandwich(x, f, g_pre, g_post, shift, scale, gate, res_w):
    h = rms_norm(x, g_pre) * (1.0 + scale[:, None, :]) + shift[:, None, :]
    y = rms_norm(f(h), g_post)
    return x + res_w * gate[:, None, :] * y


def alibi_slopes(n):
    return 2.0 ** (-8.0 * jnp.arange(1, n + 1, dtype=jnp.float32) / n)


def hybrid_mixer(h, w_in, w_out, lam_q1, lam_k1, lam_q2, lam_k2, diff_subln, sb_beta, lambda_init):
    B, S, _ = h.shape
    nb = S // BLOCK_Q
    scale = 1.0 / np.sqrt(HEAD_DIM).astype(np.float32)
    proj = h @ w_in
    dq, dk, dv, sq, sk, sv = jnp.split(proj, 6, axis=-1)
    dq = dq.reshape(B, S, DIFF_HEADS, 2, HEAD_DIM)
    dk = dk.reshape(B, S, DIFF_HEADS, 2, HEAD_DIM)
    dv = dv.reshape(B, S, DIFF_HEADS, DIFF_V_DIM)
    sq = sq.reshape(B, S, SB_HEADS, HEAD_DIM)
    sk = sk.reshape(B, S, SB_HEADS, HEAD_DIM)
    sv = sv.reshape(B, S, SB_HEADS, HEAD_DIM)

    f32 = jnp.float32
    lam = (jnp.exp(jnp.sum(lam_q1.astype(f32) * lam_k1.astype(f32)))
           - jnp.exp(jnp.sum(lam_q2.astype(f32) * lam_k2.astype(f32))) + lambda_init)
    slopes = alibi_slopes(DIFF_HEADS)
    key_pos = jnp.arange(S)

    dq_blk = dq.reshape(B, nb, BLOCK_Q, DIFF_HEADS, 2, HEAD_DIM).transpose(1, 0, 2, 3, 4, 5)
    sq_blk = sq.reshape(B, nb, BLOCK_Q, SB_HEADS, HEAD_DIM).transpose(1, 0, 2, 3, 4)

    def block(args):
        i, q_d, q_s = args
        q_pos = i * BLOCK_Q + jnp.arange(BLOCK_Q)
        dist = q_pos[:, None] - key_pos[None, :]
        s_d = jnp.einsum('bqhcd,bkhcd->bhcqk', q_d, dk).astype(f32) * scale
        s_d = s_d - slopes[None, :, None, None, None] * dist.astype(f32)
        s_d = jnp.where(dist >= 0, s_d, -jnp.inf)
        p = jax.nn.softmax(s_d, axis=-1)
        w_diff = p[:, :, 0] - lam * p[:, :, 1]
        o_d = jnp.einsum('bhqk,bkhe->bqhe', w_diff.astype(dv.dtype), dv)
        z = jnp.einsum('bqhd,bkhd->bhqk', q_s, sk).astype(f32) * scale
        strict = dist > 0
        log_beta = jax.nn.log_sigmoid(z)
        log_1m = jnp.where(strict, jax.nn.log_sigmoid(-z), 0.0)
        suffix = lax.cumsum(log_1m, axis=3, reverse=True) - log_1m
        att = jnp.where(strict, jnp.exp(log_beta + suffix), 0.0)
        o_s = jnp.einsum('bhqk,bkhd->bqhd', att.astype(sv.dtype), sv)
        return o_d, o_s

    o_d, o_s = lax.map(block, (jnp.arange(nb), dq_blk, sq_blk))
    o_d = o_d.transpose(1, 0, 2, 3, 4).reshape(B, S, DIFF_HEADS, DIFF_V_DIM)
    o_s = o_s.transpose(1, 0, 2, 3, 4).reshape(B, S, D_SB)
    o_d = (rms_norm(o_d, diff_subln) * (1.0 - lambda_init)).reshape(B, S, D_DIFF)
    o_s = rms_norm(o_s, sb_beta)
    return jnp.concatenate([o_d, o_s], axis=-1) @ w_out


def setup_inputs(seed: int = 0) -> dict:
    key = jax.random.key(seed)
    ks = jax.random.split(key, 24)
    f32 = jnp.float32
    nrm = lambda k, shape, s: jax.random.normal(k, shape, f32) * s
    gain = lambda k, n: 1.0 + nrm(k, (DEPTH, n), 0.02)
    D = D_MODEL
    return {
        "x": nrm(ks[0], (BATCH, SEQ, D), 1.0),
        "c": nrm(ks[1], (BATCH, D), 1.0),
        "w_ada": nrm(ks[2], (DEPTH, D, N_MOD * D), 0.5 * D ** -0.5),
        "b_ada": nrm(ks[3], (DEPTH, N_MOD * D), 0.01),
        "ffn1_g_pre": gain(ks[4], D),
        "ffn1_g_post": gain(ks[5], D),
        "ffn1_w_gate": nrm(ks[6], (DEPTH, D, D_FF), D ** -0.5),
        "ffn1_w_up": nrm(ks[7], (DEPTH, D, D_FF), D ** -0.5),
        "ffn1_w_down": nrm(ks[8], (DEPTH, D_FF, D), D_FF ** -0.5),
        "mix_g_pre": gain(ks[9], D),
        "mix_g_post": gain(ks[10], D),
        "w_in": nrm(ks[11], (DEPTH, D, 3 * D_MIX), D ** -0.5),
        "w_out": nrm(ks[12], (DEPTH, D_MIX, D), D_MIX ** -0.5),
        "lam_q1": nrm(ks[13], (DEPTH, HEAD_DIM), 0.1),
        "lam_k1": nrm(ks[14], (DEPTH, HEAD_DIM), 0.1),
        "lam_q2": nrm(ks[15], (DEPTH, HEAD_DIM), 0.1),
        "lam_k2": nrm(ks[16], (DEPTH, HEAD_DIM), 0.1),
        "diff_subln": gain(ks[17], DIFF_V_DIM),
        "sb_beta": gain(ks[18], D_SB),
        "ffn2_g_pre": gain(ks[19], D),
        "ffn2_g_post": gain(ks[20], D),
        "ffn2_w_gate": nrm(ks[21], (DEPTH, D, D_FF), D ** -0.5),
        "ffn2_w_up": nrm(ks[22], (DEPTH, D, D_FF), D ** -0.5),
        "ffn2_w_down": nrm(ks[23], (DEPTH, D_FF, D), D_FF ** -0.5),
    }


def reference(x, c, w_ada, b_ada, ffn1_g_pre, ffn1_g_post, ffn1_w_gate, ffn1_w_up, ffn1_w_down,
              mix_g_pre, mix_g_post, w_in, w_out, lam_q1, lam_k1, lam_q2, lam_k2, diff_subln, sb_beta,
              ffn2_g_pre, ffn2_g_post, ffn2_w_gate, ffn2_w_up, ffn2_w_down):
    for l in range(DEPTH):
        lambda_init = 0.8 - 0.6 * float(np.exp(-0.3 * l))
        mod = jax.nn.silu(c) @ w_ada[l] + b_ada[l]
        (sh1, sc1, g1, sh2, sc2, g2, sh3, sc3, g3) = jnp.split(mod, N_MOD, axis=-1)
        x = sandwich(x, lambda h: swiglu(h, ffn1_w_gate[l], ffn1_w_up[l], ffn1_w_down[l]),
                     ffn1_g_pre[l], ffn1_g_post[l], sh1, sc1, g1, FFN_RES_WEIGHT)
        x = sandwich(x, lambda h: hybrid_mixer(h, w_in[l], w_out[l], lam_q1[l], lam_k1[l], lam_q2[l],
                                               lam_k2[l], diff_subln[l], sb_beta[l], lambda_init),
                     mix_g_pre[l], mix_g_post[l], sh2, sc2, g2, MIX_RES_WEIGHT)
        x = sandwich(x, lambda h: swiglu(h, ffn2_w_gate[l], ffn2_w_up[l], ffn2_w_down[l]),
                     ffn2_g_pre[l], ffn2_g_post[l], sh3, sc3, g3, FFN_RES_WEIGHT)
    return x
```

```cpp
#include <hip/hip_runtime.h>
#include <hip/hip_cooperative_groups.h>
#include <cstdio>
#include <cstdint>
#include <cmath>
namespace cg = cooperative_groups;
namespace pg8 {
#define PG8_LAS __attribute__((address_space(3)))
typedef unsigned short bf16_t;
typedef short bf16x8 __attribute__((ext_vector_type(8)));
typedef float f32x4 __attribute__((ext_vector_type(4)));
typedef unsigned u32x4 __attribute__((ext_vector_type(4)));
constexpr int BM = 256, BK = 64, HALF = 128, HTB = HALF * BK * 2  , STAGE_BYTES = 8 * HTB, NXCD = 8, WGM = 8;

__host__ __device__ __forceinline__ int lds_byte(int r, int c) { const int st = (r >> 4) * 2 + (c >> 5), rr = r & 15, cc = c & 31, ob = rr * 64 + cc * 2; return st * 1024 + (ob ^ (((ob >> 9) & 1) << 5)); }
__host__ __device__ __forceinline__ void stage_rc(int b, int& R, int& C) { const int st = b / 1024, sb = b % 1024, swz = sb ^ (((sb >> 9) & 1) << 5); R = (st >> 1) * 16 + swz / 64; C = (st & 1) * 32 + (swz % 64) / 2; }
__host__ __device__ __forceinline__ int perm32(int rho) { const int n = rho >> 4, i = rho & 15; return 8 * (i >> 2) + 4 * n + (i & 3); }

struct Unit { int pm, pn; };
struct Gemm { const bf16_t* A; const bf16_t* Bt; int M, N, K; };

struct StaticOrder {
    int nM, nN, nwg, G, c, wgm;
    __host__ __device__ void init(int M, int N, int G_, int c_, int wgm_ = WGM) { nM = M / BM; nN = N / BM; nwg = nM * nN; G = G_; c = c_; wgm = wgm_; }
    __host__ __device__ bool next(int i, Unit& u) const {
        const long L = (long)i * G + c; if (L >= nwg) return false;
        int wgid = (int)L; { const int q = nwg / NXCD, r = nwg % NXCD, xcd = wgid % NXCD, off = wgid / NXCD; wgid = (xcd < r ? xcd * (q + 1) : r * (q + 1) + (xcd - r) * q) + off; }
        const int nig = wgm * nN, gid = wgid / nig, fm = gid * wgm, gsz = (nM - fm) < wgm ? (nM - fm) : wgm;
        u.pm = fm + ((wgid % nig) % gsz); u.pn = (wgid % nig) / gsz; return true;
    }
    __device__ __forceinline__ void a_ready(const Unit&) const {}
    __device__ __forceinline__ void done(const Unit&) const {}
};

__device__ __forceinline__ unsigned cvt_pk_bf16(float lo, float hi) { unsigned r; asm volatile("v_cvt_pk_bf16_f32 %0, %1, %2" : "=v"(r) : "v"(lo), "v"(hi)); return r; }
#define PG8_GAS __attribute__((address_space(1)))
__device__ __forceinline__ float silu_mul(float g, float u) { const float e = __builtin_amdgcn_exp2f(g * -1.4426950408889634f); return g * __builtin_amdgcn_rcpf(1.0f + e) * u; }
struct EpiSwiglu {
    static constexpr bool PERM = true, AFTER_DRAIN = false;
    bf16_t* O; int ldc;
    __device__ __forceinline__ void operator()(const f32x4 (&acc)[2][2][4][2], const Unit& u, int wr, int wc, int fr, int fq) const {
        const int row0 = u.pm * BM + wr * 64 + fr; const int col0 = u.pn * HALF + wc * 32 + 8 * fq;
#pragma unroll
        for (int ai = 0; ai < 2; ++ai)
#pragma unroll
            for (int m = 0; m < 4; ++m) { bf16_t* rowp = O + (size_t)(row0 + ai * HALF + m * 16) * ldc + col0;
                const f32x4 g0 = acc[ai][0][m][0], g1 = acc[ai][0][m][1], u0 = acc[ai][1][m][0], u1 = acc[ai][1][m][1];
                u32x4 w; w.x = cvt_pk_bf16(silu_mul(g0[0], u0[0]), silu_mul(g0[1], u0[1])); w.y = cvt_pk_bf16(silu_mul(g0[2], u0[2]), silu_mul(g0[3], u0[3]));
                w.z = cvt_pk_bf16(silu_mul(g1[0], u1[0]), silu_mul(g1[1], u1[1])); w.w = cvt_pk_bf16(silu_mul(g1[2], u1[2]), silu_mul(g1[3], u1[3]));
                *(PG8_GAS u32x4*)rowp = w; }
    }
};
struct EpiBf16Out {
    static constexpr bool PERM = true, AFTER_DRAIN = false;
    bf16_t* O; int ldc;
    __device__ __forceinline__ void operator()(const f32x4 (&acc)[2][2][4][2], const Unit& u, int wr, int wc, int fr, int fq) const {
        const int row0 = u.pm * BM + wr * 64 + fr; const int col0 = u.pn * BM + wc * 32 + 8 * fq;
#pragma unroll
        for (int ai = 0; ai < 2; ++ai)
#pragma unroll
            for (int m = 0; m < 4; ++m) { bf16_t* rowp = O + (size_t)(row0 + ai * HALF + m * 16) * ldc + col0;
#pragma unroll
                for (int bj = 0; bj < 2; ++bj) { const f32x4 v0 = acc[ai][bj][m][0], v1 = acc[ai][bj][m][1];
                    u32x4 w; w.x = cvt_pk_bf16(v0[0], v0[1]); w.y = cvt_pk_bf16(v0[2], v0[3]); w.z = cvt_pk_bf16(v1[0], v1[1]); w.w = cvt_pk_bf16(v1[2], v1[3]);
                    *(PG8_GAS u32x4*)(rowp + bj * HALF) = w; } }
    }
};
struct EpiProj {
    static constexpr bool PERM = true, AFTER_DRAIN = false;
    bf16_t* QK; bf16_t* VtD; bf16_t* VtS; float qscale; int S; unsigned* kinf;
    __device__ __forceinline__ void operator()(const f32x4 (&acc)[2][2][4][2], const Unit& u, int wr, int wc, int fr, int fq) const {
        const int seg = u.pn >> 1, half = u.pn & 1;
        if (seg == 2 || seg == 5) {
            bf16_t* Vt = (seg == 2) ? VtD : VtS;
            const int row_t = u.pm * BM; const int b = row_t / S, t0 = row_t - b * S;
#pragma unroll
            for (int ai = 0; ai < 2; ++ai)
#pragma unroll
                for (int m = 0; m < 4; ++m) { const int t = t0 + ai * HALF + wr * 64 + m * 16 + fr; const int pos = (t & ~12) | ((t & 4) << 1) | ((t & 8) >> 1);
#pragma unroll
                    for (int bj = 0; bj < 2; ++bj)
#pragma unroll
                        for (int n = 0; n < 2; ++n) { const int ch = 256 * half + 128 * bj + 32 * wc + 8 * fq + 4 * n;
                            const f32x4 v = acc[ai][bj][m][n]; const unsigned w0 = cvt_pk_bf16(v[0], v[1]), w1 = cvt_pk_bf16(v[2], v[3]);
                            const unsigned snd = (fr & 1) ? w0 : w1;
                            const unsigned rcv = (unsigned)__builtin_amdgcn_update_dpp(0, (int)snd, 0xB1, 0xF, 0xF, true);
                            const unsigned lo = (fr & 1) ? rcv : w0, hi2 = (fr & 1) ? w1 : rcv;
                            const unsigned s0 = (lo & 0xffffu) | (hi2 << 16), s1 = (lo >> 16) | (hi2 & 0xffff0000u);
                            PG8_GAS bf16_t* p = (PG8_GAS bf16_t*)(Vt + ((size_t)(b * 512 + ch + 2 * (fr & 1))) * S + (pos & ~1));
                            *(PG8_GAS unsigned*)p = s0; *(PG8_GAS unsigned*)(p + (size_t)S) = s1; } }
        } else {
            const int cbase = ((seg == 0) ? 0 : (seg == 1) ? 512 : (seg == 3) ? 1024 : 1536) + 256 * half + wc * 32 + 8 * fq;
            const float sc = (seg == 0 || seg == 3) ? qscale : 1.0f;
            const int row0 = u.pm * BM + wr * 64 + fr;
#pragma unroll
            for (int ai = 0; ai < 2; ++ai)
#pragma unroll
                for (int m = 0; m < 4; ++m) { bf16_t* rowp = QK + (size_t)(row0 + ai * HALF + m * 16) * 2048 + cbase;
#pragma unroll
                    for (int bj = 0; bj < 2; ++bj) { const f32x4 v0 = acc[ai][bj][m][0] * sc, v1 = acc[ai][bj][m][1] * sc;
                        u32x4 w; w.x = cvt_pk_bf16(v0[0], v0[1]); w.y = cvt_pk_bf16(v0[2], v0[3]); w.z = cvt_pk_bf16(v1[0], v1[1]); w.w = cvt_pk_bf16(v1[2], v1[3]);
                        *(PG8_GAS u32x4*)(rowp + bj * HALF) = w; } }
            if (seg == 1) {
                const int b = (u.pm * BM) / S;
#pragma unroll
                for (int bj = 0; bj < 2; ++bj) { float v = 0.f;
#pragma unroll
                    for (int ai = 0; ai < 2; ++ai)
#pragma unroll
                        for (int m = 0; m < 4; ++m) { const f32x4 x = acc[ai][bj][m][0], y = acc[ai][bj][m][1];
                            float s2 = (x[0] * x[0] + x[1] * x[1]) + (x[2] * x[2] + x[3] * x[3]) + (y[0] * y[0] + y[1] * y[1]) + (y[2] * y[2] + y[3] * y[3]);
                            s2 += __shfl_xor(s2, 16); s2 += __shfl_xor(s2, 32);
                            v = fmaxf(v, s2); }
#pragma unroll
                    for (int o = 1; o < 16; o <<= 1) v = fmaxf(v, __shfl_xor(v, o));
                    if (fr == 0 && fq == 0) atomicMax(kinf + (b * 8 + 4 * half + 2 * bj + (wc >> 1)) * 2 + (wc & 1), __float_as_uint(v)); }
            }
        }
    }
};

template <class Epi, class Sched, bool ALIGN_EPI = false, bool SP2 = false>
__device__ __forceinline__ void gemm_phase(PG8_LAS unsigned char* lds, const Gemm g, const Sched& S, const Epi& E) {
    int tid_l = threadIdx.x; asm volatile("" : "+v"(tid_l));
    const int tid = tid_l, wid = __builtin_amdgcn_readfirstlane(tid >> 6), lane = tid & 63, wr = wid >> 2, wc = wid & 3, fr = lane & 15, fq = lane >> 4;
    const int K = g.K, nt = K / BK;
    unsigned voffA[2], voffB[2];
#pragma unroll
    for (int i = 0; i < 2; ++i) { int R, C; stage_rc(tid * 16 + i * 8192, R, C); const int Rb = Epi::PERM ? ((R & ~31) + perm32(R & 31)) : R;
        voffA[i] = (unsigned)(R * K + C) * 2u; voffB[i] = (unsigned)(Rb * K + C) * 2u; }
    const size_t kstep = (size_t)(BK * 2);
    const size_t hstep = (size_t)HALF * K * 2;
    const size_t tstep = 2 * hstep;
    const unsigned ldsw = (unsigned)wid * 1024u;
    const int aoff = lds_byte(wr * 64 + fr, fq * 8), boff = lds_byte(wc * 32 + fr, fq * 8);
#define PG8_SA(b, h) (((b) * 2 + (h)) * HTB)
#define PG8_SB(b, h) ((4 + (b) * 2 + (h)) * HTB)
#define PG8_STAGE(bufoff, gbase, voff) do { _Pragma("unroll") for (int _i = 0; _i < 2; ++_i) \
        __builtin_amdgcn_global_load_lds((const unsigned*)((const char*)(gbase) + (voff)[_i]), (PG8_LAS unsigned*)(lds + (bufoff) + ldsw + _i * 8192), 16, 0, 0); } while (0)
#define PG8_LDA(dst, b, h) do { _Pragma("unroll") for (int m = 0; m < 4; ++m) _Pragma("unroll") for (int k = 0; k < 2; ++k) dst[m][k] = *(const PG8_LAS bf16x8*)(lds + PG8_SA(b, h) + aoff + m * 2048 + k * 1024); } while (0)
#define PG8_LDB(dst, b, h) do { _Pragma("unroll") for (int n = 0; n < 2; ++n) _Pragma("unroll") for (int k = 0; k < 2; ++k) dst[n][k] = *(const PG8_LAS bf16x8*)(lds + PG8_SB(b, h) + boff + n * 2048 + k * 1024); } while (0)
#define PG8_MMA(ai, bj, At, Bt) do { __builtin_amdgcn_s_setprio(1); _Pragma("unroll") for (int m = 0; m < 4; ++m) _Pragma("unroll") for (int n = 0; n < 2; ++n) _Pragma("unroll") for (int k = 0; k < 2; ++k) \
        acc[ai][bj][m][n] = __builtin_amdgcn_mfma_f32_16x16x32_bf16(Bt[n][k], At[m][k], acc[ai][bj][m][n], 0, 0, 0); __builtin_amdgcn_s_setprio(0); } while (0)
#define PG8_WAIT_V(n) asm volatile("s_waitcnt vmcnt(" #n ")" ::: "memory")
#define PG8_WAIT_L(n) asm volatile("s_waitcnt lgkmcnt(" #n ")" ::: "memory")
#define PG8_BAR __builtin_amdgcn_s_barrier()
#define PG8_SCHED __builtin_amdgcn_sched_barrier(0)
    Unit cur, nxt; int ui = 0;
    if (!S.next(0, cur)) return;
    f32x4 acc[2][2][4][2];
#pragma unroll
    for (int a = 0; a < 2; ++a)
#pragma unroll
        for (int b = 0; b < 2; ++b)
#pragma unroll
            for (int m = 0; m < 4; ++m)
#pragma unroll
                for (int n = 0; n < 2; ++n) acc[a][b][m][n] = (f32x4){0.f, 0.f, 0.f, 0.f};
    bf16x8 At[4][2], B0[2][2], B1[2][2];
    const char* cA = (const char*)g.A + (size_t)cur.pm * tstep; const char* cB = (const char*)g.Bt + (size_t)cur.pn * tstep;
    S.a_ready(cur);
    if constexpr (SP2) {
        PG8_STAGE(PG8_SB(0, 0), cB, voffB); PG8_STAGE(PG8_SB(0, 1), cB + hstep, voffB); PG8_STAGE(PG8_SA(0, 0), cA, voffA); PG8_STAGE(PG8_SA(0, 1), cA + hstep, voffA);
        if (wr == 1) PG8_BAR;
        PG8_WAIT_V(2); PG8_BAR;
        PG8_STAGE(PG8_SB(1, 0), cB + kstep, voffB); PG8_STAGE(PG8_SA(1, 0), cA + kstep, voffA); PG8_STAGE(PG8_SB(1, 1), cB + hstep + kstep, voffB);
        PG8_WAIT_V(6); PG8_BAR;
    } else {
        PG8_STAGE(PG8_SB(0, 0), cB, voffB); PG8_STAGE(PG8_SA(0, 0), cA, voffA); PG8_STAGE(PG8_SB(0, 1), cB + hstep, voffB); PG8_STAGE(PG8_SA(0, 1), cA + hstep, voffA);
        if (wr == 1) PG8_BAR;
        PG8_WAIT_V(4); PG8_BAR;
        PG8_STAGE(PG8_SB(1, 0), cB + kstep, voffB); PG8_STAGE(PG8_SA(1, 0), cA + kstep, voffA); PG8_STAGE(PG8_SB(1, 1), cB + hstep + kstep, voffB);
        PG8_WAIT_V(6); PG8_BAR;
    }
    for (;;) {
        const bool has_next = S.next(ui + 1, nxt);
        const char* nA = has_next ? (const char*)g.A + (size_t)nxt.pm * tstep : cA; const char* nB = has_next ? (const char*)g.Bt + (size_t)nxt.pn * tstep : cB;
        for (int t = 0; t < nt; t += 2) {
            const bool last = (t == nt - 2);
            const char* a1 = cA + (size_t)(t + 1) * kstep;
            const char* a2 = last ? nA : cA + (size_t)(t + 2) * kstep; const char* b2 = last ? nB : cB + (size_t)(t + 2) * kstep;
            const char* a3 = a2 + kstep; const char* b3 = b2 + kstep;
            if (last && has_next) S.a_ready(nxt);
            if constexpr (SP2) {
            PG8_LDB(B0, 0, 0); PG8_LDB(B1, 0, 1); PG8_SCHED; PG8_LDA(At, 0, 0); PG8_STAGE(PG8_SA(1, 1), a1 + hstep, voffA);
            PG8_WAIT_V(8); PG8_WAIT_L(0); PG8_BAR; PG8_MMA(0, 0, At, B0); PG8_MMA(0, 1, At, B1); PG8_BAR; PG8_SCHED;
            PG8_LDA(At, 0, 1); PG8_STAGE(PG8_SB(0, 0), b2, voffB); PG8_STAGE(PG8_SB(0, 1), b2 + hstep, voffB); PG8_STAGE(PG8_SA(0, 0), a2, voffA);
            PG8_WAIT_V(8); PG8_WAIT_L(0); PG8_BAR; PG8_MMA(1, 0, At, B0); PG8_MMA(1, 1, At, B1); PG8_BAR; PG8_SCHED;
            PG8_LDB(B0, 1, 0); PG8_LDB(B1, 1, 1); PG8_SCHED; PG8_LDA(At, 1, 0); PG8_STAGE(PG8_SA(0, 1), a2 + hstep, voffA);
            PG8_WAIT_V(8); PG8_WAIT_L(0); PG8_BAR; PG8_MMA(0, 0, At, B0); PG8_MMA(0, 1, At, B1); PG8_BAR; PG8_SCHED;
            PG8_LDA(At, 1, 1); PG8_STAGE(PG8_SB(1, 0), b3, voffB); PG8_STAGE(PG8_SB(1, 1), b3 + hstep, voffB); PG8_STAGE(PG8_SA(1, 0), a3, voffA);
            PG8_WAIT_V(8); PG8_WAIT_L(0); PG8_BAR; PG8_MMA(1, 0, At, B0); PG8_MMA(1, 1, At, B1); PG8_BAR; PG8_SCHED;
            } else {
            PG8_LDB(B0, 0, 0); PG8_SCHED; PG8_LDA(At, 0, 0); PG8_STAGE(PG8_SA(1, 1), a1 + hstep, voffA);
            PG8_WAIT_L(8); PG8_BAR; PG8_WAIT_L(0); PG8_MMA(0, 0, At, B0); PG8_BAR; PG8_SCHED;
            PG8_LDB(B1, 0, 1); PG8_STAGE(PG8_SB(0, 0), b2, voffB);
            PG8_BAR; PG8_WAIT_L(0); PG8_MMA(0, 1, At, B1); PG8_BAR;
            PG8_LDA(At, 0, 1); PG8_STAGE(PG8_SA(0, 0), a2, voffA);
            PG8_BAR; PG8_WAIT_L(0); PG8_MMA(1, 0, At, B0); PG8_BAR; PG8_SCHED;
            PG8_STAGE(PG8_SB(0, 1), b2 + hstep, voffB);
            PG8_WAIT_V(6); PG8_BAR; PG8_MMA(1, 1, At, B1); PG8_BAR;
            PG8_LDB(B0, 1, 0); PG8_SCHED; PG8_LDA(At, 1, 0); PG8_STAGE(PG8_SA(0, 1), a2 + hstep, voffA);
            PG8_WAIT_L(8); PG8_BAR; PG8_WAIT_L(0); PG8_MMA(0, 0, At, B0); PG8_BAR; PG8_SCHED;
            PG8_LDB(B1, 1, 1); PG8_STAGE(PG8_SB(1, 0), b3, voffB);
            PG8_BAR; PG8_WAIT_L(0); PG8_MMA(0, 1, At, B1); PG8_BAR;
            PG8_LDA(At, 1, 1); PG8_STAGE(PG8_SA(1, 0), a3, voffA);
            PG8_BAR; PG8_WAIT_L(0); PG8_MMA(1, 0, At, B0); PG8_BAR; PG8_SCHED;
            PG8_STAGE(PG8_SB(1, 1), b3 + hstep, voffB);
            PG8_WAIT_V(6); PG8_BAR; PG8_MMA(1, 1, At, B1); PG8_BAR;
            }
        }
        if constexpr (ALIGN_EPI) { if (wr == 0) PG8_BAR; }
        if constexpr (!Epi::AFTER_DRAIN) { E(acc, cur, wr, wc, fr, fq); S.done(cur); }
        if (!has_next) break;
#pragma unroll
        for (int a = 0; a < 2; ++a)
#pragma unroll
            for (int b = 0; b < 2; ++b)
#pragma unroll
                for (int m = 0; m < 4; ++m)
#pragma unroll
                    for (int n = 0; n < 2; ++n) acc[a][b][m][n] = (f32x4){0.f, 0.f, 0.f, 0.f};
        cur = nxt; cA = nA; cB = nB; ++ui;
        if constexpr (ALIGN_EPI) { if (wr == 1) PG8_BAR; }
    }
    PG8_WAIT_V(0);
    if constexpr (!ALIGN_EPI) { if (wr == 0) PG8_BAR; }
    PG8_BAR;
    if constexpr (Epi::AFTER_DRAIN) { E.fused(acc, cur, wr, wc, fr, fq, lds, wid, lane); S.done(cur); }
#undef PG8_SA
#undef PG8_SB
#undef PG8_STAGE
#undef PG8_LDA
#undef PG8_LDB
#undef PG8_MMA
#undef PG8_WAIT_V
#undef PG8_WAIT_L
#undef PG8_BAR
#undef PG8_SCHED
}
}

#define LAS __attribute__((address_space(3)))
#define GAS __attribute__((address_space(1)))
typedef unsigned short bf16;
typedef float f32x4 __attribute__((ext_vector_type(4)));
typedef float f32x2 __attribute__((ext_vector_type(2)));
typedef float f32x16 __attribute__((ext_vector_type(16)));
typedef short bf16x8 __attribute__((ext_vector_type(8)));
typedef unsigned u32x4 __attribute__((ext_vector_type(4)));
typedef unsigned u32x2 __attribute__((ext_vector_type(2)));
constexpr int NB = 4, SEQ = 8192, DM = 1024, DFF = 2816, M = NB * SEQ, NMOD = 9;
constexpr float RMS_EPS = 1e-6f;
constexpr float C2 = 0.125f * 1.4426950408889634f;
constexpr size_t MiB = 1u << 20;
constexpr size_t WS_CTL = 0;
constexpr size_t WS_WGU1 = 1 * MiB, WS_WD1 = 12 * MiB, WS_WIN = 18 * MiB, WS_WOUT = 24 * MiB, WS_WGU2 = 26 * MiB, WS_WD2 = 37 * MiB;
constexpr size_t WS_H = 48 * MiB;
constexpr size_t WS_F = 112 * MiB;
constexpr size_t WS_XB = 176 * MiB;
constexpr size_t WS_ACT = 240 * MiB;
constexpr size_t WS_VTD = 416 * MiB, WS_VTS = 448 * MiB;
constexpr size_t WS_OSB = 480 * MiB;
constexpr size_t WS_END = 512 * MiB;
constexpr int GEMM_LDS = 131072, LDS_BYTES = GEMM_LDS + 1024;
constexpr size_t WS_CTLW = 512 * 1024, CTLW_BYTES = 32 * 1024;
constexpr int CW_KINF = 4096, CW_QUEUE = 4160;

template <int CTRL> __device__ __forceinline__ float dpp_f(float v) { return __builtin_bit_cast(float, __builtin_amdgcn_update_dpp(0, __builtin_bit_cast(int, v), CTRL, 0xF, 0xF, true)); }
__device__ __forceinline__ float row16_sum(float v) {
    v += dpp_f<0xB1>(v);
    v += dpp_f<0x4E>(v);
    v += dpp_f<0x141>(v);
    v += dpp_f<0x140>(v);
    return v;
}
__device__ __forceinline__ float xrow_sum(float v) {
    { auto rr = __builtin_amdgcn_permlane16_swap(__float_as_uint(v), __float_as_uint(v), false, false); v = __uint_as_float(rr[0]) + __uint_as_float(rr[1]); }
    { auto rr = __builtin_amdgcn_permlane32_swap(__float_as_uint(v), __float_as_uint(v), false, false); v = __uint_as_float(rr[0]) + __uint_as_float(rr[1]); }
    return v;
}
__device__ __forceinline__ float wave_sum(float v) { return xrow_sum(row16_sum(v)); }
__device__ __forceinline__ unsigned pk_bf16(float lo, float hi) { return pg8::cvt_pk_bf16(lo, hi); }
__device__ __forceinline__ float bf2f(unsigned short h) { return __uint_as_float(((unsigned)h) << 16); }

namespace att {
constexpr int KSTR = 144;
constexpr int KBUFB = 64 * KSTR, STAGEB = KBUFB + 128 * KSTR;
constexpr int FLAG_OFF = 2 * STAGEB;
constexpr float THR = -48.0f;
__device__ __forceinline__ int crow(int r, int hi) { return (r & 3) + 8 * (r >> 2) + 4 * hi; }
typedef __bf16 bf16x2_t __attribute__((ext_vector_type(2)));
__device__ __forceinline__ unsigned cvtpk_c(float lo, float hi) { const f32x2 v = {lo, hi}; const bf16x2_t b = __builtin_convertvector(v, bf16x2_t); return __builtin_bit_cast(unsigned, b); }
__device__ __forceinline__ bf16x8 pack8(const f32x16& p, int b) {
    u32x4 w; w.x = cvtpk_c(p[b], p[b + 1]); w.y = cvtpk_c(p[b + 2], p[b + 3]); w.z = cvtpk_c(p[b + 4], p[b + 5]); w.w = cvtpk_c(p[b + 6], p[b + 7]);
    return __builtin_bit_cast(bf16x8, w);
}
#define MFMA32(a, b, c) __builtin_amdgcn_mfma_f32_32x32x16_bf16((a), (b), (c), 0, 0, 0)
__device__ __forceinline__ float max3f(float a, float b, float c) { float r; asm("v_max3_f32 %0, %1, %2, %3" : "=v"(r) : "v"(a), "v"(b), "v"(c)); return r; }
__device__ __forceinline__ float xhalf_max(float m) { auto rr = __builtin_amdgcn_permlane32_swap(__float_as_uint(m), __float_as_uint(m), false, false); return fmaxf(__uint_as_float(rr[0]), __uint_as_float(rr[1])); }
__device__ __forceinline__ float xhalf_sum(float m) { auto rr = __builtin_amdgcn_permlane32_swap(__float_as_uint(m), __float_as_uint(m), false, false); return __uint_as_float(rr[0]) + __uint_as_float(rr[1]); }

template <int MODE, int DV>
__device__ __forceinline__ void attn_unit(LAS unsigned char* lds, const bf16* __restrict__ QK, int qcol, int kcol, const bf16* __restrict__ Vt,
                                          size_t rowbase, int qb, float slope2, float kinfa, float kinfb, float* __restrict__ Of, bf16* __restrict__ Ob, int ocol) {
    constexpr int NDB = DV / 32, NVC = DV / 64, NACC = NDB;
    int tid_l = threadIdx.x; asm volatile("" : "+v"(tid_l));
    const int tid = tid_l, lane = tid & 63, r32 = lane & 31, hi = lane >> 5;
    const int wid = __builtin_amdgcn_readfirstlane(tid >> 6);
    const int q0 = qb * 256, tw0 = q0 + 32 * wid, t = tw0 + r32;
    const int NT = 4 * qb + 4;
    bf16x8 qf[4];
    { const bf16* qp = QK + (rowbase + t) * 2048 + qcol + hi * 8;
#pragma unroll
      for (int ds = 0; ds < 4; ++ds) qf[ds] = *(const GAS bf16x8*)(qp + ds * 16); }
    float rowc = 0.f;
    if (MODE == 0) {
        float sa = 0.f, sb2 = 0.f;
#pragma unroll
        for (int ds = 0; ds < 4; ++ds) { const u32x4 w = __builtin_bit_cast(u32x4, qf[ds]);
            const float e0 = __uint_as_float(w.x << 16), e1 = __uint_as_float(w.x & 0xffff0000u), e2 = __uint_as_float(w.y << 16), e3 = __uint_as_float(w.y & 0xffff0000u);
            const float e4 = __uint_as_float(w.z << 16), e5 = __uint_as_float(w.z & 0xffff0000u), e6 = __uint_as_float(w.w << 16), e7 = __uint_as_float(w.w & 0xffff0000u);
            const float q2 = (e0 * e0 + e1 * e1) + (e2 * e2 + e3 * e3) + (e4 * e4 + e5 * e5) + (e6 * e6 + e7 * e7);
            if (ds < 2) sa += q2; else sb2 += q2; }
        sa = xhalf_sum(sa); sb2 = xhalf_sum(sb2);
        rowc = (sqrtf(sa * kinfa) + sqrtf(sb2 * kinfb)) * 1.02f;
    }
    const int krow = tid >> 3, kch = tid & 7;
    const bf16* ksrc = QK + (rowbase + krow) * 2048 + kcol + kch * 8;
    const unsigned kdst = krow * KSTR + kch * 16;
    const bf16* vsrc = Vt + (size_t)krow * SEQ + kch * 8;
    const unsigned vdst = KBUFB + krow * KSTR + kch * 16;
    const unsigned koff = r32 * KSTR + hi * 16;
    LAS unsigned* flags = (LAS unsigned*)(lds + FLAG_OFF);

    f32x16 o[NACC];
#pragma unroll
    for (int d = 0; d < NACC; ++d)
#pragma unroll
        for (int r = 0; r < 16; ++r) o[d][r] = 0.f;
    float mrun = 0.f, carry = 0.f, lrun = 0.f;
    bool wdone = false, first = true;
    bf16x8 ut0, ut1, uone;
    { const u32x4 c = {0x3F803F80u, 0x3F803F80u, 0x3F803F80u, 0x3F803F80u}; uone = __builtin_bit_cast(bf16x8, c); }
    if (MODE == 1) {
        u32x4 a, b;
        unsigned e0[8], e1[8];
#pragma unroll
        for (int j = 0; j < 8; ++j) { const int jj = 8 * (j >> 2) + 4 * hi + (j & 3); e0[j] = (jj > r32) ? 0x3F80u : 0u; e1[j] = (16 + jj > r32) ? 0x3F80u : 0u; }
        a.x = e0[0] | (e0[1] << 16); a.y = e0[2] | (e0[3] << 16); a.z = e0[4] | (e0[5] << 16); a.w = e0[6] | (e0[7] << 16);
        b.x = e1[0] | (e1[1] << 16); b.y = e1[2] | (e1[3] << 16); b.z = e1[4] | (e1[5] << 16); b.w = e1[6] | (e1[7] << 16);
        ut0 = __builtin_bit_cast(bf16x8, a); ut1 = __builtin_bit_cast(bf16x8, b);
    }
    u32x4 kreg[2], vreg[2][NVC];
#define ATT_LOAD(set_, kt_) do { kreg[set_] = *(const GAS u32x4*)(ksrc + (size_t)(kt_) * 64 * 2048); \
        _Pragma("unroll") for (int i_ = 0; i_ < NVC; ++i_) vreg[set_][i_] = *(const GAS u32x4*)(vsrc + (size_t)i_ * 64 * SEQ + (kt_) * 64); } while (0)
#define ATT_STORE(set_, stg_) do { *(LAS u32x4*)(lds + (stg_) * STAGEB + kdst) = kreg[set_]; \
        _Pragma("unroll") for (int i_ = 0; i_ < NVC; ++i_) *(LAS u32x4*)(lds + (stg_) * STAGEB + vdst + i_ * 64 * KSTR) = vreg[set_][i_]; } while (0)
    ATT_LOAD(0, NT - 1); ATT_LOAD(1, (NT - 2 > 0) ? NT - 2 : 0); ATT_STORE(0, 0);
    __syncthreads();
    int kt = NT - 1; bool fin = false;
    for (;;) {
#pragma unroll
      for (int hh = 0; hh < 2; ++hh) {
        const bool hasn = (kt > 0);
        ATT_LOAD(hh, (kt - 2 > 0) ? kt - 2 : 0);
        const int k0 = kt * 64;
        const LAS unsigned char* sb = lds + hh * STAGEB;
        const bool active = ((MODE == 0) ? (k0 <= tw0 + 31) : (k0 < tw0 + 31)) && !wdone;
        if (active) {
            f32x16 p0, p1;
            if (MODE == 0) {
                const float bb = slope2 * (float)(k0 + 4 * hi - t) - mrun;
#pragma unroll
                for (int r = 0; r < 16; ++r) { const float c = __builtin_fmaf(slope2, (float)((r & 3) + 8 * (r >> 2)), bb); p0[r] = c; p1[r] = __builtin_fmaf(slope2, 32.0f, c); }
            } else {
#pragma unroll
                for (int r = 0; r < 16; ++r) { p0[r] = 0.f; p1[r] = 0.f; }
            }
#pragma unroll
            for (int ds = 0; ds < 4; ++ds) {
                const bf16x8 k0f = *(const LAS bf16x8*)(sb + koff + ds * 32);
                const bf16x8 k1f = *(const LAS bf16x8*)(sb + koff + 32 * KSTR + ds * 32);
                p0 = MFMA32(k0f, qf[ds], p0); p1 = MFMA32(k1f, qf[ds], p1);
            }
            const bool diag = (MODE == 0) ? (k0 + 63 > tw0) : (k0 + 63 >= tw0);
            bf16x8 pf0, pf1, pf2, pf3;
            if (MODE == 0) {
                if (diag) {
#pragma unroll
                    for (int r = 0; r < 16; ++r) { const int key = k0 + crow(r, hi); if (key > t) p0[r] = -INFINITY; if (key + 32 > t) p1[r] = -INFINITY; }
                }
                float mx;
                { float a0 = max3f(p0[0], p0[1], p0[2]), a1 = max3f(p0[3], p0[4], p0[5]), a2 = max3f(p0[6], p0[7], p0[8]), a3 = max3f(p0[9], p0[10], p0[11]);
                  float a4 = max3f(p0[12], p0[13], p0[14]), a5 = max3f(p0[15], p1[0], p1[1]), a6 = max3f(p1[2], p1[3], p1[4]), a7 = max3f(p1[5], p1[6], p1[7]);
                  float a8 = max3f(p1[8], p1[9], p1[10]), a9 = max3f(p1[11], p1[12], p1[13]), a10 = max3f(p1[14], p1[15], a0);
                  a1 = max3f(a1, a2, a3); a4 = max3f(a4, a5, a6); a7 = max3f(a7, a8, a9);
                  mx = xhalf_max(max3f(max3f(a1, a4, a7), a10, a10)); }
                if (first || __any(mx > 6.0f)) {
                    const float dl = first ? mx : fmaxf(mx, 0.f);
#pragma unroll
                    for (int r = 0; r < 16; ++r) { p0[r] -= dl; p1[r] -= dl; }
                    mrun += dl;
                    if (!first) { const float alpha = __builtin_amdgcn_exp2f(-dl); lrun *= alpha;
#pragma unroll
                        for (int d = 0; d < NACC; ++d)
#pragma unroll
                            for (int r = 0; r < 16; ++r) o[d][r] *= alpha; }
                    first = false;
                }
#pragma unroll
                for (int r = 0; r < 16; ++r) { p0[r] = __builtin_amdgcn_exp2f(p0[r]); p1[r] = __builtin_amdgcn_exp2f(p1[r]); }
                { float s0 = p0[0] + p1[0], s1 = p0[1] + p1[1], s2 = p0[2] + p1[2], s3 = p0[3] + p1[3];
#pragma unroll
                  for (int r = 4; r < 16; r += 4) { s0 += p0[r] + p1[r]; s1 += p0[r + 1] + p1[r + 1]; s2 += p0[r + 2] + p1[r + 2]; s3 += p0[r + 3] + p1[r + 3]; }
                  lrun += (s0 + s1) + (s2 + s3); }
                pf0 = pack8(p0, 0); pf1 = pack8(p0, 8); pf2 = pack8(p1, 0); pf3 = pack8(p1, 8);
                wdone = __all(rowc - slope2 * (float)(t - k0 + 1) < mrun - 32.0f) != 0;
            } else {
                float ts = 0.f;
                f32x16 l0, l1;
#pragma unroll
                for (int r = 0; r < 16; ++r) {
                    { const float z = p0[r]; const float e = __builtin_amdgcn_exp2f(-fabsf(z)); const float sp = fmaxf(-z, 0.f) + __builtin_amdgcn_logf(1.0f + e);
                      const float lb = -sp; float lm = lb - z; if (diag && !(k0 + crow(r, hi) < t)) lm = 0.f; l0[r] = lm; ts += lm; p0[r] = lb + carry; }
                    { const float z = p1[r]; const float e = __builtin_amdgcn_exp2f(-fabsf(z)); const float sp = fmaxf(-z, 0.f) + __builtin_amdgcn_logf(1.0f + e);
                      const float lb = -sp; float lm = lb - z; if (diag && !(k0 + 32 + crow(r, hi) < t)) lm = 0.f; l1[r] = lm; ts += lm; p1[r] = lb + carry; }
                }
                const bf16x8 L0a = pack8(l0, 0), L0b = pack8(l0, 8), L1a = pack8(l1, 0), L1b = pack8(l1, 8);
                p0 = MFMA32(ut0, L0a, p0); p0 = MFMA32(ut1, L0b, p0); p0 = MFMA32(uone, L1a, p0); p0 = MFMA32(uone, L1b, p0);
                p1 = MFMA32(ut0, L1a, p1); p1 = MFMA32(ut1, L1b, p1);
#pragma unroll
                for (int r = 0; r < 16; ++r) {
                    float a0 = __builtin_amdgcn_exp2f(p0[r]), a1 = __builtin_amdgcn_exp2f(p1[r]);
                    if (diag) { if (!(k0 + crow(r, hi) < t)) a0 = 0.f; if (!(k0 + 32 + crow(r, hi) < t)) a1 = 0.f; }
                    p0[r] = a0; p1[r] = a1;
                }
                ts = xhalf_sum(ts);
                carry += ts;
                pf0 = pack8(p0, 0); pf1 = pack8(p0, 8); pf2 = pack8(p1, 0); pf3 = pack8(p1, 8);
                wdone = __all(carry < THR) != 0;
            }
#pragma unroll
            for (int d = 0; d < NDB; ++d) {
                const LAS unsigned char* vb = sb + KBUFB + d * 32 * KSTR + koff;
                const bf16x8 v0 = *(const LAS bf16x8*)(vb), v1 = *(const LAS bf16x8*)(vb + 32), v2 = *(const LAS bf16x8*)(vb + 64), v3 = *(const LAS bf16x8*)(vb + 96);
                o[d] = MFMA32(v0, pf0, o[d]); o[d] = MFMA32(v1, pf1, o[d]); o[d] = MFMA32(v2, pf2, o[d]); o[d] = MFMA32(v3, pf3, o[d]);
            }
        }
        if (hasn) ATT_STORE(hh ^ 1, hh ^ 1);
        if (lane == 0) flags[hh * 8 + wid] = wdone ? 1u : 0u;
        __syncthreads();
        if (!hasn) { fin = true; break; }
        { const unsigned f = flags[hh * 8 + (lane & 7)]; if (__all(f != 0u)) { fin = true; break; } }
        --kt;
      }
      if (fin) break;
    }
#undef ATT_LOAD
#undef ATT_STORE
    if (MODE == 0) {
        const float inv = 1.0f / xhalf_sum(lrun);
        bf16* op = (bf16*)Of + (rowbase + t) * 1024 + ocol + 4 * hi;
#pragma unroll
        for (int d = 0; d < NDB; ++d)
#pragma unroll
            for (int g = 0; g < 4; ++g) { u32x2 w; w.x = pk_bf16(o[d][4 * g] * inv, o[d][4 * g + 1] * inv); w.y = pk_bf16(o[d][4 * g + 2] * inv, o[d][4 * g + 3] * inv); *(GAS u32x2*)(op + 32 * d + 8 * g) = w; }
    } else {
        bf16* op = Ob + (rowbase + t) * 512 + ocol + 4 * hi;
#pragma unroll
        for (int d = 0; d < NDB; ++d)
#pragma unroll
            for (int g = 0; g < 4; ++g) { u32x2 w; w.x = pk_bf16(o[d][4 * g], o[d][4 * g + 1]); w.y = pk_bf16(o[d][4 * g + 2], o[d][4 * g + 3]); *(GAS u32x2*)(op + 32 * d + 8 * g) = w; }
    }
}
#undef MFMA32
}

#define XB_TMO      128
#define XB_XCNT(j)  (256  + 64 * (j))
#define XB_XSUB(j)  (1280 + 64 * (j))
#define XB_XGEN(j)  (2304 + 64 * (j))
#define XB_TOP      3328
#define XB_TOPGEN   3392
#define XCD_BAR_WORDS 3456
#define XB_SPIN_CAP (1u << 18)

__device__ __forceinline__ unsigned xb_ld(unsigned* p)              { return __hip_atomic_load(p, __ATOMIC_RELAXED, __HIP_MEMORY_SCOPE_AGENT); }
__device__ __forceinline__ unsigned xb_add(unsigned* p, unsigned v) { return __hip_atomic_fetch_add(p, v, __ATOMIC_RELAXED, __HIP_MEMORY_SCOPE_AGENT); }
__device__ __forceinline__ unsigned xb_xcc_id() { return (unsigned)__builtin_amdgcn_s_getreg((3 << 11) | 20) & 0xFu; }
#define XB_SPIN(cond, bar) do { unsigned _sp = 0; while (cond) { __builtin_amdgcn_s_sleep(1); \
    if ((++_sp & 255u) == 0u) { if (xb_ld(&(bar)[XB_TMO])) break; if (_sp > XB_SPIN_CAP) { atomicAdd(&(bar)[XB_TMO], 1u); break; } } } } while (0)

struct XcdBarrier {
    unsigned* bar; unsigned x;
    volatile LAS unsigned* st;
};

__device__ __forceinline__ XcdBarrier xcd_barrier_post(unsigned* bar, volatile LAS unsigned* st) {
    XcdBarrier b; b.bar = bar; b.x = xb_xcc_id(); b.st = st;
    if (threadIdx.x == 0) (void)xb_add(&bar[XB_XCNT(b.x)], 1u);
    return b;
}
__device__ __forceinline__ void xcd_barrier_complete(unsigned* bar, unsigned x, unsigned& nloc, unsigned& nx) {
    const unsigned G = gridDim.x * gridDim.y * gridDim.z;
    unsigned sum, cnt, mine, sp = 0u;
    for (;;) {
        sum = 0u; cnt = 0u; mine = 0u;
#pragma unroll
        for (unsigned j = 0; j < 16; ++j) { const unsigned c = xb_ld(&bar[XB_XCNT(j)]); sum += c; cnt += (c > 0u) ? 1u : 0u; mine = (j == x) ? c : mine; }
        if (sum == G) break;
        __builtin_amdgcn_s_sleep(1);
        if ((++sp & 255u) == 0u) { if (xb_ld(&bar[XB_TMO])) break; if (sp > XB_SPIN_CAP) { atomicAdd(&bar[XB_TMO], 1u); break; } }
    }
    nloc = mine > 0u ? mine : 1u; nx = cnt > 0u ? cnt : 1u;
}

__device__ __forceinline__ void xcd_barrier(const XcdBarrier& b) {
    asm volatile("s_waitcnt vmcnt(0)" ::: "memory");
    __syncthreads();
    if (threadIdx.x == 0) {
        unsigned* bar = b.bar;
        __builtin_amdgcn_s_waitcnt(0);
        unsigned nloc = b.st[0], nx = b.st[1];
        if (nloc == 0u) { xcd_barrier_complete(bar, b.x, nloc, nx); b.st[0] = nloc; b.st[1] = nx; }
        const unsigned old = xb_add(&bar[XB_XSUB(b.x)], 1u);
        const unsigned gen = old / nloc;
        if (old + 1u == (gen + 1u) * nloc) {
            __builtin_amdgcn_fence(__ATOMIC_RELEASE, "agent");
            asm volatile("s_waitcnt vmcnt(0)" ::: "memory");
            const unsigned og = xb_add(&bar[XB_TOP], 1u);
            const unsigned tg = og / nx;
            if (og + 1u == (tg + 1u) * nx) xb_add(&bar[XB_TOPGEN], 1u);
            else XB_SPIN(xb_ld(&bar[XB_TOPGEN]) == tg, bar);
            __builtin_amdgcn_fence(__ATOMIC_ACQUIRE, "agent");
            xb_add(&bar[XB_XGEN(b.x)], 1u);
            asm volatile("s_waitcnt vmcnt(0)" ::: "memory");
        } else {
            XB_SPIN(xb_ld(&bar[XB_XGEN(b.x)]) == gen, bar);
            __builtin_amdgcn_fence(__ATOMIC_ACQUIRE, "agent");
            asm volatile("s_waitcnt vmcnt(0)" ::: "memory");
        }
    }
    __syncthreads();
}

#ifndef WGM_GU
#define WGM_GU 4
#endif
#ifndef WGM_N1K
#define WGM_N1K 4
#endif
#ifndef WGM_IN
#define WGM_IN 4
#endif
#ifndef PHASE_MASK
#define PHASE_MASK 0xFFFF
#endif
#define PH(n) (((PHASE_MASK) >> (n)) & 1)
#ifndef DUP_MASK
#define DUP_MASK 0
#endif
#ifndef ATT_DUP
#define ATT_DUP 0
#endif
#define REP(n) for (int rep_ = 0; rep_ < 1 + (((DUP_MASK) >> (n)) & 1); ++rep_)
#ifndef ATT_PASS_MASK
#define ATT_PASS_MASK 3
#endif
struct Args { const float* in[24]; float* out; unsigned char* ws; };

__device__ __forceinline__ void transpose_item(const float* __restrict__ W, int K, int N, bf16* __restrict__ WT, int mode, LAS float* scr, int item, int lane) {
    const int nblk = N / 32, kb = item / nblk, nb = item % nblk, k0 = 64 * kb, n0 = 32 * nb;
#pragma unroll
    for (int i = 0; i < 8; ++i) { const int kk = 8 * i + (lane >> 3), nq = 4 * (lane & 7);
        const f32x4 v = *(const GAS f32x4*)(W + (size_t)(k0 + kk) * N + n0 + nq); LAS float* d = scr + kk * 33 + nq; d[0] = v.x; d[1] = v.y; d[2] = v.z; d[3] = v.w; }
    asm volatile("s_waitcnt lgkmcnt(0)" ::: "memory");
    const int c = lane & 7;
#pragma unroll
    for (int j = 0; j < 4; ++j) { const int n = (lane >> 3) + 8 * j; const LAS float* s = scr + (8 * c) * 33 + n;
        u32x4 o; o.x = pk_bf16(s[0 * 33], s[1 * 33]); o.y = pk_bf16(s[2 * 33], s[3 * 33]); o.z = pk_bf16(s[4 * 33], s[5 * 33]); o.w = pk_bf16(s[6 * 33], s[7 * 33]);
        const int ng = n0 + n; const int nr = (mode == 0) ? ng : (256 * (ng >> 7) + (ng & 127) + (mode == 2 ? 128 : 0));
        *(GAS u32x4*)(WT + (size_t)nr * K + k0 + 8 * c) = o; }
    asm volatile("s_waitcnt lgkmcnt(0)" ::: "memory");
}

template <bool HAS_F, bool HAS_H, bool XIN_B = false, bool XOUT_B = false>
__device__ __forceinline__ void rowpass(const void* xin_, const bf16* __restrict__ Fb, void* xout_, bf16* __restrict__ H,
                                        const float* __restrict__ gpost, const float* __restrict__ modp, int gi  , float resw,
                                        const float* __restrict__ gpre, int sci, int shi, int gw, int lane) {
    constexpr int RPW = M / 2048;
    const int row_lo = gw * RPW; const int b = row_lo / SEQ;
    const float* mb = modp + (size_t)b * (NMOD * DM);
    f32x4 Cg[4], A[4], Sh[4];
#pragma unroll
    for (int j = 0; j < 4; ++j) { const int col = 256 * j + 4 * lane;
        if (HAS_F) { const f32x4 g = *(const GAS f32x4*)(mb + gi * DM + col), gp = *(const GAS f32x4*)(gpost + col); Cg[j] = g * gp * resw; }
        if (HAS_H) { const f32x4 s = *(const GAS f32x4*)(mb + sci * DM + col), gp = *(const GAS f32x4*)(gpre + col); A[j] = gp * (s + 1.0f); Sh[j] = *(const GAS f32x4*)(mb + shi * DM + col); } }
    const float* xin = (const float*)xin_; const bf16* xinb = (const bf16*)xin_; float* xout = (float*)xout_; bf16* xoutb = (bf16*)xout_;
#define RP_LDX(dst, r, j) do { if (XIN_B) { const u32x2 w_ = *(const GAS u32x2*)(xinb + (size_t)(r) * DM + 256 * (j) + 4 * lane); \
        dst = (f32x4){__uint_as_float(w_.x << 16), __uint_as_float(w_.x & 0xffff0000u), __uint_as_float(w_.y << 16), __uint_as_float(w_.y & 0xffff0000u)}; } \
      else dst = *(const GAS f32x4*)(xin + (size_t)(r) * DM + 256 * (j) + 4 * lane); } while (0)
    f32x4 xn[4]; u32x2 fn[4];
#pragma unroll
    for (int j = 0; j < 4; ++j) { RP_LDX(xn[j], row_lo, j); if (HAS_F) fn[j] = *(const GAS u32x2*)(Fb + (size_t)row_lo * DM + 256 * j + 4 * lane); }
    for (int row = row_lo; row < row_lo + RPW; ++row) {
        f32x4 x[4]; u32x2 fwv[4];
#pragma unroll
        for (int j = 0; j < 4; ++j) { x[j] = xn[j]; if (HAS_F) fwv[j] = fn[j]; }
        { const int rn = (row + 1 < row_lo + RPW) ? row + 1 : row;
#pragma unroll
          for (int j = 0; j < 4; ++j) { RP_LDX(xn[j], rn, j); if (HAS_F) fn[j] = *(const GAS u32x2*)(Fb + (size_t)rn * DM + 256 * j + 4 * lane); } }
        if (HAS_F) {
            f32x4 f[4]; float ss = 0.f;
#pragma unroll
            for (int j = 0; j < 4; ++j) { const u32x2 fw = fwv[j];
                f[j] = (f32x4){__uint_as_float(fw.x << 16), __uint_as_float(fw.x & 0xffff0000u), __uint_as_float(fw.y << 16), __uint_as_float(fw.y & 0xffff0000u)}; ss += (f[j].x * f[j].x + f[j].y * f[j].y) + (f[j].z * f[j].z + f[j].w * f[j].w); }
            const float rstd = 1.0f / sqrtf(wave_sum(ss) * (1.0f / DM) + RMS_EPS);
#pragma unroll
            for (int j = 0; j < 4; ++j) { x[j] = x[j] + f[j] * rstd * Cg[j];
                if (XOUT_B) { u32x2 w; w.x = pk_bf16(x[j].x, x[j].y); w.y = pk_bf16(x[j].z, x[j].w); *(GAS u32x2*)(xoutb + (size_t)row * DM + 256 * j + 4 * lane) = w;
                    x[j] = (f32x4){__uint_as_float(w.x << 16), __uint_as_float(w.x & 0xffff0000u), __uint_as_float(w.y << 16), __uint_as_float(w.y & 0xffff0000u)}; }
                else *(GAS f32x4*)(xout + (size_t)row * DM + 256 * j + 4 * lane) = x[j]; }
        }
        if (HAS_H) {
            float ss = 0.f;
#pragma unroll
            for (int j = 0; j < 4; ++j) ss += (x[j].x * x[j].x + x[j].y * x[j].y) + (x[j].z * x[j].z + x[j].w * x[j].w);
            const float rstd = 1.0f / sqrtf(wave_sum(ss) * (1.0f / DM) + RMS_EPS);
#pragma unroll
            for (int j = 0; j < 4; ++j) { const f32x4 h = x[j] * rstd * A[j] + Sh[j]; u32x2 w; w.x = pk_bf16(h.x, h.y); w.y = pk_bf16(h.z, h.w);
                *(GAS u32x2*)(H + (size_t)row * DM + 256 * j + 4 * lane) = w; }
        }
    }
}
#undef RP_LDX

__device__ __forceinline__ void rowpass_attn(const float* __restrict__ Od, const bf16* __restrict__ Os, bf16* __restrict__ H, const float* __restrict__ subln,
                                             const float* __restrict__ sbeta, float lam, int gw, int lane) {
    constexpr int RPW = M / 2048;
    const int hd = lane >> 4, e0 = 8 * (lane & 15);
    const f32x4 sl0 = *(const GAS f32x4*)(subln + e0), sl1 = *(const GAS f32x4*)(subln + e0 + 4);
    const f32x4 be0 = *(const GAS f32x4*)(sbeta + 8 * lane), be1 = *(const GAS f32x4*)(sbeta + 8 * lane + 4);
#define RA_UNPK(W_, V_) do { V_[0] = __uint_as_float(W_.x << 16); V_[1] = __uint_as_float(W_.x & 0xffff0000u); V_[2] = __uint_as_float(W_.y << 16); V_[3] = __uint_as_float(W_.y & 0xffff0000u); \
        V_[4] = __uint_as_float(W_.z << 16); V_[5] = __uint_as_float(W_.z & 0xffff0000u); V_[6] = __uint_as_float(W_.w << 16); V_[7] = __uint_as_float(W_.w & 0xffff0000u); } while (0)
    const int row_lo = gw * RPW;
    u32x4 n0 = *(const GAS u32x4*)((const bf16*)Od + (size_t)row_lo * 1024 + hd * 256 + e0), n1 = *(const GAS u32x4*)((const bf16*)Od + (size_t)row_lo * 1024 + hd * 256 + 128 + e0);
    u32x4 ns = *(const GAS u32x4*)(Os + (size_t)row_lo * 512 + 8 * lane);
    for (int row = row_lo; row < row_lo + RPW; ++row) {
        const u32x4 w0 = n0, w1 = n1, ws = ns;
        { const int rn = (row + 1 < row_lo + RPW) ? row + 1 : row;
          n0 = *(const GAS u32x4*)((const bf16*)Od + (size_t)rn * 1024 + hd * 256 + e0); n1 = *(const GAS u32x4*)((const bf16*)Od + (size_t)rn * 1024 + hd * 256 + 128 + e0);
          ns = *(const GAS u32x4*)(Os + (size_t)rn * 512 + 8 * lane); }
        float a0[8], a1[8], v[8], sv[8];
        RA_UNPK(w0, a0); RA_UNPK(w1, a1); RA_UNPK(ws, sv);
        float ss = 0.f, s2 = 0.f;
#pragma unroll
        for (int i = 0; i < 8; ++i) { v[i] = a0[i] - a1[i] * lam; ss += v[i] * v[i]; s2 += sv[i] * sv[i]; }
        ss = row16_sum(ss);
        const float rstd = 0.8f / sqrtf(ss * (1.0f / 128.0f) + RMS_EPS);
        u32x4 od; od.x = pk_bf16(v[0] * rstd * sl0.x, v[1] * rstd * sl0.y); od.y = pk_bf16(v[2] * rstd * sl0.z, v[3] * rstd * sl0.w);
        od.z = pk_bf16(v[4] * rstd * sl1.x, v[5] * rstd * sl1.y); od.w = pk_bf16(v[6] * rstd * sl1.z, v[7] * rstd * sl1.w);
        *(GAS u32x4*)(H + (size_t)row * 1024 + hd * 128 + e0) = od;
        const float rstd2 = 1.0f / sqrtf(wave_sum(s2) * (1.0f / 512.0f) + RMS_EPS);
        u32x4 o; o.x = pk_bf16(sv[0] * rstd2 * be0.x, sv[1] * rstd2 * be0.y); o.y = pk_bf16(sv[2] * rstd2 * be0.z, sv[3] * rstd2 * be0.w);
        o.z = pk_bf16(sv[4] * rstd2 * be1.x, sv[5] * rstd2 * be1.y); o.w = pk_bf16(sv[6] * rstd2 * be1.z, sv[7] * rstd2 * be1.w);
        *(GAS u32x4*)(H + (size_t)row * 1024 + 512 + 8 * lane) = o;
    }
#undef RA_UNPK
}

#define KAS __attribute__((address_space(4)))
__device__ __forceinline__ const float* karg(int i) { const KAS char* ka = (const KAS char*)__builtin_amdgcn_kernarg_segment_ptr(); return (const float*)(*(const volatile KAS unsigned long long*)(ka + 8 * i)); }
#define AIN(i) karg(i)
__device__ __forceinline__ int fresh_tid() { int t = threadIdx.x; asm volatile("" : "+v"(t)); return t; }
__global__ void __launch_bounds__(512) fwd_megakernel(Args args) {
    extern __shared__ __attribute__((aligned(16))) unsigned char lds_raw[];
    cg::grid_group grid = cg::this_grid();
    LAS unsigned char* lds = (LAS unsigned char*)lds_raw;
    const int wave = __builtin_amdgcn_readfirstlane((int)threadIdx.x >> 6);
#define tid (fresh_tid())
#define lane (fresh_tid() & 63)
    const int G = gridDim.x, bx = blockIdx.x;
    const int vcu = (G % 8 == 0) ? (bx % 8) * (G / 8) + bx / 8 : bx;
    const int gw = vcu * 8 + wave, NGW = G * 8;
    unsigned* ctlw = (unsigned*)((unsigned char*)karg(25) + WS_CTLW);
    volatile LAS unsigned* MISC = (volatile LAS unsigned*)(lds + GEMM_LDS);
    if (tid < 64) MISC[tid] = 0u;
    __syncthreads();
    XcdBarrier bar = xcd_barrier_post(ctlw, MISC + 8);
#define WSP(off) ((unsigned char*)karg(25) + (off))
#define ctl ((float*)WSP(WS_CTL))
#define modp (((float*)WSP(WS_CTL)) + 1024)
#define out ((float*)karg(24))
#define Wgu1 ((bf16*)WSP(WS_WGU1))
#define Wd1 ((bf16*)WSP(WS_WD1))
#define Win ((bf16*)WSP(WS_WIN))
#define Wout ((bf16*)WSP(WS_WOUT))
#define Wgu2 ((bf16*)WSP(WS_WGU2))
#define Wd2 ((bf16*)WSP(WS_WD2))
#define H ((bf16*)WSP(WS_H))
#define F ((float*)WSP(WS_F))
#define ACT ((bf16*)WSP(WS_ACT))
#define QK ((bf16*)WSP(WS_ACT))
#define VtD ((bf16*)WSP(WS_VTD))
#define VtS ((bf16*)WSP(WS_VTS))
#define Osb ((bf16*)WSP(WS_OSB))
#define XB ((bf16*)WSP(WS_XB))
    if (PH(0)) REP(0) {
        if (bx < 144) {
            LAS float* sc = (LAS float*)lds;
            LAS float* red = sc + 4096;
            const float* c = AIN(1);
            for (int i = tid; i < 4096; i += 512) { const float v = c[i]; sc[i] = v / (1.0f + __expf(-v)); }
            __syncthreads();
            const int col = bx * 64 + (tid & 63), kg = tid >> 6;
            const float* wp = AIN(2) + (size_t)(kg * 128) * (NMOD * DM) + col;
            float a0 = 0.f, a1 = 0.f, a2 = 0.f, a3 = 0.f;
#pragma unroll 8
            for (int k = 0; k < 128; ++k) { const float w = ((const GAS float*)wp)[(size_t)k * (NMOD * DM)]; const int kk = kg * 128 + k;
                a0 += sc[kk] * w; a1 += sc[1024 + kk] * w; a2 += sc[2048 + kk] * w; a3 += sc[3072 + kk] * w; }
            red[(kg * 4 + 0) * 64 + (tid & 63)] = a0; red[(kg * 4 + 1) * 64 + (tid & 63)] = a1; red[(kg * 4 + 2) * 64 + (tid & 63)] = a2; red[(kg * 4 + 3) * 64 + (tid & 63)] = a3;
            __syncthreads();
            if (tid < 256) { const int b = tid >> 6, cc = tid & 63; float s = 0.f;
#pragma unroll
                for (int g = 0; g < 8; ++g) s += red[(g * 4 + b) * 64 + cc];
                modp[(size_t)b * (NMOD * DM) + bx * 64 + cc] = s + AIN(3)[bx * 64 + cc]; }
            __syncthreads();
        }
        if (bx == G - 1 && wave == 0) {
            const float s1 = wave_sum(AIN(13)[lane] * AIN(14)[lane]), s2 = wave_sum(AIN(15)[lane] * AIN(16)[lane]);
            if (lane == 0) ctl[0] = __expf(s1) - __expf(s2) + 0.2f;
        }
        LAS float* scr = (LAS float*)(lds + wave * 16384);
        constexpr int I_G = (DM / 64) * (DFF / 32), I_D = (DFF / 64) * (DM / 32), I_IN = (DM / 64) * (3 * DM / 32), I_OUT = (DM / 64) * (DM / 32);
        constexpr int NITEMS = 6 * I_G + I_IN + I_OUT;
        static_assert(I_G == I_D, "item counts");
        for (int itx = gw; itx < NITEMS; itx += NGW) {
            int r = itx;
            if (r < I_G) { transpose_item(AIN(6), DM, DFF, Wgu1, 1, scr, r, lane); continue; } r -= I_G;
            if (r < I_G) { transpose_item(AIN(7), DM, DFF, Wgu1, 2, scr, r, lane); continue; } r -= I_G;
            if (r < I_D) { transpose_item(AIN(8), DFF, DM, Wd1, 0, scr, r, lane); continue; } r -= I_D;
            if (r < I_G) { transpose_item(AIN(21), DM, DFF, Wgu2, 1, scr, r, lane); continue; } r -= I_G;
            if (r < I_G) { transpose_item(AIN(22), DM, DFF, Wgu2, 2, scr, r, lane); continue; } r -= I_G;
            if (r < I_D) { transpose_item(AIN(23), DFF, DM, Wd2, 0, scr, r, lane); continue; } r -= I_D;
            if (r < I_IN) { transpose_item(AIN(11), DM, 3 * DM, Win, 0, scr, r, lane); continue; } r -= I_IN;
            transpose_item(AIN(12), DM, DM, Wout, 0, scr, r, lane);
        }
    }
    if (G == 0x7ffffff0) grid.sync();
    xcd_barrier(bar);
#ifdef EXTRA_SYNCS
    for (int es = 0; es < EXTRA_SYNCS; ++es) xcd_barrier(bar);
#endif
    if (PH(1)) REP(1) rowpass<false, true>(AIN(0), nullptr, nullptr, H, nullptr, modp, 0, 0.f, AIN(4), 1, 0, gw, lane);
    xcd_barrier(bar);
    if (PH(2)) REP(2) { pg8::Gemm g{H, Wgu1, M, 2 * DFF, DM}; pg8::StaticOrder S; S.init(M, 2 * DFF, G, bx, WGM_GU); pg8::EpiSwiglu E{ACT, DFF};
      pg8::gemm_phase<pg8::EpiSwiglu, pg8::StaticOrder, true, true>(lds, g, S, E); }
    xcd_barrier(bar);
    if (PH(3)) REP(3) { pg8::Gemm g{ACT, Wd1, M, DM, DFF}; pg8::StaticOrder S; S.init(M, DM, G, bx, WGM_N1K); pg8::EpiBf16Out E{(bf16*)F, DM};
      pg8::gemm_phase<pg8::EpiBf16Out, pg8::StaticOrder, true, true>(lds, g, S, E); }
    xcd_barrier(bar);
    if (PH(4)) REP(4) rowpass<true, true, false, true>(AIN(0), (const bf16*)F, XB, H, AIN(5), modp, 2, 0.5f, AIN(9), 4, 3, gw, lane);
    xcd_barrier(bar);
    if (PH(5)) REP(5) { pg8::Gemm g{H, Win, M, 3 * DM, DM}; pg8::StaticOrder S; S.init(M, 3 * DM, G, bx, WGM_IN); pg8::EpiProj E{QK, VtD, VtS, C2, SEQ, ctlw + CW_KINF};
      pg8::gemm_phase<pg8::EpiProj, pg8::StaticOrder, true, true>(lds, g, S, E); }
    xcd_barrier(bar);
    if (PH(6)) {
        const unsigned* kinfw = ctlw + CW_KINF;
        LAS unsigned* uslot = (LAS unsigned*)(lds + att::FLAG_OFF + 128);
        const unsigned myx = xb_xcc_id() & 7u;
        for (int qi = 0; qi < 8; ++qi) {
            const unsigned xq = (myx + (unsigned)qi) & 7u;
            unsigned* qctr = ctlw + CW_QUEUE + 64 * xq;
            for (;;) {
                if (tid == 0) *uslot = atomicAdd(qctr, 1u);
                __syncthreads();
                const unsigned u = *uslot;
                __syncthreads();
                if (u >= 128u) break;
                const int h = 3 - (int)(u >> 5), qb = 31 - (int)(u & 31), b = (int)(xq >> 1), vh = 2 * h + (int)(xq & 1);
                const float slope2 = 1.4426950408889634f * exp2f(-2.0f * (float)(h + 1));
                const float kinfa = __uint_as_float(kinfw[(b * 8 + vh) * 2]), kinfb = __uint_as_float(kinfw[(b * 8 + vh) * 2 + 1]);
                att::attn_unit<0, 128>(lds, QK, vh * 64, 512 + vh * 64, VtD + ((size_t)(b * 512 + h * 128)) * SEQ, (size_t)b * SEQ, qb, slope2, kinfa, kinfb, F, nullptr, vh * 128);
            }
        }
        {
            unsigned* qctr = ctlw + CW_QUEUE + 64 * 8;
            for (;;) {
                if (tid == 0) *uslot = atomicAdd(qctr, 1u);
                __syncthreads();
                const unsigned u = *uslot;
                __syncthreads();
                if (u >= 1024u) break;
                const int v = (int)u, qb = 31 - (v >> 5), b = (v & 31) >> 3, h = v & 7;
                att::attn_unit<1, 64>(lds, QK, 1024 + h * 64, 1536 + h * 64, VtS + ((size_t)(b * 512 + h * 64)) * SEQ, (size_t)b * SEQ, qb, 0.f, 0.f, 0.f, nullptr, Osb, h * 64);
            }
        }
    }
    xcd_barrier(bar);
    if (PH(7)) REP(7) rowpass_attn(F, Osb, H, AIN(17), AIN(18), ctl[0], gw, lane);
    xcd_barrier(bar);
    if (PH(8)) REP(8) { pg8::Gemm g{H, Wout, M, DM, DM}; pg8::StaticOrder S; S.init(M, DM, G, bx, WGM_N1K); pg8::EpiBf16Out E{(bf16*)F, DM};
      pg8::gemm_phase<pg8::EpiBf16Out, pg8::StaticOrder, true, true>(lds, g, S, E); }
    xcd_barrier(bar);
    if (PH(9)) REP(9) rowpass<true, true, true, true>(XB, (const bf16*)F, XB, H, AIN(10), modp, 5, 1.0f, AIN(19), 7, 6, gw, lane);
    xcd_barrier(bar);
    if (PH(10)) REP(10) { pg8::Gemm g{H, Wgu2, M, 2 * DFF, DM}; pg8::StaticOrder S; S.init(M, 2 * DFF, G, bx, WGM_GU); pg8::EpiSwiglu E{ACT, DFF};
      pg8::gemm_phase<pg8::EpiSwiglu, pg8::StaticOrder, true, true>(lds, g, S, E); }
    xcd_barrier(bar);
    if (PH(11)) REP(11) { pg8::Gemm g{ACT, Wd2, M, DM, DFF}; pg8::StaticOrder S; S.init(M, DM, G, bx, WGM_N1K); pg8::EpiBf16Out E{(bf16*)F, DM};
      pg8::gemm_phase<pg8::EpiBf16Out, pg8::StaticOrder, true, true>(lds, g, S, E); }
    xcd_barrier(bar);
    if (PH(12)) REP(12) rowpass<true, false, true, false>(XB, (const bf16*)F, out, nullptr, AIN(20), modp, 8, 0.5f, nullptr, 0, 0, gw, lane);
}
#undef ctl
#undef modp
#undef out
#undef Wgu1
#undef Wd1
#undef Win
#undef Wout
#undef Wgu2
#undef Wd2
#undef H
#undef F
#undef ACT
#undef QK
#undef VtD
#undef VtS
#undef Osb
#undef XB

#undef tid
#undef lane
extern "C" void kernel_launch(void* const* d_in, const int* in_sizes, int n_in, void* d_out, int out_size, void* d_ws, size_t ws_size, hipStream_t stream) {
    static int grid = 0;
    if (grid == 0) {
        if (n_in != 24 || out_size != M * DM || ws_size < WS_END) { fprintf(stderr, "kernel_launch: unexpected shapes (n_in %d out %d ws %zu)\n", n_in, out_size, ws_size); grid = -1; return; }
        int dev = 0, cus = 0, per_cu = 0;
        hipGetDevice(&dev); hipDeviceGetAttribute(&cus, hipDeviceAttributeMultiprocessorCount, dev);
        if (hipFuncSetAttribute((const void*)fwd_megakernel, hipFuncAttributeMaxDynamicSharedMemorySize, LDS_BYTES) != hipSuccess) { fprintf(stderr, "kernel_launch: hipFuncSetAttribute failed\n"); grid = -1; return; }
        if (hipOccupancyMaxActiveBlocksPerMultiprocessor(&per_cu, (const void*)fwd_megakernel, 512, LDS_BYTES) != hipSuccess || per_cu < 1) { fprintf(stderr, "kernel_launch: occupancy query says %d blocks per CU\n", per_cu); per_cu = 1; }
        (void)hipGetLastError();
        if (cus < 256) { fprintf(stderr, "kernel_launch: built for a 256-CU device (got %d CUs)\n", cus); grid = -1; return; }
        grid = 256;
    }
    if (grid < 0) return;
    if (hipMemsetAsync((char*)d_ws + WS_CTLW, 0, CTLW_BYTES, stream) != hipSuccess) { fprintf(stderr, "kernel_launch: memset of the control words failed\n"); return; }
    Args a{};
    for (int i = 0; i < 24; ++i) a.in[i] = (const float*)d_in[i];
    a.out = (float*)d_out; a.ws = (unsigned char*)d_ws;
    void* kargs[] = {&a};
    hipError_t e = hipLaunchCooperativeKernel((const void*)fwd_megakernel, dim3(grid), dim3(512), kargs, LDS_BYTES, stream);
    if (e != hipSuccess) fprintf(stderr, "cooperative launch failed: %s (grid %d)\n", hipGetErrorString(e), grid);
}
```

```cpp
#include <hip/hip_runtime.h>
#include <hip/hip_cooperative_groups.h>
#include <cstdio>
#include <cstdint>
#include <cmath>
namespace cg = cooperative_groups;
namespace pg8 {
#define PG8_LAS __attribute__((address_space(3)))
typedef unsigned short bf16_t;
typedef short bf16x8 __attribute__((ext_vector_type(8)));
typedef float f32x4 __attribute__((ext_vector_type(4)));
typedef unsigned u32x4 __attribute__((ext_vector_type(4)));
constexpr int BM = 256, BK = 64, HALF = 128, HTB = HALF * BK * 2  , STAGE_BYTES = 8 * HTB, NXCD = 8, WGM = 8;

__host__ __device__ __forceinline__ int lds_byte(int r, int c) { const int st = (r >> 4) * 2 + (c >> 5), rr = r & 15, cc = c & 31, ob = rr * 64 + cc * 2; return st * 1024 + (ob ^ (((ob >> 9) & 1) << 5)); }
__host__ __device__ __forceinline__ void stage_rc(int b, int& R, int& C) { const int st = b / 1024, sb = b % 1024, swz = sb ^ (((sb >> 9) & 1) << 5); R = (st >> 1) * 16 + swz / 64; C = (st & 1) * 32 + (swz % 64) / 2; }
__host__ __device__ __forceinline__ int perm32(int rho) { const int n = rho >> 4, i = rho & 15; return 8 * (i >> 2) + 4 * n + (i & 3); }

struct Unit { int pm, pn; };
struct Gemm { const bf16_t* A; const bf16_t* Bt; int M, N, K; };

struct StaticOrder {
    int nM, nN, nwg, G, c, wgm;
    __host__ __device__ void init(int M, int N, int G_, int c_, int wgm_ = WGM) { nM = M / BM; nN = N / BM; nwg = nM * nN; G = G_; c = c_; wgm = wgm_; }
    __host__ __device__ bool next(int i, Unit& u) const {
        const long L = (long)i * G + c; if (L >= nwg) return false;
        int wgid = (int)L; { const int q = nwg / NXCD, r = nwg % NXCD, xcd = wgid % NXCD, off = wgid / NXCD; wgid = (xcd < r ? xcd * (q + 1) : r * (q + 1) + (xcd - r) * q) + off; }
        const int nig = wgm * nN, gid = wgid / nig, fm = gid * wgm, gsz = (nM - fm) < wgm ? (nM - fm) : wgm;
        u.pm = fm + ((wgid % nig) % gsz); u.pn = (wgid % nig) / gsz; return true;
    }
    __device__ __forceinline__ void a_ready(const Unit&) const {}
    __device__ __forceinline__ void done(const Unit&) const {}
};

__device__ __forceinline__ unsigned cvt_pk_bf16(float lo, float hi) { unsigned r; asm volatile("v_cvt_pk_bf16_f32 %0, %1, %2" : "=v"(r) : "v"(lo), "v"(hi)); return r; }
#define PG8_GAS __attribute__((address_space(1)))
__device__ __forceinline__ float silu_mul(float g, float u) { const float e = __builtin_amdgcn_exp2f(g * -1.4426950408889634f); return g * __builtin_amdgcn_rcpf(1.0f + e) * u; }
struct EpiSwiglu {
    static constexpr bool PERM = true, AFTER_DRAIN = false;
    bf16_t* O; int ldc;
    __device__ __forceinline__ void operator()(const f32x4 (&acc)[2][2][4][2], const Unit& u, int wr, int wc, int fr, int fq) const {
        const int row0 = u.pm * BM + wr * 64 + fr; const int col0 = u.pn * HALF + wc * 32 + 8 * fq;
#pragma unroll
        for (int ai = 0; ai < 2; ++ai)
#pragma unroll
            for (int m = 0; m < 4; ++m) { bf16_t* rowp = O + (size_t)(row0 + ai * HALF + m * 16) * ldc + col0;
                const f32x4 g0 = acc[ai][0][m][0], g1 = acc[ai][0][m][1], u0 = acc[ai][1][m][0], u1 = acc[ai][1][m][1];
                u32x4 w; w.x = cvt_pk_bf16(silu_mul(g0[0], u0[0]), silu_mul(g0[1], u0[1])); w.y = cvt_pk_bf16(silu_mul(g0[2], u0[2]), silu_mul(g0[3], u0[3]));
                w.z = cvt_pk_bf16(silu_mul(g1[0], u1[0]), silu_mul(g1[1], u1[1])); w.w = cvt_pk_bf16(silu_mul(g1[2], u1[2]), silu_mul(g1[3], u1[3]));
                *(PG8_GAS u32x4*)rowp = w; }
    }
};
struct EpiBf16Out {
    static constexpr bool PERM = true, AFTER_DRAIN = false;
    bf16_t* O; int ldc;
    __device__ __forceinline__ void operator()(const f32x4 (&acc)[2][2][4][2], const Unit& u, int wr, int wc, int fr, int fq) const {
        const int row0 = u.pm * BM + wr * 64 + fr; const int col0 = u.pn * BM + wc * 32 + 8 * fq;
#pragma unroll
        for (int ai = 0; ai < 2; ++ai)
#pragma unroll
            for (int m = 0; m < 4; ++m) { bf16_t* rowp = O + (size_t)(row0 + ai * HALF + m * 16) * ldc + col0;
#pragma unroll
                for (int bj = 0; bj < 2; ++bj) { const f32x4 v0 = acc[ai][bj][m][0], v1 = acc[ai][bj][m][1];
                    u32x4 w; w.x = cvt_pk_bf16(v0[0], v0[1]); w.y = cvt_pk_bf16(v0[2], v0[3]); w.z = cvt_pk_bf16(v1[0], v1[1]); w.w = cvt_pk_bf16(v1[2], v1[3]);
                    *(PG8_GAS u32x4*)(rowp + bj * HALF) = w; } }
    }
};
struct EpiProj {
    static constexpr bool PERM = true, AFTER_DRAIN = false;
    bf16_t* QK; bf16_t* VtD; bf16_t* VtS; float qscale; int S; unsigned* kinf;
    __device__ __forceinline__ void operator()(const f32x4 (&acc)[2][2][4][2], const Unit& u, int wr, int wc, int fr, int fq) const {
        const int seg = u.pn >> 1, half = u.pn & 1;
        if (seg == 2 || seg == 5) {
            bf16_t* Vt = (seg == 2) ? VtD : VtS;
            const int row_t = u.pm * BM; const int b = row_t / S, t0 = row_t - b * S;
#pragma unroll
            for (int ai = 0; ai < 2; ++ai)
#pragma unroll
                for (int m = 0; m < 4; ++m) { const int t = t0 + ai * HALF + wr * 64 + m * 16 + fr; const int pos = (t & ~12) | ((t & 4) << 1) | ((t & 8) >> 1);
#pragma unroll
                    for (int bj = 0; bj < 2; ++bj)
#pragma unroll
                        for (int n = 0; n < 2; ++n) { const int ch = 256 * half + 128 * bj + 32 * wc + 8 * fq + 4 * n;
                            const f32x4 v = acc[ai][bj][m][n]; const unsigned w0 = cvt_pk_bf16(v[0], v[1]), w1 = cvt_pk_bf16(v[2], v[3]);
                            const unsigned snd = (fr & 1) ? w0 : w1;
                            const unsigned rcv = (unsigned)__builtin_amdgcn_update_dpp(0, (int)snd, 0xB1, 0xF, 0xF, true);
                            const unsigned lo = (fr & 1) ? rcv : w0, hi2 = (fr & 1) ? w1 : rcv;
                            const unsigned s0 = (lo & 0xffffu) | (hi2 << 16), s1 = (lo >> 16) | (hi2 & 0xffff0000u);
                            PG8_GAS bf16_t* p = (PG8_GAS bf16_t*)(Vt + ((size_t)(b * 512 + ch + 2 * (fr & 1))) * S + (pos & ~1));
                            *(PG8_GAS unsigned*)p = s0; *(PG8_GAS unsigned*)(p + (size_t)S) = s1; } }
        } else {
            const int cbase = ((seg == 0) ? 0 : (seg == 1) ? 512 : (seg == 3) ? 1024 : 1536) + 256 * half + wc * 32 + 8 * fq;
            const float sc = (seg == 0 || seg == 3) ? qscale : 1.0f;
            const int row0 = u.pm * BM + wr * 64 + fr;
#pragma unroll
            for (int ai = 0; ai < 2; ++ai)
#pragma unroll
                for (int m = 0; m < 4; ++m) { bf16_t* rowp = QK + (size_t)(row0 + ai * HALF + m * 16) * 2048 + cbase;
#pragma unroll
                    for (int bj = 0; bj < 2; ++bj) { const f32x4 v0 = acc[ai][bj][m][0] * sc, v1 = acc[ai][bj][m][1] * sc;
                        u32x4 w; w.x = cvt_pk_bf16(v0[0], v0[1]); w.y = cvt_pk_bf16(v0[2], v0[3]); w.z = cvt_pk_bf16(v1[0], v1[1]); w.w = cvt_pk_bf16(v1[2], v1[3]);
                        *(PG8_GAS u32x4*)(rowp + bj * HALF) = w; } }
            if (seg == 1) {
                const int b = (u.pm * BM) / S;
#pragma unroll
                for (int bj = 0; bj < 2; ++bj) { float v = 0.f;
#pragma unroll
                    for (int ai = 0; ai < 2; ++ai)
#pragma unroll
                        for (int m = 0; m < 4; ++m) { const f32x4 x = acc[ai][bj][m][0], y = acc[ai][bj][m][1];
                            float s2 = (x[0] * x[0] + x[1] * x[1]) + (x[2] * x[2] + x[3] * x[3]) + (y[0] * y[0] + y[1] * y[1]) + (y[2] * y[2] + y[3] * y[3]);
                            s2 += __shfl_xor(s2, 16); s2 += __shfl_xor(s2, 32);
                            v = fmaxf(v, s2); }
#pragma unroll
                    for (int o = 1; o < 16; o <<= 1) v = fmaxf(v, __shfl_xor(v, o));
                    if (fr == 0 && fq == 0) atomicMax(kinf + (b * 8 + 4 * half + 2 * bj + (wc >> 1)) * 2 + (wc & 1), __float_as_uint(v)); }
            }
        }
    }
};

template <class Epi, class Sched, bool ALIGN_EPI = false, bool SP2 = false>
__device__ __forceinline__ void gemm_phase(PG8_LAS unsigned char* lds, const Gemm g, const Sched& S, const Epi& E) {
    int tid_l = threadIdx.x; asm volatile("" : "+v"(tid_l));
    const int tid = tid_l, wid = __builtin_amdgcn_readfirstlane(tid >> 6), lane = tid & 63, wr = wid >> 2, wc = wid & 3, fr = lane & 15, fq = lane >> 4;
    const int K = g.K, nt = K / BK;
    unsigned voffA[2], voffB[2];
#pragma unroll
    for (int i = 0; i < 2; ++i) { int R, C; stage_rc(tid * 16 + i * 8192, R, C); const int Rb = Epi::PERM ? ((R & ~31) + perm32(R & 31)) : R;
        voffA[i] = (unsigned)(R * K + C) * 2u; voffB[i] = (unsigned)(Rb * K + C) * 2u; }
    const size_t kstep = (size_t)(BK * 2);
    const size_t hstep = (size_t)HALF * K * 2;
    const size_t tstep = 2 * hstep;
    const unsigned ldsw = (unsigned)wid * 1024u;
    const int aoff = lds_byte(wr * 64 + fr, fq * 8), boff = lds_byte(wc * 32 + fr, fq * 8);
#define PG8_SA(b, h) (((b) * 2 + (h)) * HTB)
#define PG8_SB(b, h) ((4 + (b) * 2 + (h)) * HTB)
#define PG8_STAGE(bufoff, gbase, voff) do { _Pragma("unroll") for (int _i = 0; _i < 2; ++_i) \
        __builtin_amdgcn_global_load_lds((const unsigned*)((const char*)(gbase) + (voff)[_i]), (PG8_LAS unsigned*)(lds + (bufoff) + ldsw + _i * 8192), 16, 0, 0); } while (0)
#define PG8_LDA(dst, b, h) do { _Pragma("unroll") for (int m = 0; m < 4; ++m) _Pragma("unroll") for (int k = 0; k < 2; ++k) dst[m][k] = *(const PG8_LAS bf16x8*)(lds + PG8_SA(b, h) + aoff + m * 2048 + k * 1024); } while (0)
#define PG8_LDB(dst, b, h) do { _Pragma("unroll") for (int n = 0; n < 2; ++n) _Pragma("unroll") for (int k = 0; k < 2; ++k) dst[n][k] = *(const PG8_LAS bf16x8*)(lds + PG8_SB(b, h) + boff + n * 2048 + k * 1024); } while (0)
#define PG8_MMA(ai, bj, At, Bt) do { __builtin_amdgcn_s_setprio(1); _Pragma("unroll") for (int m = 0; m < 4; ++m) _Pragma("unroll") for (int n = 0; n < 2; ++n) _Pragma("unroll") for (int k = 0; k < 2; ++k) \
        acc[ai][bj][m][n] = __builtin_amdgcn_mfma_f32_16x16x32_bf16(Bt[n][k], At[m][k], acc[ai][bj][m][n], 0, 0, 0); __builtin_amdgcn_s_setprio(0); } while (0)
#define PG8_WAIT_V(n) asm volatile("s_waitcnt vmcnt(" #n ")" ::: "memory")
#define PG8_WAIT_L(n) asm volatile("s_waitcnt lgkmcnt(" #n ")" ::: "memory")
#define PG8_BAR __builtin_amdgcn_s_barrier()
#define PG8_SCHED __builtin_amdgcn_sched_barrier(0)
    Unit cur, nxt; int ui = 0;
    if (!S.next(0, cur)) return;
    f32x4 acc[2][2][4][2];
#pragma unroll
    for (int a = 0; a < 2; ++a)
#pragma unroll
        for (int b = 0; b < 2; ++b)
#pragma unroll
            for (int m = 0; m < 4; ++m)
#pragma unroll
                for (int n = 0; n < 2; ++n) acc[a][b][m][n] = (f32x4){0.f, 0.f, 0.f, 0.f};
    bf16x8 At[4][2], B0[2][2], B1[2][2];
    const char* cA = (const char*)g.A + (size_t)cur.pm * tstep; const char* cB = (const char*)g.Bt + (size_t)cur.pn * tstep;
    S.a_ready(cur);
    if constexpr (SP2) {
        PG8_STAGE(PG8_SB(0, 0), cB, voffB); PG8_STAGE(PG8_SB(0, 1), cB + hstep, voffB); PG8_STAGE(PG8_SA(0, 0), cA, voffA); PG8_STAGE(PG8_SA(0, 1), cA + hstep, voffA);
        if (wr == 1) PG8_BAR;
        PG8_WAIT_V(2); PG8_BAR;
        PG8_STAGE(PG8_SB(1, 0), cB + kstep, voffB); PG8_STAGE(PG8_SA(1, 0), cA + kstep, voffA); PG8_STAGE(PG8_SB(1, 1), cB + hstep + kstep, voffB);
        PG8_WAIT_V(6); PG8_BAR;
    } else {
        PG8_STAGE(PG8_SB(0, 0), cB, voffB); PG8_STAGE(PG8_SA(0, 0), cA, voffA); PG8_STAGE(PG8_SB(0, 1), cB + hstep, voffB); PG8_STAGE(PG8_SA(0, 1), cA + hstep, voffA);
        if (wr == 1) PG8_BAR;
        PG8_WAIT_V(4); PG8_BAR;
        PG8_STAGE(PG8_SB(1, 0), cB + kstep, voffB); PG8_STAGE(PG8_SA(1, 0), cA + kstep, voffA); PG8_STAGE(PG8_SB(1, 1), cB + hstep + kstep, voffB);
        PG8_WAIT_V(6); PG8_BAR;
    }
    for (;;) {
        const bool has_next = S.next(ui + 1, nxt);
        const char* nA = has_next ? (const char*)g.A + (size_t)nxt.pm * tstep : cA; const char* nB = has_next ? (const char*)g.Bt + (size_t)nxt.pn * tstep : cB;
        for (int t = 0; t < nt; t += 2) {
            const bool last = (t == nt - 2);
            const char* a1 = cA + (size_t)(t + 1) * kstep;
            const char* a2 = last ? nA : cA + (size_t)(t + 2) * kstep; const char* b2 = last ? nB : cB + (size_t)(t + 2) * kstep;
            const char* a3 = a2 + kstep; const char* b3 = b2 + kstep;
            if (last && has_next) S.a_ready(nxt);
            if constexpr (SP2) {
            PG8_LDB(B0, 0, 0); PG8_LDB(B1, 0, 1); PG8_SCHED; PG8_LDA(At, 0, 0); PG8_STAGE(PG8_SA(1, 1), a1 + hstep, voffA);
            PG8_WAIT_V(8); PG8_WAIT_L(0); PG8_BAR; PG8_MMA(0, 0, At, B0); PG8_MMA(0, 1, At, B1); PG8_BAR; PG8_SCHED;
            PG8_LDA(At, 0, 1); PG8_STAGE(PG8_SB(0, 0), b2, voffB); PG8_STAGE(PG8_SB(0, 1), b2 + hstep, voffB); PG8_STAGE(PG8_SA(0, 0), a2, voffA);
            PG8_WAIT_V(8); PG8_WAIT_L(0); PG8_BAR; PG8_MMA(1, 0, At, B0); PG8_MMA(1, 1, At, B1); PG8_BAR; PG8_SCHED;
            PG8_LDB(B0, 1, 0); PG8_LDB(B1, 1, 1); PG8_SCHED; PG8_LDA(At, 1, 0); PG8_STAGE(PG8_SA(0, 1), a2 + hstep, voffA);
            PG8_WAIT_V(8); PG8_WAIT_L(0); PG8_BAR; PG8_MMA(0, 0, At, B0); PG8_MMA(0, 1, At, B1); PG8_BAR; PG8_SCHED;
            PG8_LDA(At, 1, 1); PG8_STAGE(PG8_SB(1, 0), b3, voffB); PG8_STAGE(PG8_SB(1, 1), b3 + hstep, voffB); PG8_STAGE(PG8_SA(1, 0), a3, voffA);
            PG8_WAIT_V(8); PG8_WAIT_L(0); PG8_BAR; PG8_MMA(1, 0, At, B0); PG8_MMA(1, 1, At, B1); PG8_BAR; PG8_SCHED;
            } else {
            PG8_LDB(B0, 0, 0); PG8_SCHED; PG8_LDA(At, 0, 0); PG8_STAGE(PG8_SA(1, 1), a1 + hstep, voffA);
            PG8_WAIT_L(8); PG8_BAR; PG8_WAIT_L(0); PG8_MMA(0, 0, At, B0); PG8_BAR; PG8_SCHED;
            PG8_LDB(B1, 0, 1); PG8_STAGE(PG8_SB(0, 0), b2, voffB);
            PG8_BAR; PG8_WAIT_L(0); PG8_MMA(0, 1, At, B1); PG8_BAR;
            PG8_LDA(At, 0, 1); PG8_STAGE(PG8_SA(0, 0), a2, voffA);
            PG8_BAR; PG8_WAIT_L(0); PG8_MMA(1, 0, At, B0); PG8_BAR; PG8_SCHED;
            PG8_STAGE(PG8_SB(0, 1), b2 + hstep, voffB);
            PG8_WAIT_V(6); PG8_BAR; PG8_MMA(1, 1, At, B1); PG8_BAR;
            PG8_LDB(B0, 1, 0); PG8_SCHED; PG8_LDA(At, 1, 0); PG8_STAGE(PG8_SA(0, 1), a2 + hstep, voffA);
            PG8_WAIT_L(8); PG8_BAR; PG8_WAIT_L(0); PG8_MMA(0, 0, At, B0); PG8_BAR; PG8_SCHED;
            PG8_LDB(B1, 1, 1); PG8_STAGE(PG8_SB(1, 0), b3, voffB);
            PG8_BAR; PG8_WAIT_L(0); PG8_MMA(0, 1, At, B1); PG8_BAR;
            PG8_LDA(At, 1, 1); PG8_STAGE(PG8_SA(1, 0), a3, voffA);
            PG8_BAR; PG8_WAIT_L(0); PG8_MMA(1, 0, At, B0); PG8_BAR; PG8_SCHED;
            PG8_STAGE(PG8_SB(1, 1), b3 + hstep, voffB);
            PG8_WAIT_V(6); PG8_BAR; PG8_MMA(1, 1, At, B1); PG8_BAR;
            }
        }
        if constexpr (ALIGN_EPI) { if (wr == 0) PG8_BAR; }
        if constexpr (!Epi::AFTER_DRAIN) { E(acc, cur, wr, wc, fr, fq); S.done(cur); }
        if (!has_next) break;
#pragma unroll
        for (int a = 0; a < 2; ++a)
#pragma unroll
            for (int b = 0; b < 2; ++b)
#pragma unroll
                for (int m = 0; m < 4; ++m)
#pragma unroll
                    for (int n = 0; n < 2; ++n) acc[a][b][m][n] = (f32x4){0.f, 0.f, 0.f, 0.f};
        cur = nxt; cA = nA; cB = nB; ++ui;
        if constexpr (ALIGN_EPI) { if (wr == 1) PG8_BAR; }
    }
    PG8_WAIT_V(0);
    if constexpr (!ALIGN_EPI) { if (wr == 0) PG8_BAR; }
    PG8_BAR;
    if constexpr (Epi::AFTER_DRAIN) { E.fused(acc, cur, wr, wc, fr, fq, lds, wid, lane); S.done(cur); }
#undef PG8_SA
#undef PG8_SB
#undef PG8_STAGE
#undef PG8_LDA
#undef PG8_LDB
#undef PG8_MMA
#undef PG8_WAIT_V
#undef PG8_WAIT_L
#undef PG8_BAR
#undef PG8_SCHED
}
}

#define LAS __attribute__((address_space(3)))
#define GAS __attribute__((address_space(1)))
typedef unsigned short bf16;
typedef float f32x4 __attribute__((ext_vector_type(4)));
typedef float f32x2 __attribute__((ext_vector_type(2)));
typedef float f32x16 __attribute__((ext_vector_type(16)));
typedef short bf16x8 __attribute__((ext_vector_type(8)));
typedef unsigned u32x4 __attribute__((ext_vector_type(4)));
typedef unsigned u32x2 __attribute__((ext_vector_type(2)));
constexpr int NB = 4, SEQ = 8192, DM = 1024, DFF = 2816, M = NB * SEQ, NMOD = 9;
constexpr float RMS_EPS = 1e-6f;
constexpr float C2 = 0.125f * 1.4426950408889634f;
constexpr size_t MiB = 1u << 20;
constexpr size_t WS_CTL = 0;
constexpr size_t WS_WGU1 = 1 * MiB, WS_WD1 = 12 * MiB, WS_WIN = 18 * MiB, WS_WOUT = 24 * MiB, WS_WGU2 = 26 * MiB, WS_WD2 = 37 * MiB;
constexpr size_t WS_H = 48 * MiB;
constexpr size_t WS_F = 112 * MiB;
constexpr size_t WS_XB = 176 * MiB;
constexpr size_t WS_ACT = 240 * MiB;
constexpr size_t WS_VTD = 416 * MiB, WS_VTS = 448 * MiB;
constexpr size_t WS_OSB = 480 * MiB;
constexpr size_t WS_END = 512 * MiB;
constexpr int GEMM_LDS = 131072, LDS_BYTES = GEMM_LDS + 1024;
constexpr size_t WS_CTLW = 512 * 1024, CTLW_BYTES = 32 * 1024;
constexpr int CW_KINF = 4096, CW_QUEUE = 4160;

template <int CTRL> __device__ __forceinline__ float dpp_f(float v) { return __builtin_bit_cast(float, __builtin_amdgcn_update_dpp(0, __builtin_bit_cast(int, v), CTRL, 0xF, 0xF, true)); }
__device__ __forceinline__ float row16_sum(float v) {
    v += dpp_f<0xB1>(v);
    v += dpp_f<0x4E>(v);
    v += dpp_f<0x141>(v);
    v += dpp_f<0x140>(v);
    return v;
}
__device__ __forceinline__ float xrow_sum(float v) {
    { auto rr = __builtin_amdgcn_permlane16_swap(__float_as_uint(v), __float_as_uint(v), false, false); v = __uint_as_float(rr[0]) + __uint_as_float(rr[1]); }
    { auto rr = __builtin_amdgcn_permlane32_swap(__float_as_uint(v), __float_as_uint(v), false, false); v = __uint_as_float(rr[0]) + __uint_as_float(rr[1]); }
    return v;
}
__device__ __forceinline__ float wave_sum(float v) { return xrow_sum(row16_sum(v)); }
__device__ __forceinline__ unsigned pk_bf16(float lo, float hi) { return pg8::cvt_pk_bf16(lo, hi); }
__device__ __forceinline__ float bf2f(unsigned short h) { return __uint_as_float(((unsigned)h) << 16); }

namespace att {
constexpr int KSTR = 144;
constexpr int KBUFB = 64 * KSTR, STAGEB = KBUFB + 128 * KSTR;
constexpr int FLAG_OFF = 2 * STAGEB;
constexpr float THR = -48.0f;
__device__ __forceinline__ int crow(int r, int hi) { return (r & 3) + 8 * (r >> 2) + 4 * hi; }
typedef __bf16 bf16x2_t __attribute__((ext_vector_type(2)));
__device__ __forceinline__ unsigned cvtpk_c(float lo, float hi) { const f32x2 v = {lo, hi}; const bf16x2_t b = __builtin_convertvector(v, bf16x2_t); return __builtin_bit_cast(unsigned, b); }
__device__ __forceinline__ bf16x8 pack8(const f32x16& p, int b) {
    u32x4 w; w.x = cvtpk_c(p[b], p[b + 1]); w.y = cvtpk_c(p[b + 2], p[b + 3]); w.z = cvtpk_c(p[b + 4], p[b + 5]); w.w = cvtpk_c(p[b + 6], p[b + 7]);
    return __builtin_bit_cast(bf16x8, w);
}
#define MFMA32(a, b, c) __builtin_amdgcn_mfma_f32_32x32x16_bf16((a), (b), (c), 0, 0, 0)
__device__ __forceinline__ float max3f(float a, float b, float c) { float r; asm("v_max3_f32 %0, %1, %2, %3" : "=v"(r) : "v"(a), "v"(b), "v"(c)); return r; }
__device__ __forceinline__ float xhalf_max(float m) { auto rr = __builtin_amdgcn_permlane32_swap(__float_as_uint(m), __float_as_uint(m), false, false); return fmaxf(__uint_as_float(rr[0]), __uint_as_float(rr[1])); }
__device__ __forceinline__ float xhalf_sum(float m) { auto rr = __builtin_amdgcn_permlane32_swap(__float_as_uint(m), __float_as_uint(m), false, false); return __uint_as_float(rr[0]) + __uint_as_float(rr[1]); }

template <int MODE, int DV>
__device__ __forceinline__ void attn_unit(LAS unsigned char* lds, const bf16* __restrict__ QK, int qcol, int kcol, const bf16* __restrict__ Vt,
                                          size_t rowbase, int qb, float slope2, float kinfa, float kinfb, float* __restrict__ Of, bf16* __restrict__ Ob, int ocol) {
    constexpr int NDB = DV / 32, NVC = DV / 64, NACC = NDB;
    int tid_l = threadIdx.x; asm volatile("" : "+v"(tid_l));
    const int tid = tid_l, lane = tid & 63, r32 = lane & 31, hi = lane >> 5;
    const int wid = __builtin_amdgcn_readfirstlane(tid >> 6);
    const int q0 = qb * 256, tw0 = q0 + 32 * wid, t = tw0 + r32;
    const int NT = 4 * qb + 4;
    bf16x8 qf[4];
    { const bf16* qp = QK + (rowbase + t) * 2048 + qcol + hi * 8;
#pragma unroll
      for (int ds = 0; ds < 4; ++ds) qf[ds] = *(const GAS bf16x8*)(qp + ds * 16); }
    float rowc = 0.f;
    if (MODE == 0) {
        float sa = 0.f, sb2 = 0.f;
#pragma unroll
        for (int ds = 0; ds < 4; ++ds) { const u32x4 w = __builtin_bit_cast(u32x4, qf[ds]);
            const float e0 = __uint_as_float(w.x << 16), e1 = __uint_as_float(w.x & 0xffff0000u), e2 = __uint_as_float(w.y << 16), e3 = __uint_as_float(w.y & 0xffff0000u);
            const float e4 = __uint_as_float(w.z << 16), e5 = __uint_as_float(w.z & 0xffff0000u), e6 = __uint_as_float(w.w << 16), e7 = __uint_as_float(w.w & 0xffff0000u);
            const float q2 = (e0 * e0 + e1 * e1) + (e2 * e2 + e3 * e3) + (e4 * e4 + e5 * e5) + (e6 * e6 + e7 * e7);
            if (ds < 2) sa += q2; else sb2 += q2; }
        sa = xhalf_sum(sa); sb2 = xhalf_sum(sb2);
        rowc = (sqrtf(sa * kinfa) + sqrtf(sb2 * kinfb)) * 1.02f;
    }
    const int krow = tid >> 3, kch = tid & 7;
    const bf16* ksrc = QK + (rowbase + krow) * 2048 + kcol + kch * 8;
    const unsigned kdst = krow * KSTR + kch * 16;
    const bf16* vsrc = Vt + (size_t)krow * SEQ + kch * 8;
    const unsigned vdst = KBUFB + krow * KSTR + kch * 16;
    const unsigned koff = r32 * KSTR + hi * 16;
    LAS unsigned* flags = (LAS unsigned*)(lds + FLAG_OFF);

    f32x16 o[NACC];
#pragma unroll
    for (int d = 0; d < NACC; ++d)
#pragma unroll
        for (int r = 0; r < 16; ++r) o[d][r] = 0.f;
    float mrun = 0.f, carry = 0.f, lrun = 0.f;
    bool wdone = false, first = true;
    bf16x8 ut0, ut1, uone;
    { const u32x4 c = {0x3F803F80u, 0x3F803F80u, 0x3F803F80u, 0x3F803F80u}; uone = __builtin_bit_cast(bf16x8, c); }
    if (MODE == 1) {
        u32x4 a, b;
        unsigned e0[8], e1[8];
#pragma unroll
        for (int j = 0; j < 8; ++j) { const int jj = 8 * (j >> 2) + 4 * hi + (j & 3); e0[j] = (jj > r32) ? 0x3F80u : 0u; e1[j] = (16 + jj > r32) ? 0x3F80u : 0u; }
        a.x = e0[0] | (e0[1] << 16); a.y = e0[2] | (e0[3] << 16); a.z = e0[4] | (e0[5] << 16); a.w = e0[6] | (e0[7] << 16);
        b.x = e1[0] | (e1[1] << 16); b.y = e1[2] | (e1[3] << 16); b.z = e1[4] | (e1[5] << 16); b.w = e1[6] | (e1[7] << 16);
        ut0 = __builtin_bit_cast(bf16x8, a); ut1 = __builtin_bit_cast(bf16x8, b);
    }
    u32x4 kreg[2], vreg[2][NVC];
#define ATT_LOAD(set_, kt_) do { kreg[set_] = *(const GAS u32x4*)(ksrc + (size_t)(kt_) * 64 * 2048); \
        _Pragma("unroll") for (int i_ = 0; i_ < NVC; ++i_) vreg[set_][i_] = *(const GAS u32x4*)(vsrc + (size_t)i_ * 64 * SEQ + (kt_) * 64); } while (0)
#define ATT_STORE(set_, stg_) do { *(LAS u32x4*)(lds + (stg_) * STAGEB + kdst) = kreg[set_]; \
        _Pragma("unroll") for (int i_ = 0; i_ < NVC; ++i_) *(LAS u32x4*)(lds + (stg_) * STAGEB + vdst + i_ * 64 * KSTR) = vreg[set_][i_]; } while (0)
    ATT_LOAD(0, NT - 1); ATT_LOAD(1, (NT - 2 > 0) ? NT - 2 : 0); ATT_STORE(0, 0);
    __syncthreads();
    int kt = NT - 1; bool fin = false;
    for (;;) {
#pragma unroll
      for (int hh = 0; hh < 2; ++hh) {
        const bool hasn = (kt > 0);
        ATT_LOAD(hh, (kt - 2 > 0) ? kt - 2 : 0);
        const int k0 = kt * 64;
        const LAS unsigned char* sb = lds + hh * STAGEB;
        const bool active = ((MODE == 0) ? (k0 <= tw0 + 31) : (k0 < tw0 + 31)) && !wdone;
        if (active) {
            f32x16 p0, p1;
            if (MODE == 0) {
                const float bb = slope2 * (float)(k0 + 4 * hi - t) - mrun;
#pragma unroll
                for (int r = 0; r < 16; ++r) { const float c = __builtin_fmaf(slope2, (float)((r & 3) + 8 * (r >> 2)), bb); p0[r] = c; p1[r] = __builtin_fmaf(slope2, 32.0f, c); }
            } else {
#pragma unroll
                for (int r = 0; r < 16; ++r) { p0[r] = 0.f; p1[r] = 0.f; }
            }
#pragma unroll
            for (int ds = 0; ds < 4; ++ds) {
                const bf16x8 k0f = *(const LAS bf16x8*)(sb + koff + ds * 32);
                const bf16x8 k1f = *(const LAS bf16x8*)(sb + koff + 32 * KSTR + ds * 32);
                p0 = MFMA32(k0f, qf[ds], p0); p1 = MFMA32(k1f, qf[ds], p1);
            }
            const bool diag = (MODE == 0) ? (k0 + 63 > tw0) : (k0 + 63 >= tw0);
            bf16x8 pf0, pf1, pf2, pf3;
            if (MODE == 0) {
                if (diag) {
#pragma unroll
                    for (int r = 0; r < 16; ++r) { const int key = k0 + crow(r, hi); if (key > t) p0[r] = -INFINITY; if (key + 32 > t) p1[r] = -INFINITY; }
                }
                float mx;
                { float a0 = max3f(p0[0], p0[1], p0[2]), a1 = max3f(p0[3], p0[4], p0[5]), a2 = max3f(p0[6], p0[7], p0[8]), a3 = max3f(p0[9], p0[10], p0[11]);
                  float a4 = max3f(p0[12], p0[13], p0[14]), a5 = max3f(p0[15], p1[0], p1[1]), a6 = max3f(p1[2], p1[3], p1[4]), a7 = max3f(p1[5], p1[6], p1[7]);
                  float a8 = max3f(p1[8], p1[9], p1[10]), a9 = max3f(p1[11], p1[12], p1[13]), a10 = max3f(p1[14], p1[15], a0);
                  a1 = max3f(a1, a2, a3); a4 = max3f(a4, a5, a6); a7 = max3f(a7, a8, a9);
                  mx = xhalf_max(max3f(max3f(a1, a4, a7), a10, a10)); }
                if (first || __any(mx > 6.0f)) {
                    const float dl = first ? mx : fmaxf(mx, 0.f);
#pragma unroll
                    for (int r = 0; r < 16; ++r) { p0[r] -= dl; p1[r] -= dl; }
                    mrun += dl;
                    if (!first) { const float alpha = __builtin_amdgcn_exp2f(-dl); lrun *= alpha;
#pragma unroll
                        for (int d = 0; d < NACC; ++d)
#pragma unroll
                            for (int r = 0; r < 16; ++r) o[d][r] *= alpha; }
                    first = false;
                }
#pragma unroll
                for (int r = 0; r < 16; ++r) { p0[r] = __builtin_amdgcn_exp2f(p0[r]); p1[r] = __builtin_amdgcn_exp2f(p1[r]); }
                { float s0 = p0[0] + p1[0], s1 = p0[1] + p1[1], s2 = p0[2] + p1[2], s3 = p0[3] + p1[3];
#pragma unroll
                  for (int r = 4; r < 16; r += 4) { s0 += p0[r] + p1[r]; s1 += p0[r + 1] + p1[r + 1]; s2 += p0[r + 2] + p1[r + 2]; s3 += p0[r + 3] + p1[r + 3]; }
                  lrun += (s0 + s1) + (s2 + s3); }
                pf0 = pack8(p0, 0); pf1 = pack8(p0, 8); pf2 = pack8(p1, 0); pf3 = pack8(p1, 8);
                wdone = __all(rowc - slope2 * (float)(t - k0 + 1) < mrun - 32.0f) != 0;
            } else {
                float ts = 0.f;
                f32x16 l0, l1;
#pragma unroll
                for (int r = 0; r < 16; ++r) {
                    { const float z = p0[r]; const float e = __builtin_amdgcn_exp2f(-fabsf(z)); const float sp = fmaxf(-z, 0.f) + __builtin_amdgcn_logf(1.0f + e);
                      const float lb = -sp; float lm = lb - z; if (diag && !(k0 + crow(r, hi) < t)) lm = 0.f; l0[r] = lm; ts += lm; p0[r] = lb + carry; }
                    { const float z = p1[r]; const float e = __builtin_amdgcn_exp2f(-fabsf(z)); const float sp = fmaxf(-z, 0.f) + __builtin_amdgcn_logf(1.0f + e);
                      const float lb = -sp; float lm = lb - z; if (diag && !(k0 + 32 + crow(r, hi) < t)) lm = 0.f; l1[r] = lm; ts += lm; p1[r] = lb + carry; }
                }
                const bf16x8 L0a = pack8(l0, 0), L0b = pack8(l0, 8), L1a = pack8(l1, 0), L1b = pack8(l1, 8);
                p0 = MFMA32(ut0, L0a, p0); p0 = MFMA32(ut1, L0b, p0); p0 = MFMA32(uone, L1a, p0); p0 = MFMA32(uone, L1b, p0);
                p1 = MFMA32(ut0, L1a, p1); p1 = MFMA32(ut1, L1b, p1);
#pragma unroll
                for (int r = 0; r < 16; ++r) {
                    float a0 = __builtin_amdgcn_exp2f(p0[r]), a1 = __builtin_amdgcn_exp2f(p1[r]);
                    if (diag) { if (!(k0 + crow(r, hi) < t)) a0 = 0.f; if (!(k0 + 32 + crow(r, hi) < t)) a1 = 0.f; }
                    p0[r] = a0; p1[r] = a1;
                }
                ts = xhalf_sum(ts);
                carry += ts;
                pf0 = pack8(p0, 0); pf1 = pack8(p0, 8); pf2 = pack8(p1, 0); pf3 = pack8(p1, 8);
                wdone = __all(carry < THR) != 0;
            }
#pragma unroll
            for (int d = 0; d < NDB; ++d) {
                const LAS unsigned char* vb = sb + KBUFB + d * 32 * KSTR + koff;
                const bf16x8 v0 = *(const LAS bf16x8*)(vb), v1 = *(const LAS bf16x8*)(vb + 32), v2 = *(const LAS bf16x8*)(vb + 64), v3 = *(const LAS bf16x8*)(vb + 96);
                o[d] = MFMA32(v0, pf0, o[d]); o[d] = MFMA32(v1, pf1, o[d]); o[d] = MFMA32(v2, pf2, o[d]); o[d] = MFMA32(v3, pf3, o[d]);
            }
        }
        if (hasn) ATT_STORE(hh ^ 1, hh ^ 1);
        if (lane == 0) flags[hh * 8 + wid] = wdone ? 1u : 0u;
        __syncthreads();
        if (!hasn) { fin = true; break; }
        { const unsigned f = flags[hh * 8 + (lane & 7)]; if (__all(f != 0u)) { fin = true; break; } }
        --kt;
      }
      if (fin) break;
    }
#undef ATT_LOAD
#undef ATT_STORE
    if (MODE == 0) {
        const float inv = 1.0f / xhalf_sum(lrun);
        bf16* op = (bf16*)Of + (rowbase + t) * 1024 + ocol + 4 * hi;
#pragma unroll
        for (int d = 0; d < NDB; ++d)
#pragma unroll
            for (int g = 0; g < 4; ++g) { u32x2 w; w.x = pk_bf16(o[d][4 * g] * inv, o[d][4 * g + 1] * inv); w.y = pk_bf16(o[d][4 * g + 2] * inv, o[d][4 * g + 3] * inv); *(GAS u32x2*)(op + 32 * d + 8 * g) = w; }
    } else {
        bf16* op = Ob + (rowbase + t) * 512 + ocol + 4 * hi;
#pragma unroll
        for (int d = 0; d < NDB; ++d)
#pragma unroll
            for (int g = 0; g < 4; ++g) { u32x2 w; w.x = pk_bf16(o[d][4 * g], o[d][4 * g + 1]); w.y = pk_bf16(o[d][4 * g + 2], o[d][4 * g + 3]); *(GAS u32x2*)(op + 32 * d + 8 * g) = w; }
    }
}
#undef MFMA32
}

#define XB_TMO      128
#define XB_XCNT(j)  (256  + 64 * (j))
#define XB_XSUB(j)  (1280 + 64 * (j))
#define XB_XGEN(j)  (2304 + 64 * (j))
#define XB_TOP      3328
#define XB_TOPGEN   3392
#define XCD_BAR_WORDS 3456
#define XB_SPIN_CAP (1u << 18)

__device__ __forceinline__ unsigned xb_ld(unsigned* p)              { return __hip_atomic_load(p, __ATOMIC_RELAXED, __HIP_MEMORY_SCOPE_AGENT); }
__device__ __forceinline__ unsigned xb_add(unsigned* p, unsigned v) { return __hip_atomic_fetch_add(p, v, __ATOMIC_RELAXED, __HIP_MEMORY_SCOPE_AGENT); }
__device__ __forceinline__ unsigned xb_xcc_id() { return (unsigned)__builtin_amdgcn_s_getreg((3 << 11) | 20) & 0xFu; }
#define XB_SPIN(cond, bar) do { unsigned _sp = 0; while (cond) { __builtin_amdgcn_s_sleep(1); \
    if ((++_sp & 255u) == 0u) { if (xb_ld(&(bar)[XB_TMO])) break; if (_sp > XB_SPIN_CAP) { atomicAdd(&(bar)[XB_TMO], 1u); break; } } } } while (0)

struct XcdBarrier {
    unsigned* bar; unsigned x;
    volatile LAS unsigned* st;
};

__device__ __forceinline__ XcdBarrier xcd_barrier_post(unsigned* bar, volatile LAS unsigned* st) {
    XcdBarrier b; b.bar = bar; b.x = xb_xcc_id(); b.st = st;
    if (threadIdx.x == 0) (void)xb_add(&bar[XB_XCNT(b.x)], 1u);
    return b;
}
__device__ __forceinline__ void xcd_barrier_complete(unsigned* bar, unsigned x, unsigned& nloc, unsigned& nx) {
    const unsigned G = gridDim.x * gridDim.y * gridDim.z;
    unsigned sum, cnt, mine, sp = 0u;
    for (;;) {
        sum = 0u; cnt = 0u; mine = 0u;
#pragma unroll
        for (unsigned j = 0; j < 16; ++j) { const unsigned c = xb_ld(&bar[XB_XCNT(j)]); sum += c; cnt += (c > 0u) ? 1u : 0u; mine = (j == x) ? c : mine; }
        if (sum == G) break;
        __builtin_amdgcn_s_sleep(1);
        if ((++sp & 255u) == 0u) { if (xb_ld(&bar[XB_TMO])) break; if (sp > XB_SPIN_CAP) { atomicAdd(&bar[XB_TMO], 1u); break; } }
    }
    nloc = mine > 0u ? mine : 1u; nx = cnt > 0u ? cnt : 1u;
}

__device__ __forceinline__ void xcd_barrier(const XcdBarrier& b) {
    asm volatile("s_waitcnt vmcnt(0)" ::: "memory");
    __syncthreads();
    if (threadIdx.x == 0) {
        unsigned* bar = b.bar;
        __builtin_amdgcn_s_waitcnt(0);
        unsigned nloc = b.st[0], nx = b.st[1];
        if (nloc == 0u) { xcd_barrier_complete(bar, b.x, nloc, nx); b.st[0] = nloc; b.st[1] = nx; }
        const unsigned old = xb_add(&bar[XB_XSUB(b.x)], 1u);
        const unsigned gen = old / nloc;
        if (old + 1u == (gen + 1u) * nloc) {
            __builtin_amdgcn_fence(__ATOMIC_RELEASE, "agent");
            asm volatile("s_waitcnt vmcnt(0)" ::: "memory");
            const unsigned og = xb_add(&bar[XB_TOP], 1u);
            const unsigned tg = og / nx;
            if (og + 1u == (tg + 1u) * nx) xb_add(&bar[XB_TOPGEN], 1u);
            else XB_SPIN(xb_ld(&bar[XB_TOPGEN]) == tg, bar);
            __builtin_amdgcn_fence(__ATOMIC_ACQUIRE, "agent");
            xb_add(&bar[XB_XGEN(b.x)], 1u);
            asm volatile("s_waitcnt vmcnt(0)" ::: "memory");
        } else {
            XB_SPIN(xb_ld(&bar[XB_XGEN(b.x)]) == gen, bar);
            __builtin_amdgcn_fence(__ATOMIC_ACQUIRE, "agent");
            asm volatile("s_waitcnt vmcnt(0)" ::: "memory");
        }
    }
    __syncthreads();
}

#ifndef WGM_GU
#define WGM_GU 4
#endif
#ifndef WGM_N1K
#define WGM_N1K 4
#endif
#ifndef WGM_IN
#define WGM_IN 4
#endif
#ifndef PHASE_MASK
#define PHASE_MASK 0xFFFF
#endif
#define PH(n) (((PHASE_MASK) >> (n)) & 1)
#ifndef DUP_MASK
#define DUP_MASK 0
#endif
#ifndef ATT_DUP
#define ATT_DUP 0
#endif
#define REP(n) for (int rep_ = 0; rep_ < 1 + (((DUP_MASK) >> (n)) & 1); ++rep_)
#ifndef ATT_PASS_MASK
#define ATT_PASS_MASK 3
#endif
struct Args { const float* in[24]; float* out; unsigned char* ws; };

__device__ __forceinline__ void transpose_item(const float* __restrict__ W, int K, int N, bf16* __restrict__ WT, int mode, LAS float* scr, int item, int lane) {
    const int nblk = N / 32, kb = item / nblk, nb = item % nblk, k0 = 64 * kb, n0 = 32 * nb;
#pragma unroll
    for (int i = 0; i < 8; ++i) { const int kk = 8 * i + (lane >> 3), nq = 4 * (lane & 7);
        const f32x4 v = *(const GAS f32x4*)(W + (size_t)(k0 + kk) * N + n0 + nq); LAS float* d = scr + kk * 33 + nq; d[0] = v.x; d[1] = v.y; d[2] = v.z; d[3] = v.w; }
    asm volatile("s_waitcnt lgkmcnt(0)" ::: "memory");
    const int c = lane & 7;
#pragma unroll
    for (int j = 0; j < 4; ++j) { const int n = (lane >> 3) + 8 * j; const LAS float* s = scr + (8 * c) * 33 + n;
        u32x4 o; o.x = pk_bf16(s[0 * 33], s[1 * 33]); o.y = pk_bf16(s[2 * 33], s[3 * 33]); o.z = pk_bf16(s[4 * 33], s[5 * 33]); o.w = pk_bf16(s[6 * 33], s[7 * 33]);
        const int ng = n0 + n; const int nr = (mode == 0) ? ng : (256 * (ng >> 7) + (ng & 127) + (mode == 2 ? 128 : 0));
        *(GAS u32x4*)(WT + (size_t)nr * K + k0 + 8 * c) = o; }
    asm volatile("s_waitcnt lgkmcnt(0)" ::: "memory");
}

template <bool HAS_F, bool HAS_H, bool XIN_B = false, bool XOUT_B = false>
__device__ __forceinline__ void rowpass(const void* xin_, const bf16* __restrict__ Fb, void* xout_, bf16* __restrict__ H,
                                        const float* __restrict__ gpost, const float* __restrict__ modp, int gi  , float resw,
                                        const float* __restrict__ gpre, int sci, int shi, int gw, int lane) {
    constexpr int RPW = M / 2048;
    const int row_lo = gw * RPW; const int b = row_lo / SEQ;
    const float* mb = modp + (size_t)b * (NMOD * DM);
    f32x4 Cg[4], A[4], Sh[4];
#pragma unroll
    for (int j = 0; j < 4; ++j) { const int col = 256 * j + 4 * lane;
        if (HAS_F) { const f32x4 g = *(const GAS f32x4*)(mb + gi * DM + col), gp = *(const GAS f32x4*)(gpost + col); Cg[j] = g * gp * resw; }
        if (HAS_H) { const f32x4 s = *(const GAS f32x4*)(mb + sci * DM + col), gp = *(const GAS f32x4*)(gpre + col); A[j] = gp * (s + 1.0f); Sh[j] = *(const GAS f32x4*)(mb + shi * DM + col); } }
    const float* xin = (const float*)xin_; const bf16* xinb = (const bf16*)xin_; float* xout = (float*)xout_; bf16* xoutb = (bf16*)xout_;
#define RP_LDX(dst, r, j) do { if (XIN_B) { const u32x2 w_ = __builtin_nontemporal_load((const GAS u32x2*)(xinb + (size_t)(r) * DM + 256 * (j) + 4 * lane)); \
        dst = (f32x4){__uint_as_float(w_.x << 16), __uint_as_float(w_.x & 0xffff0000u), __uint_as_float(w_.y << 16), __uint_as_float(w_.y & 0xffff0000u)}; } \
      else dst = __builtin_nontemporal_load((const GAS f32x4*)(xin + (size_t)(r) * DM + 256 * (j) + 4 * lane)); } while (0)
    f32x4 xn[4]; u32x2 fn[4];
#pragma unroll
    for (int j = 0; j < 4; ++j) { RP_LDX(xn[j], row_lo, j); if (HAS_F) fn[j] = __builtin_nontemporal_load((const GAS u32x2*)(Fb + (size_t)row_lo * DM + 256 * j + 4 * lane)); }
    for (int row = row_lo; row < row_lo + RPW; ++row) {
        f32x4 x[4]; u32x2 fwv[4];
#pragma unroll
        for (int j = 0; j < 4; ++j) { x[j] = xn[j]; if (HAS_F) fwv[j] = fn[j]; }
        { const int rn = (row + 1 < row_lo + RPW) ? row + 1 : row;
#pragma unroll
          for (int j = 0; j < 4; ++j) { RP_LDX(xn[j], rn, j); if (HAS_F) fn[j] = __builtin_nontemporal_load((const GAS u32x2*)(Fb + (size_t)rn * DM + 256 * j + 4 * lane)); } }
        if (HAS_F) {
            f32x4 f[4]; float ss = 0.f;
#pragma unroll
            for (int j = 0; j < 4; ++j) { const u32x2 fw = fwv[j];
                f[j] = (f32x4){__uint_as_float(fw.x << 16), __uint_as_float(fw.x & 0xffff0000u), __uint_as_float(fw.y << 16), __uint_as_float(fw.y & 0xffff0000u)}; ss += (f[j].x * f[j].x + f[j].y * f[j].y) + (f[j].z * f[j].z + f[j].w * f[j].w); }
            const float rstd = 1.0f / sqrtf(wave_sum(ss) * (1.0f / DM) + RMS_EPS);
#pragma unroll
            for (int j = 0; j < 4; ++j) { x[j] = x[j] + f[j] * rstd * Cg[j];
                if (XOUT_B) { u32x2 w; w.x = pk_bf16(x[j].x, x[j].y); w.y = pk_bf16(x[j].z, x[j].w); *(GAS u32x2*)(xoutb + (size_t)row * DM + 256 * j + 4 * lane) = w;
                    x[j] = (f32x4){__uint_as_float(w.x << 16), __uint_as_float(w.x & 0xffff0000u), __uint_as_float(w.y << 16), __uint_as_float(w.y & 0xffff0000u)}; }
                else __builtin_nontemporal_store(x[j], (GAS f32x4*)(xout + (size_t)row * DM + 256 * j + 4 * lane)); }
        }
        if (HAS_H) {
            float ss = 0.f;
#pragma unroll
            for (int j = 0; j < 4; ++j) ss += (x[j].x * x[j].x + x[j].y * x[j].y) + (x[j].z * x[j].z + x[j].w * x[j].w);
            const float rstd = 1.0f / sqrtf(wave_sum(ss) * (1.0f / DM) + RMS_EPS);
#pragma unroll
            for (int j = 0; j < 4; ++j) { const f32x4 h = x[j] * rstd * A[j] + Sh[j]; u32x2 w; w.x = pk_bf16(h.x, h.y); w.y = pk_bf16(h.z, h.w);
                *(GAS u32x2*)(H + (size_t)row * DM + 256 * j + 4 * lane) = w; }
        }
    }
}
#undef RP_LDX

__device__ __forceinline__ void rowpass_attn(const float* __restrict__ Od, const bf16* __restrict__ Os, bf16* __restrict__ H, const float* __restrict__ subln,
                                             const float* __restrict__ sbeta, float lam, int gw, int lane) {
    constexpr int RPW = M / 2048;
    const int hd = lane >> 4, e0 = 8 * (lane & 15);
    const f32x4 sl0 = *(const GAS f32x4*)(subln + e0), sl1 = *(const GAS f32x4*)(subln + e0 + 4);
    const f32x4 be0 = *(const GAS f32x4*)(sbeta + 8 * lane), be1 = *(const GAS f32x4*)(sbeta + 8 * lane + 4);
#define RA_UNPK(W_, V_) do { V_[0] = __uint_as_float(W_.x << 16); V_[1] = __uint_as_float(W_.x & 0xffff0000u); V_[2] = __uint_as_float(W_.y << 16); V_[3] = __uint_as_float(W_.y & 0xffff0000u); \
        V_[4] = __uint_as_float(W_.z << 16); V_[5] = __uint_as_float(W_.z & 0xffff0000u); V_[6] = __uint_as_float(W_.w << 16); V_[7] = __uint_as_float(W_.w & 0xffff0000u); } while (0)
    const int row_lo = gw * RPW;
    u32x4 n0 = *(const GAS u32x4*)((const bf16*)Od + (size_t)row_lo * 1024 + hd * 256 + e0), n1 = *(const GAS u32x4*)((const bf16*)Od + (size_t)row_lo * 1024 + hd * 256 + 128 + e0);
    u32x4 ns = *(const GAS u32x4*)(Os + (size_t)row_lo * 512 + 8 * lane);
    for (int row = row_lo; row < row_lo + RPW; ++row) {
        const u32x4 w0 = n0, w1 = n1, ws = ns;
        { const int rn = (row + 1 < row_lo + RPW) ? row + 1 : row;
          n0 = *(const GAS u32x4*)((const bf16*)Od + (size_t)rn * 1024 + hd * 256 + e0); n1 = *(const GAS u32x4*)((const bf16*)Od + (size_t)rn * 1024 + hd * 256 + 128 + e0);
          ns = *(const GAS u32x4*)(Os + (size_t)rn * 512 + 8 * lane); }
        float a0[8], a1[8], v[8], sv[8];
        RA_UNPK(w0, a0); RA_UNPK(w1, a1); RA_UNPK(ws, sv);
        float ss = 0.f, s2 = 0.f;
#pragma unroll
        for (int i = 0; i < 8; ++i) { v[i] = a0[i] - a1[i] * lam; ss += v[i] * v[i]; s2 += sv[i] * sv[i]; }
        ss = row16_sum(ss);
        const float rstd = 0.8f / sqrtf(ss * (1.0f / 128.0f) + RMS_EPS);
        u32x4 od; od.x = pk_bf16(v[0] * rstd * sl0.x, v[1] * rstd * sl0.y); od.y = pk_bf16(v[2] * rstd * sl0.z, v[3] * rstd * sl0.w);
        od.z = pk_bf16(v[4] * rstd * sl1.x, v[5] * rstd * sl1.y); od.w = pk_bf16(v[6] * rstd * sl1.z, v[7] * rstd * sl1.w);
        *(GAS u32x4*)(H + (size_t)row * 1024 + hd * 128 + e0) = od;
        const float rstd2 = 1.0f / sqrtf(wave_sum(s2) * (1.0f / 512.0f) + RMS_EPS);
        u32x4 o; o.x = pk_bf16(sv[0] * rstd2 * be0.x, sv[1] * rstd2 * be0.y); o.y = pk_bf16(sv[2] * rstd2 * be0.z, sv[3] * rstd2 * be0.w);
        o.z = pk_bf16(sv[4] * rstd2 * be1.x, sv[5] * rstd2 * be1.y); o.w = pk_bf16(sv[6] * rstd2 * be1.z, sv[7] * rstd2 * be1.w);
        *(GAS u32x4*)(H + (size_t)row * 1024 + 512 + 8 * lane) = o;
    }
#undef RA_UNPK
}

#define KAS __attribute__((address_space(4)))
__device__ __forceinline__ const float* karg(int i) { const KAS char* ka = (const KAS char*)__builtin_amdgcn_kernarg_segment_ptr(); return (const float*)(*(const volatile KAS unsigned long long*)(ka + 8 * i)); }
#define AIN(i) karg(i)
__device__ __forceinline__ int fresh_tid() { int t = threadIdx.x; asm volatile("" : "+v"(t)); return t; }
__global__ void __launch_bounds__(512) fwd_megakernel(Args args) {
    extern __shared__ __attribute__((aligned(16))) unsigned char lds_raw[];
    cg::grid_group grid = cg::this_grid();
    LAS unsigned char* lds = (LAS unsigned char*)lds_raw;
    const int wave = __builtin_amdgcn_readfirstlane((int)threadIdx.x >> 6);
#define tid (fresh_tid())
#define lane (fresh_tid() & 63)
    const int G = gridDim.x, bx = blockIdx.x;
    const int vcu = (G % 8 == 0) ? (bx % 8) * (G / 8) + bx / 8 : bx;
    const int gw = vcu * 8 + wave, NGW = G * 8;
    unsigned* ctlw = (unsigned*)((unsigned char*)karg(25) + WS_CTLW);
    volatile LAS unsigned* MISC = (volatile LAS unsigned*)(lds + GEMM_LDS);
    if (tid < 64) MISC[tid] = 0u;
    __syncthreads();
    XcdBarrier bar = xcd_barrier_post(ctlw, MISC + 8);
#define WSP(off) ((unsigned char*)karg(25) + (off))
#define ctl ((float*)WSP(WS_CTL))
#define modp (((float*)WSP(WS_CTL)) + 1024)
#define out ((float*)karg(24))
#define Wgu1 ((bf16*)WSP(WS_WGU1))
#define Wd1 ((bf16*)WSP(WS_WD1))
#define Win ((bf16*)WSP(WS_WIN))
#define Wout ((bf16*)WSP(WS_WOUT))
#define Wgu2 ((bf16*)WSP(WS_WGU2))
#define Wd2 ((bf16*)WSP(WS_WD2))
#define H ((bf16*)WSP(WS_H))
#define F ((float*)WSP(WS_F))
#define ACT ((bf16*)WSP(WS_ACT))
#define QK ((bf16*)WSP(WS_ACT))
#define VtD ((bf16*)WSP(WS_VTD))
#define VtS ((bf16*)WSP(WS_VTS))
#define Osb ((bf16*)WSP(WS_OSB))
#define XB ((bf16*)WSP(WS_XB))
    if (PH(0)) REP(0) {
        if (bx < 144) {
            LAS float* sc = (LAS float*)lds;
            LAS float* red = sc + 4096;
            const float* c = AIN(1);
            for (int i = tid; i < 4096; i += 512) { const float v = c[i]; sc[i] = v / (1.0f + __expf(-v)); }
            __syncthreads();
            const int col = bx * 64 + (tid & 63), kg = tid >> 6;
            const float* wp = AIN(2) + (size_t)(kg * 128) * (NMOD * DM) + col;
            float a0 = 0.f, a1 = 0.f, a2 = 0.f, a3 = 0.f;
#pragma unroll 8
            for (int k = 0; k < 128; ++k) { const float w = ((const GAS float*)wp)[(size_t)k * (NMOD * DM)]; const int kk = kg * 128 + k;
                a0 += sc[kk] * w; a1 += sc[1024 + kk] * w; a2 += sc[2048 + kk] * w; a3 += sc[3072 + kk] * w; }
            red[(kg * 4 + 0) * 64 + (tid & 63)] = a0; red[(kg * 4 + 1) * 64 + (tid & 63)] = a1; red[(kg * 4 + 2) * 64 + (tid & 63)] = a2; red[(kg * 4 + 3) * 64 + (tid & 63)] = a3;
            __syncthreads();
            if (tid < 256) { const int b = tid >> 6, cc = tid & 63; float s = 0.f;
#pragma unroll
                for (int g = 0; g < 8; ++g) s += red[(g * 4 + b) * 64 + cc];
                modp[(size_t)b * (NMOD * DM) + bx * 64 + cc] = s + AIN(3)[bx * 64 + cc]; }
            __syncthreads();
        }
        if (bx == G - 1 && wave == 0) {
            const float s1 = wave_sum(AIN(13)[lane] * AIN(14)[lane]), s2 = wave_sum(AIN(15)[lane] * AIN(16)[lane]);
            if (lane == 0) ctl[0] = __expf(s1) - __expf(s2) + 0.2f;
        }
        LAS float* scr = (LAS float*)(lds + wave * 16384);
        constexpr int I_G = (DM / 64) * (DFF / 32), I_D = (DFF / 64) * (DM / 32), I_IN = (DM / 64) * (3 * DM / 32), I_OUT = (DM / 64) * (DM / 32);
        constexpr int NITEMS = 6 * I_G + I_IN + I_OUT;
        static_assert(I_G == I_D, "item counts");
        for (int itx = gw; itx < NITEMS; itx += NGW) {
            int r = itx;
            if (r < I_G) { transpose_item(AIN(6), DM, DFF, Wgu1, 1, scr, r, lane); continue; } r -= I_G;
            if (r < I_G) { transpose_item(AIN(7), DM, DFF, Wgu1, 2, scr, r, lane); continue; } r -= I_G;
            if (r < I_D) { transpose_item(AIN(8), DFF, DM, Wd1, 0, scr, r, lane); continue; } r -= I_D;
            if (r < I_G) { transpose_item(AIN(21), DM, DFF, Wgu2, 1, scr, r, lane); continue; } r -= I_G;
            if (r < I_G) { transpose_item(AIN(22), DM, DFF, Wgu2, 2, scr, r, lane); continue; } r -= I_G;
            if (r < I_D) { transpose_item(AIN(23), DFF, DM, Wd2, 0, scr, r, lane); continue; } r -= I_D;
            if (r < I_IN) { transpose_item(AIN(11), DM, 3 * DM, Win, 0, scr, r, lane); continue; } r -= I_IN;
            transpose_item(AIN(12), DM, DM, Wout, 0, scr, r, lane);
        }
    }
    if (G == 0x7ffffff0) grid.sync();
    xcd_barrier(bar);
#ifdef EXTRA_SYNCS
    for (int es = 0; es < EXTRA_SYNCS; ++es) xcd_barrier(bar);
#endif
    if (PH(1)) REP(1) rowpass<false, true>(AIN(0), nullptr, nullptr, H, nullptr, modp, 0, 0.f, AIN(4), 1, 0, gw, lane);
    xcd_barrier(bar);
    if (PH(2)) REP(2) { pg8::Gemm g{H, Wgu1, M, 2 * DFF, DM}; pg8::StaticOrder S; S.init(M, 2 * DFF, G, bx, WGM_GU); pg8::EpiSwiglu E{ACT, DFF};
      pg8::gemm_phase<pg8::EpiSwiglu, pg8::StaticOrder, true, true>(lds, g, S, E); }
    xcd_barrier(bar);
    if (PH(3)) REP(3) { pg8::Gemm g{ACT, Wd1, M, DM, DFF}; pg8::StaticOrder S; S.init(M, DM, G, bx, WGM_N1K); pg8::EpiBf16Out E{(bf16*)F, DM};
      pg8::gemm_phase<pg8::EpiBf16Out, pg8::StaticOrder, true, true>(lds, g, S, E); }
    xcd_barrier(bar);
    if (PH(4)) REP(4) rowpass<true, true, false, true>(AIN(0), (const bf16*)F, XB, H, AIN(5), modp, 2, 0.5f, AIN(9), 4, 3, gw, lane);
    xcd_barrier(bar);
    if (PH(5)) REP(5) { pg8::Gemm g{H, Win, M, 3 * DM, DM}; pg8::StaticOrder S; S.init(M, 3 * DM, G, bx, WGM_IN); pg8::EpiProj E{QK, VtD, VtS, C2, SEQ, ctlw + CW_KINF};
      pg8::gemm_phase<pg8::EpiProj, pg8::StaticOrder, true, true>(lds, g, S, E); }
    xcd_barrier(bar);
    if (PH(6)) {
        const unsigned* kinfw = ctlw + CW_KINF;
        LAS unsigned* uslot = (LAS unsigned*)(lds + att::FLAG_OFF + 128);
        const unsigned myx = xb_xcc_id() & 7u;
        for (int qi = 0; qi < 8; ++qi) {
            const unsigned xq = (myx + (unsigned)qi) & 7u;
            unsigned* qctr = ctlw + CW_QUEUE + 64 * xq;
            for (;;) {
                if (tid == 0) *uslot = atomicAdd(qctr, 1u);
                __syncthreads();
                const unsigned u = *uslot;
                __syncthreads();
                if (u >= 128u) break;
                const int h = 3 - (int)(u >> 5), qb = 31 - (int)(u & 31), b = (int)(xq >> 1), vh = 2 * h + (int)(xq & 1);
                const float slope2 = 1.4426950408889634f * exp2f(-2.0f * (float)(h + 1));
                const float kinfa = __uint_as_float(kinfw[(b * 8 + vh) * 2]), kinfb = __uint_as_float(kinfw[(b * 8 + vh) * 2 + 1]);
                att::attn_unit<0, 128>(lds, QK, vh * 64, 512 + vh * 64, VtD + ((size_t)(b * 512 + h * 128)) * SEQ, (size_t)b * SEQ, qb, slope2, kinfa, kinfb, F, nullptr, vh * 128);
            }
        }
        {
            unsigned* qctr = ctlw + CW_QUEUE + 64 * 8;
            for (;;) {
                if (tid == 0) *uslot = atomicAdd(qctr, 1u);
                __syncthreads();
                const unsigned u = *uslot;
                __syncthreads();
                if (u >= 1024u) break;
                const int v = (int)u, qb = 31 - (v >> 5), b = (v & 31) >> 3, h = v & 7;
                att::attn_unit<1, 64>(lds, QK, 1024 + h * 64, 1536 + h * 64, VtS + ((size_t)(b * 512 + h * 64)) * SEQ, (size_t)b * SEQ, qb, 0.f, 0.f, 0.f, nullptr, Osb, h * 64);
            }
        }
    }
    xcd_barrier(bar);
    if (PH(7)) REP(7) rowpass_attn(F, Osb, H, AIN(17), AIN(18), ctl[0], gw, lane);
    xcd_barrier(bar);
    if (PH(8)) REP(8) { pg8::Gemm g{H, Wout, M, DM, DM}; pg8::StaticOrder S; S.init(M, DM, G, bx, WGM_N1K); pg8::EpiBf16Out E{(bf16*)F, DM};
      pg8::gemm_phase<pg8::EpiBf16Out, pg8::StaticOrder, true, true>(lds, g, S, E); }
    xcd_barrier(bar);
    if (PH(9)) REP(9) rowpass<true, true, true, true>(XB, (const bf16*)F, XB, H, AIN(10), modp, 5, 1.0f, AIN(19), 7, 6, gw, lane);
    xcd_barrier(bar);
    if (PH(10)) REP(10) { pg8::Gemm g{H, Wgu2, M, 2 * DFF, DM}; pg8::StaticOrder S; S.init(M, 2 * DFF, G, bx, WGM_GU); pg8::EpiSwiglu E{ACT, DFF};
      pg8::gemm_phase<pg8::EpiSwiglu, pg8::StaticOrder, true, true>(lds, g, S, E); }
    xcd_barrier(bar);
    if (PH(11)) REP(11) { pg8::Gemm g{ACT, Wd2, M, DM, DFF}; pg8::StaticOrder S; S.init(M, DM, G, bx, WGM_N1K); pg8::EpiBf16Out E{(bf16*)F, DM};
      pg8::gemm_phase<pg8::EpiBf16Out, pg8::StaticOrder, true, true>(lds, g, S, E); }
    xcd_barrier(bar);
    if (PH(12)) REP(12) rowpass<true, false, true, false>(XB, (const bf16*)F, out, nullptr, AIN(20), modp, 8, 0.5f, nullptr, 0, 0, gw, lane);
}
#undef ctl
#undef modp
#undef out
#undef Wgu1
#undef Wd1
#undef Win
#undef Wout
#undef Wgu2
#undef Wd2
#undef H
#undef F
#undef ACT
#undef QK
#undef VtD
#undef VtS
#undef Osb
#undef XB

#undef tid
#undef lane
extern "C" void kernel_launch(void* const* d_in, const int* in_sizes, int n_in, void* d_out, int out_size, void* d_ws, size_t ws_size, hipStream_t stream) {
    static int grid = 0;
    if (grid == 0) {
        if (n_in != 24 || out_size != M * DM || ws_size < WS_END) { fprintf(stderr, "kernel_launch: unexpected shapes (n_in %d out %d ws %zu)\n", n_in, out_size, ws_size); grid = -1; return; }
        int dev = 0, cus = 0, per_cu = 0;
        hipGetDevice(&dev); hipDeviceGetAttribute(&cus, hipDeviceAttributeMultiprocessorCount, dev);
        if (hipFuncSetAttribute((const void*)fwd_megakernel, hipFuncAttributeMaxDynamicSharedMemorySize, LDS_BYTES) != hipSuccess) { fprintf(stderr, "kernel_launch: hipFuncSetAttribute failed\n"); grid = -1; return; }
        if (hipOccupancyMaxActiveBlocksPerMultiprocessor(&per_cu, (const void*)fwd_megakernel, 512, LDS_BYTES) != hipSuccess || per_cu < 1) { fprintf(stderr, "kernel_launch: occupancy query says %d blocks per CU\n", per_cu); per_cu = 1; }
        (void)hipGetLastError();
        if (cus < 256) { fprintf(stderr, "kernel_launch: built for a 256-CU device (got %d CUs)\n", cus); grid = -1; return; }
        grid = 256;
    }
    if (grid < 0) return;
    if (hipMemsetAsync((char*)d_ws + WS_CTLW, 0, CTLW_BYTES, stream) != hipSuccess) { fprintf(stderr, "kernel_launch: memset of the control words failed\n"); return; }
    Args a{};
    for (int i = 0; i < 24; ++i) a.in[i] = (const float*)d_in[i];
    a.out = (float*)d_out; a.ws = (unsigned char*)d_ws;
    void* kargs[] = {&a};
    hipError_t e = hipLaunchCooperativeKernel((const void*)fwd_megakernel, dim3(grid), dim3(512), kargs, LDS_BYTES, stream);
    if (e != hipSuccess) fprintf(stderr, "cooperative launch failed: %s (grid %d)\n", hipGetErrorString(e), grid);
}
```

```cpp
#include <hip/hip_runtime.h>
#include <hip/hip_cooperative_groups.h>
#include <cstdio>
#include <cstdint>
#include <cmath>
namespace cg = cooperative_groups;
namespace pg8 {
#define PG8_LAS __attribute__((address_space(3)))
typedef unsigned short bf16_t;
typedef short bf16x8 __attribute__((ext_vector_type(8)));
typedef float f32x4 __attribute__((ext_vector_type(4)));
typedef unsigned u32x4 __attribute__((ext_vector_type(4)));
constexpr int BM = 256, BK = 64, HALF = 128, HTB = HALF * BK * 2  , STAGE_BYTES = 8 * HTB, NXCD = 8, WGM = 8;

__host__ __device__ __forceinline__ int lds_byte(int r, int c) { const int st = (r >> 4) * 2 + (c >> 5), rr = r & 15, cc = c & 31, ob = rr * 64 + cc * 2; return st * 1024 + (ob ^ (((ob >> 9) & 1) << 5)); }
__host__ __device__ __forceinline__ void stage_rc(int b, int& R, int& C) { const int st = b / 1024, sb = b % 1024, swz = sb ^ (((sb >> 9) & 1) << 5); R = (st >> 1) * 16 + swz / 64; C = (st & 1) * 32 + (swz % 64) / 2; }
__host__ __device__ __forceinline__ int perm32(int rho) { const int n = rho >> 4, i = rho & 15; return 8 * (i >> 2) + 4 * n + (i & 3); }

struct Unit { int pm, pn; };
struct Gemm { const bf16_t* A; const bf16_t* Bt; int M, N, K; };

struct StaticOrder {
    int nM, nN, nwg, G, c, wgm;
    __host__ __device__ void init(int M, int N, int G_, int c_, int wgm_ = WGM) { nM = M / BM; nN = N / BM; nwg = nM * nN; G = G_; c = c_; wgm = wgm_; }
    __host__ __device__ bool next(int i, Unit& u) const {
        const long L = (long)i * G + c; if (L >= nwg) return false;
        int wgid = (int)L; { const int q = nwg / NXCD, r = nwg % NXCD, xcd = wgid % NXCD, off = wgid / NXCD; wgid = (xcd < r ? xcd * (q + 1) : r * (q + 1) + (xcd - r) * q) + off; }
        const int nig = wgm * nN, gid = wgid / nig, fm = gid * wgm, gsz = (nM - fm) < wgm ? (nM - fm) : wgm;
        u.pm = fm + ((wgid % nig) % gsz); u.pn = (wgid % nig) / gsz; return true;
    }
    __device__ __forceinline__ void a_ready(const Unit&) const {}
    __device__ __forceinline__ void done(const Unit&) const {}
};

__device__ __forceinline__ unsigned cvt_pk_bf16(float lo, float hi) { unsigned r; asm volatile("v_cvt_pk_bf16_f32 %0, %1, %2" : "=v"(r) : "v"(lo), "v"(hi)); return r; }
#define PG8_GAS __attribute__((address_space(1)))
__device__ __forceinline__ float silu_mul(float g, float u) { const float e = __builtin_amdgcn_exp2f(g * -1.4426950408889634f); return g * __builtin_amdgcn_rcpf(1.0f + e) * u; }
struct EpiSwiglu {
    static constexpr bool PERM = true, AFTER_DRAIN = false;
    bf16_t* O; int ldc;
    __device__ __forceinline__ void operator()(const f32x4 (&acc)[2][2][4][2], const Unit& u, int wr, int wc, int fr, int fq) const {
        const int row0 = u.pm * BM + wr * 64 + fr; const int col0 = u.pn * HALF + wc * 32 + 8 * fq;
#pragma unroll
        for (int ai = 0; ai < 2; ++ai)
#pragma unroll
            for (int m = 0; m < 4; ++m) { bf16_t* rowp = O + (size_t)(row0 + ai * HALF + m * 16) * ldc + col0;
                const f32x4 g0 = acc[ai][0][m][0], g1 = acc[ai][0][m][1], u0 = acc[ai][1][m][0], u1 = acc[ai][1][m][1];
                u32x4 w; w.x = cvt_pk_bf16(silu_mul(g0[0], u0[0]), silu_mul(g0[1], u0[1])); w.y = cvt_pk_bf16(silu_mul(g0[2], u0[2]), silu_mul(g0[3], u0[3]));
                w.z = cvt_pk_bf16(silu_mul(g1[0], u1[0]), silu_mul(g1[1], u1[1])); w.w = cvt_pk_bf16(silu_mul(g1[2], u1[2]), silu_mul(g1[3], u1[3]));
                *(PG8_GAS u32x4*)rowp = w; }
    }
};
struct EpiBf16Out {
    static constexpr bool PERM = true, AFTER_DRAIN = false;
    bf16_t* O; int ldc;
    __device__ __forceinline__ void operator()(const f32x4 (&acc)[2][2][4][2], const Unit& u, int wr, int wc, int fr, int fq) const {
        const int row0 = u.pm * BM + wr * 64 + fr; const int col0 = u.pn * BM + wc * 32 + 8 * fq;
#pragma unroll
        for (int ai = 0; ai < 2; ++ai)
#pragma unroll
            for (int m = 0; m < 4; ++m) { bf16_t* rowp = O + (size_t)(row0 + ai * HALF + m * 16) * ldc + col0;
#pragma unroll
                for (int bj = 0; bj < 2; ++bj) { const f32x4 v0 = acc[ai][bj][m][0], v1 = acc[ai][bj][m][1];
                    u32x4 w; w.x = cvt_pk_bf16(v0[0], v0[1]); w.y = cvt_pk_bf16(v0[2], v0[3]); w.z = cvt_pk_bf16(v1[0], v1[1]); w.w = cvt_pk_bf16(v1[2], v1[3]);
                    *(PG8_GAS u32x4*)(rowp + bj * HALF) = w; } }
    }
};
struct EpiProj {
    static constexpr bool PERM = true, AFTER_DRAIN = false;
    bf16_t* QK; bf16_t* VtD; bf16_t* VtS; float qscale; int S; unsigned* kinf;
    __device__ __forceinline__ void operator()(const f32x4 (&acc)[2][2][4][2], const Unit& u, int wr, int wc, int fr, int fq) const {
        const int seg = u.pn >> 1, half = u.pn & 1;
        if (seg == 2 || seg == 5) {
            bf16_t* Vt = (seg == 2) ? VtD : VtS;
            const int row_t = u.pm * BM; const int b = row_t / S, t0 = row_t - b * S;
#pragma unroll
            for (int ai = 0; ai < 2; ++ai)
#pragma unroll
                for (int m = 0; m < 4; ++m) { const int t = t0 + ai * HALF + wr * 64 + m * 16 + fr; const int pos = (t & ~12) | ((t & 4) << 1) | ((t & 8) >> 1);
#pragma unroll
                    for (int bj = 0; bj < 2; ++bj)
#pragma unroll
                        for (int n = 0; n < 2; ++n) { const int ch = 256 * half + 128 * bj + 32 * wc + 8 * fq + 4 * n;
                            const f32x4 v = acc[ai][bj][m][n]; const unsigned w0 = cvt_pk_bf16(v[0], v[1]), w1 = cvt_pk_bf16(v[2], v[3]);
                            const unsigned snd = (fr & 1) ? w0 : w1;
                            const unsigned rcv = (unsigned)__builtin_amdgcn_update_dpp(0, (int)snd, 0xB1, 0xF, 0xF, true);
                            const unsigned lo = (fr & 1) ? rcv : w0, hi2 = (fr & 1) ? w1 : rcv;
                            const unsigned s0 = (lo & 0xffffu) | (hi2 << 16), s1 = (lo >> 16) | (hi2 & 0xffff0000u);
                            PG8_GAS bf16_t* p = (PG8_GAS bf16_t*)(Vt + ((size_t)(b * 512 + ch + 2 * (fr & 1))) * S + (pos & ~1));
                            *(PG8_GAS unsigned*)p = s0; *(PG8_GAS unsigned*)(p + (size_t)S) = s1; } }
        } else {
            const int cbase = ((seg == 0) ? 0 : (seg == 1) ? 512 : (seg == 3) ? 1024 : 1536) + 256 * half + wc * 32 + 8 * fq;
            const float sc = (seg == 0 || seg == 3) ? qscale : 1.0f;
            const int row0 = u.pm * BM + wr * 64 + fr;
#pragma unroll
            for (int ai = 0; ai < 2; ++ai)
#pragma unroll
                for (int m = 0; m < 4; ++m) { bf16_t* rowp = QK + (size_t)(row0 + ai * HALF + m * 16) * 2048 + cbase;
#pragma unroll
                    for (int bj = 0; bj < 2; ++bj) { const f32x4 v0 = acc[ai][bj][m][0] * sc, v1 = acc[ai][bj][m][1] * sc;
                        u32x4 w; w.x = cvt_pk_bf16(v0[0], v0[1]); w.y = cvt_pk_bf16(v0[2], v0[3]); w.z = cvt_pk_bf16(v1[0], v1[1]); w.w = cvt_pk_bf16(v1[2], v1[3]);
                        *(PG8_GAS u32x4*)(rowp + bj * HALF) = w; } }
            if (seg == 1) {
                const int b = (u.pm * BM) / S;
#pragma unroll
                for (int bj = 0; bj < 2; ++bj) { float v = 0.f;
#pragma unroll
                    for (int ai = 0; ai < 2; ++ai)
#pragma unroll
                        for (int m = 0; m < 4; ++m) { const f32x4 x = acc[ai][bj][m][0], y = acc[ai][bj][m][1];
                            float s2 = (x[0] * x[0] + x[1] * x[1]) + (x[2] * x[2] + x[3] * x[3]) + (y[0] * y[0] + y[1] * y[1]) + (y[2] * y[2] + y[3] * y[3]);
                            s2 += __shfl_xor(s2, 16); s2 += __shfl_xor(s2, 32);
                            v = fmaxf(v, s2); }
#pragma unroll
                    for (int o = 1; o < 16; o <<= 1) v = fmaxf(v, __shfl_xor(v, o));
                    if (fr == 0 && fq == 0) atomicMax(kinf + (b * 8 + 4 * half + 2 * bj + (wc >> 1)) * 2 + (wc & 1), __float_as_uint(v)); }
            }
        }
    }
};

template <class Epi, class Sched, bool ALIGN_EPI = false, bool SP2 = false>
__device__ __forceinline__ void gemm_phase(PG8_LAS unsigned char* lds, const Gemm g, const Sched& S, const Epi& E) {
    int tid_l = threadIdx.x; asm volatile("" : "+v"(tid_l));
    const int tid = tid_l, wid = __builtin_amdgcn_readfirstlane(tid >> 6), lane = tid & 63, wr = wid >> 2, wc = wid & 3, fr = lane & 15, fq = lane >> 4;
    const int K = g.K, nt = K / BK;
    unsigned voffA[2], voffB[2];
#pragma unroll
    for (int i = 0; i < 2; ++i) { int R, C; stage_rc(tid * 16 + i * 8192, R, C); const int Rb = Epi::PERM ? ((R & ~31) + perm32(R & 31)) : R;
        voffA[i] = (unsigned)(R * K + C) * 2u; voffB[i] = (unsigned)(Rb * K + C) * 2u; }
    const size_t kstep = (size_t)(BK * 2);
    const size_t hstep = (size_t)HALF * K * 2;
    const size_t tstep = 2 * hstep;
    const unsigned ldsw = (unsigned)wid * 1024u;
    const int aoff = lds_byte(wr * 64 + fr, fq * 8), boff = lds_byte(wc * 32 + fr, fq * 8);
#define PG8_SA(b, h) (((b) * 2 + (h)) * HTB)
#define PG8_SB(b, h) ((4 + (b) * 2 + (h)) * HTB)
#define PG8_STAGE(bufoff, gbase, voff) do { _Pragma("unroll") for (int _i = 0; _i < 2; ++_i) \
        __builtin_amdgcn_global_load_lds((const unsigned*)((const char*)(gbase) + (voff)[_i]), (PG8_LAS unsigned*)(lds + (bufoff) + ldsw + _i * 8192), 16, 0, 0); } while (0)
#define PG8_LDA(dst, b, h) do { _Pragma("unroll") for (int m = 0; m < 4; ++m) _Pragma("unroll") for (int k = 0; k < 2; ++k) dst[m][k] = *(const PG8_LAS bf16x8*)(lds + PG8_SA(b, h) + aoff + m * 2048 + k * 1024); } while (0)
#define PG8_LDB(dst, b, h) do { _Pragma("unroll") for (int n = 0; n < 2; ++n) _Pragma("unroll") for (int k = 0; k < 2; ++k) dst[n][k] = *(const PG8_LAS bf16x8*)(lds + PG8_SB(b, h) + boff + n * 2048 + k * 1024); } while (0)
#define PG8_MMA(ai, bj, At, Bt) do { __builtin_amdgcn_s_setprio(1); _Pragma("unroll") for (int m = 0; m < 4; ++m) _Pragma("unroll") for (int n = 0; n < 2; ++n) _Pragma("unroll") for (int k = 0; k < 2; ++k) \
        acc[ai][bj][m][n] = __builtin_amdgcn_mfma_f32_16x16x32_bf16(Bt[n][k], At[m][k], acc[ai][bj][m][n], 0, 0, 0); __builtin_amdgcn_s_setprio(0); } while (0)
#define PG8_WAIT_V(n) asm volatile("s_waitcnt vmcnt(" #n ")" ::: "memory")
#define PG8_WAIT_L(n) asm volatile("s_waitcnt lgkmcnt(" #n ")" ::: "memory")
#define PG8_BAR __builtin_amdgcn_s_barrier()
#define PG8_SCHED __builtin_amdgcn_sched_barrier(0)
    Unit cur, nxt; int ui = 0;
    if (!S.next(0, cur)) return;
    f32x4 acc[2][2][4][2];
#pragma unroll
    for (int a = 0; a < 2; ++a)
#pragma unroll
        for (int b = 0; b < 2; ++b)
#pragma unroll
            for (int m = 0; m < 4; ++m)
#pragma unroll
                for (int n = 0; n < 2; ++n) acc[a][b][m][n] = (f32x4){0.f, 0.f, 0.f, 0.f};
    bf16x8 At[4][2], B0[2][2], B1[2][2];
    const char* cA = (const char*)g.A + (size_t)cur.pm * tstep; const char* cB = (const char*)g.Bt + (size_t)cur.pn * tstep;
    S.a_ready(cur);
    if constexpr (SP2) {
        PG8_STAGE(PG8_SB(0, 0), cB, voffB); PG8_STAGE(PG8_SB(0, 1), cB + hstep, voffB); PG8_STAGE(PG8_SA(0, 0), cA, voffA); PG8_STAGE(PG8_SA(0, 1), cA + hstep, voffA);
        if (wr == 1) PG8_BAR;
        PG8_WAIT_V(2); PG8_BAR;
        PG8_STAGE(PG8_SB(1, 0), cB + kstep, voffB); PG8_STAGE(PG8_SA(1, 0), cA + kstep, voffA); PG8_STAGE(PG8_SB(1, 1), cB + hstep + kstep, voffB);
        PG8_WAIT_V(6); PG8_BAR;
    } else {
        PG8_STAGE(PG8_SB(0, 0), cB, voffB); PG8_STAGE(PG8_SA(0, 0), cA, voffA); PG8_STAGE(PG8_SB(0, 1), cB + hstep, voffB); PG8_STAGE(PG8_SA(0, 1), cA + hstep, voffA);
        if (wr == 1) PG8_BAR;
        PG8_WAIT_V(4); PG8_BAR;
        PG8_STAGE(PG8_SB(1, 0), cB + kstep, voffB); PG8_STAGE(PG8_SA(1, 0), cA + kstep, voffA); PG8_STAGE(PG8_SB(1, 1), cB + hstep + kstep, voffB);
        PG8_WAIT_V(6); PG8_BAR;
    }
    for (;;) {
        const bool has_next = S.next(ui + 1, nxt);
        const char* nA = has_next ? (const char*)g.A + (size_t)nxt.pm * tstep : cA; const char* nB = has_next ? (const char*)g.Bt + (size_t)nxt.pn * tstep : cB;
        for (int t = 0; t < nt; t += 2) {
            const bool last = (t == nt - 2);
            const char* a1 = cA + (size_t)(t + 1) * kstep;
            const char* a2 = last ? nA : cA + (size_t)(t + 2) * kstep; const char* b2 = last ? nB : cB + (size_t)(t + 2) * kstep;
            const char* a3 = a2 + kstep; const char* b3 = b2 + kstep;
            if (last && has_next) S.a_ready(nxt);
            if constexpr (SP2) {
            PG8_LDB(B0, 0, 0); PG8_LDB(B1, 0, 1); PG8_SCHED; PG8_LDA(At, 0, 0); PG8_STAGE(PG8_SA(1, 1), a1 + hstep, voffA);
            PG8_WAIT_V(8); PG8_WAIT_L(0); PG8_BAR; PG8_MMA(0, 0, At, B0); PG8_MMA(0, 1, At, B1); PG8_BAR; PG8_SCHED;
            PG8_LDA(At, 0, 1); PG8_STAGE(PG8_SB(0, 0), b2, voffB); PG8_STAGE(PG8_SB(0, 1), b2 + hstep, voffB); PG8_STAGE(PG8_SA(0, 0), a2, voffA);
            PG8_WAIT_V(8); PG8_WAIT_L(0); PG8_BAR; PG8_MMA(1, 0, At, B0); PG8_MMA(1, 1, At, B1); PG8_BAR; PG8_SCHED;
            PG8_LDB(B0, 1, 0); PG8_LDB(B1, 1, 1); PG8_SCHED; PG8_LDA(At, 1, 0); PG8_STAGE(PG8_SA(0, 1), a2 + hstep, voffA);
            PG8_WAIT_V(8); PG8_WAIT_L(0); PG8_BAR; PG8_MMA(0, 0, At, B0); PG8_MMA(0, 1, At, B1); PG8_BAR; PG8_SCHED;
            PG8_LDA(At, 1, 1); PG8_STAGE(PG8_SB(1, 0), b3, voffB); PG8_STAGE(PG8_SB(1, 1), b3 + hstep, voffB); PG8_STAGE(PG8_SA(1, 0), a3, voffA);
            PG8_WAIT_V(8); PG8_WAIT_L(0); PG8_BAR; PG8_MMA(1, 0, At, B0); PG8_MMA(1, 1, At, B1); PG8_BAR; PG8_SCHED;
            } else {
            PG8_LDB(B0, 0, 0); PG8_SCHED; PG8_LDA(At, 0, 0); PG8_STAGE(PG8_SA(1, 1), a1 + hstep, voffA);
            PG8_WAIT_L(8); PG8_BAR; PG8_WAIT_L(0); PG8_MMA(0, 0, At, B0); PG8_BAR; PG8_SCHED;
            PG8_LDB(B1, 0, 1); PG8_STAGE(PG8_SB(0, 0), b2, voffB);
            PG8_BAR; PG8_WAIT_L(0); PG8_MMA(0, 1, At, B1); PG8_BAR;
            PG8_LDA(At, 0, 1); PG8_STAGE(PG8_SA(0, 0), a2, voffA);
            PG8_BAR; PG8_WAIT_L(0); PG8_MMA(1, 0, At, B0); PG8_BAR; PG8_SCHED;
            PG8_STAGE(PG8_SB(0, 1), b2 + hstep, voffB);
            PG8_WAIT_V(6); PG8_BAR; PG8_MMA(1, 1, At, B1); PG8_BAR;
            PG8_LDB(B0, 1, 0); PG8_SCHED; PG8_LDA(At, 1, 0); PG8_STAGE(PG8_SA(0, 1), a2 + hstep, voffA);
            PG8_WAIT_L(8); PG8_BAR; PG8_WAIT_L(0); PG8_MMA(0, 0, At, B0); PG8_BAR; PG8_SCHED;
            PG8_LDB(B1, 1, 1); PG8_STAGE(PG8_SB(1, 0), b3, voffB);
            PG8_BAR; PG8_WAIT_L(0); PG8_MMA(0, 1, At, B1); PG8_BAR;
            PG8_LDA(At, 1, 1); PG8_STAGE(PG8_SA(1, 0), a3, voffA);
            PG8_BAR; PG8_WAIT_L(0); PG8_MMA(1, 0, At, B0); PG8_BAR; PG8_SCHED;
            PG8_STAGE(PG8_SB(1, 1), b3 + hstep, voffB);
            PG8_WAIT_V(6); PG8_BAR; PG8_MMA(1, 1, At, B1); PG8_BAR;
            }
        }
        if constexpr (ALIGN_EPI) { if (wr == 0) PG8_BAR; }
        if constexpr (!Epi::AFTER_DRAIN) { E(acc, cur, wr, wc, fr, fq); S.done(cur); }
        if (!has_next) break;
#pragma unroll
        for (int a = 0; a < 2; ++a)
#pragma unroll
            for (int b = 0; b < 2; ++b)
#pragma unroll
                for (int m = 0; m < 4; ++m)
#pragma unroll
                    for (int n = 0; n < 2; ++n) acc[a][b][m][n] = (f32x4){0.f, 0.f, 0.f, 0.f};
        cur = nxt; cA = nA; cB = nB; ++ui;
        if constexpr (ALIGN_EPI) { if (wr == 1) PG8_BAR; }
    }
    PG8_WAIT_V(0);
    if constexpr (!ALIGN_EPI) { if (wr == 0) PG8_BAR; }
    PG8_BAR;
    if constexpr (Epi::AFTER_DRAIN) { E.fused(acc, cur, wr, wc, fr, fq, lds, wid, lane); S.done(cur); }
#undef PG8_SA
#undef PG8_SB
#undef PG8_STAGE
#undef PG8_LDA
#undef PG8_LDB
#undef PG8_MMA
#undef PG8_WAIT_V
#undef PG8_WAIT_L
#undef PG8_BAR
#undef PG8_SCHED
}
}

#define LAS __attribute__((address_space(3)))
#define GAS __attribute__((address_space(1)))
typedef unsigned short bf16;
typedef float f32x4 __attribute__((ext_vector_type(4)));
typedef float f32x2 __attribute__((ext_vector_type(2)));
typedef float f32x16 __attribute__((ext_vector_type(16)));
typedef short bf16x8 __attribute__((ext_vector_type(8)));
typedef unsigned u32x4 __attribute__((ext_vector_type(4)));
typedef unsigned u32x2 __attribute__((ext_vector_type(2)));
constexpr int NB = 4, SEQ = 8192, DM = 1024, DFF = 2816, M = NB * SEQ, NMOD = 9;
constexpr float RMS_EPS = 1e-6f;
constexpr float C2 = 0.125f * 1.4426950408889634f;
constexpr size_t MiB = 1u << 20;
constexpr size_t WS_CTL = 0;
constexpr size_t WS_WGU1 = 1 * MiB, WS_WD1 = 12 * MiB, WS_WIN = 18 * MiB, WS_WOUT = 24 * MiB, WS_WGU2 = 26 * MiB, WS_WD2 = 37 * MiB;
constexpr size_t WS_H = 48 * MiB;
constexpr size_t WS_F = 112 * MiB;
constexpr size_t WS_XB = 176 * MiB;
constexpr size_t WS_ACT = 240 * MiB;
constexpr size_t WS_VTD = 416 * MiB, WS_VTS = 448 * MiB;
constexpr size_t WS_OSB = 480 * MiB;
constexpr size_t WS_END = 512 * MiB;
constexpr int GEMM_LDS = 131072, LDS_BYTES = GEMM_LDS + 1024;
constexpr size_t WS_CTLW = 512 * 1024, CTLW_BYTES = 32 * 1024;
constexpr int CW_KINF = 4096, CW_QUEUE = 4160;

template <int CTRL> __device__ __forceinline__ float dpp_f(float v) { return __builtin_bit_cast(float, __builtin_amdgcn_update_dpp(0, __builtin_bit_cast(int, v), CTRL, 0xF, 0xF, true)); }
__device__ __forceinline__ float row16_sum(float v) {
    v += dpp_f<0xB1>(v);
    v += dpp_f<0x4E>(v);
    v += dpp_f<0x141>(v);
    v += dpp_f<0x140>(v);
    return v;
}
__device__ __forceinline__ float xrow_sum(float v) {
    { auto rr = __builtin_amdgcn_permlane16_swap(__float_as_uint(v), __float_as_uint(v), false, false); v = __uint_as_float(rr[0]) + __uint_as_float(rr[1]); }
    { auto rr = __builtin_amdgcn_permlane32_swap(__float_as_uint(v), __float_as_uint(v), false, false); v = __uint_as_float(rr[0]) + __uint_as_float(rr[1]); }
    return v;
}
__device__ __forceinline__ float wave_sum(float v) { return xrow_sum(row16_sum(v)); }
__device__ __forceinline__ unsigned pk_bf16(float lo, float hi) { return pg8::cvt_pk_bf16(lo, hi); }
__device__ __forceinline__ float bf2f(unsigned short h) { return __uint_as_float(((unsigned)h) << 16); }

namespace att {
constexpr int KSTR = 144;
constexpr int KBUFB = 64 * KSTR, STAGEB = KBUFB + 128 * KSTR;
constexpr int FLAG_OFF = 2 * STAGEB;
constexpr float THR = -48.0f;
__device__ __forceinline__ int crow(int r, int hi) { return (r & 3) + 8 * (r >> 2) + 4 * hi; }
typedef __bf16 bf16x2_t __attribute__((ext_vector_type(2)));
__device__ __forceinline__ unsigned cvtpk_c(float lo, float hi) { const f32x2 v = {lo, hi}; const bf16x2_t b = __builtin_convertvector(v, bf16x2_t); return __builtin_bit_cast(unsigned, b); }
__device__ __forceinline__ bf16x8 pack8(const f32x16& p, int b) {
    u32x4 w; w.x = cvtpk_c(p[b], p[b + 1]); w.y = cvtpk_c(p[b + 2], p[b + 3]); w.z = cvtpk_c(p[b + 4], p[b + 5]); w.w = cvtpk_c(p[b + 6], p[b + 7]);
    return __builtin_bit_cast(bf16x8, w);
}
#define MFMA32(a, b, c) __builtin_amdgcn_mfma_f32_32x32x16_bf16((a), (b), (c), 0, 0, 0)
__device__ __forceinline__ float max3f(float a, float b, float c) { float r; asm("v_max3_f32 %0, %1, %2, %3" : "=v"(r) : "v"(a), "v"(b), "v"(c)); return r; }
__device__ __forceinline__ float xhalf_max(float m) { auto rr = __builtin_amdgcn_permlane32_swap(__float_as_uint(m), __float_as_uint(m), false, false); return fmaxf(__uint_as_float(rr[0]), __uint_as_float(rr[1])); }
__device__ __forceinline__ float xhalf_sum(float m) { auto rr = __builtin_amdgcn_permlane32_swap(__float_as_uint(m), __float_as_uint(m), false, false); return __uint_as_float(rr[0]) + __uint_as_float(rr[1]); }

template <int MODE, int DV>
__device__ __forceinline__ void attn_unit(LAS unsigned char* lds, const bf16* __restrict__ QK, int qcol, int kcol, const bf16* __restrict__ Vt,
                                          size_t rowbase, int qb, float slope2, float kinfa, float kinfb, float* __restrict__ Of, bf16* __restrict__ Ob, int ocol) {
    constexpr int NDB = DV / 32, NVC = DV / 64, NACC = NDB;
    int tid_l = threadIdx.x; asm volatile("" : "+v"(tid_l));
    const int tid = tid_l, lane = tid & 63, r32 = lane & 31, hi = lane >> 5;
    const int wid = __builtin_amdgcn_readfirstlane(tid >> 6);
    const int q0 = qb * 256, tw0 = q0 + 32 * wid, t = tw0 + r32;
    const int NT = 4 * qb + 4;
    bf16x8 qf[4];
    { const bf16* qp = QK + (rowbase + t) * 2048 + qcol + hi * 8;
#pragma unroll
      for (int ds = 0; ds < 4; ++ds) qf[ds] = *(const GAS bf16x8*)(qp + ds * 16); }
    float rowc = 0.f;
    if (MODE == 0) {
        float sa = 0.f, sb2 = 0.f;
#pragma unroll
        for (int ds = 0; ds < 4; ++ds) { const u32x4 w = __builtin_bit_cast(u32x4, qf[ds]);
            const float e0 = __uint_as_float(w.x << 16), e1 = __uint_as_float(w.x & 0xffff0000u), e2 = __uint_as_float(w.y << 16), e3 = __uint_as_float(w.y & 0xffff0000u);
            const float e4 = __uint_as_float(w.z << 16), e5 = __uint_as_float(w.z & 0xffff0000u), e6 = __uint_as_float(w.w << 16), e7 = __uint_as_float(w.w & 0xffff0000u);
            const float q2 = (e0 * e0 + e1 * e1) + (e2 * e2 + e3 * e3) + (e4 * e4 + e5 * e5) + (e6 * e6 + e7 * e7);
            if (ds < 2) sa += q2; else sb2 += q2; }
        sa = xhalf_sum(sa); sb2 = xhalf_sum(sb2);
        rowc = (sqrtf(sa * kinfa) + sqrtf(sb2 * kinfb)) * 1.02f;
    }
    const int krow = tid >> 3, kch = tid & 7;
    const bf16* ksrc = QK + (rowbase + krow) * 2048 + kcol + kch * 8;
    const unsigned kdst = krow * KSTR + kch * 16;
    const bf16* vsrc = Vt + (size_t)krow * SEQ + kch * 8;
    const unsigned vdst = KBUFB + krow * KSTR + kch * 16;
    const unsigned koff = r32 * KSTR + hi * 16;
    LAS unsigned* flags = (LAS unsigned*)(lds + FLAG_OFF);

    f32x16 o[NACC];
#pragma unroll
    for (int d = 0; d < NACC; ++d)
#pragma unroll
        for (int r = 0; r < 16; ++r) o[d][r] = 0.f;
    float mrun = 0.f, carry = 0.f, lrun = 0.f;
    bool wdone = false, first = true;
    bf16x8 ut0, ut1, uone;
    { const u32x4 c = {0x3F803F80u, 0x3F803F80u, 0x3F803F80u, 0x3F803F80u}; uone = __builtin_bit_cast(bf16x8, c); }
    if (MODE == 1) {
        u32x4 a, b;
        unsigned e0[8], e1[8];
#pragma unroll
        for (int j = 0; j < 8; ++j) { const int jj = 8 * (j >> 2) + 4 * hi + (j & 3); e0[j] = (jj > r32) ? 0x3F80u : 0u; e1[j] = (16 + jj > r32) ? 0x3F80u : 0u; }
        a.x = e0[0] | (e0[1] << 16); a.y = e0[2] | (e0[3] << 16); a.z = e0[4] | (e0[5] << 16); a.w = e0[6] | (e0[7] << 16);
        b.x = e1[0] | (e1[1] << 16); b.y = e1[2] | (e1[3] << 16); b.z = e1[4] | (e1[5] << 16); b.w = e1[6] | (e1[7] << 16);
        ut0 = __builtin_bit_cast(bf16x8, a); ut1 = __builtin_bit_cast(bf16x8, b);
    }
    u32x4 kreg[2], vreg[2][NVC];
#define ATT_LOAD(set_, kt_) do { kreg[set_] = *(const GAS u32x4*)(ksrc + (size_t)(kt_) * 64 * 2048); \
        _Pragma("unroll") for (int i_ = 0; i_ < NVC; ++i_) vreg[set_][i_] = *(const GAS u32x4*)(vsrc + (size_t)i_ * 64 * SEQ + (kt_) * 64); } while (0)
#define ATT_STORE(set_, stg_) do { *(LAS u32x4*)(lds + (stg_) * STAGEB + kdst) = kreg[set_]; \
        _Pragma("unroll") for (int i_ = 0; i_ < NVC; ++i_) *(LAS u32x4*)(lds + (stg_) * STAGEB + vdst + i_ * 64 * KSTR) = vreg[set_][i_]; } while (0)
    ATT_LOAD(0, NT - 1); ATT_LOAD(1, (NT - 2 > 0) ? NT - 2 : 0); ATT_STORE(0, 0);
    __syncthreads();
    int kt = NT - 1; bool fin = false;
    for (;;) {
#pragma unroll
      for (int hh = 0; hh < 2; ++hh) {
        const bool hasn = (kt > 0);
        ATT_LOAD(hh, (kt - 2 > 0) ? kt - 2 : 0);
        const int k0 = kt * 64;
        const LAS unsigned char* sb = lds + hh * STAGEB;
        const bool active = ((MODE == 0) ? (k0 <= tw0 + 31) : (k0 < tw0 + 31)) && !wdone;
        if (active) {
            f32x16 p0, p1;
            if (MODE == 0) {
                const float bb = slope2 * (float)(k0 + 4 * hi - t) - mrun;
#pragma unroll
                for (int r = 0; r < 16; ++r) { const float c = __builtin_fmaf(slope2, (float)((r & 3) + 8 * (r >> 2)), bb); p0[r] = c; p1[r] = __builtin_fmaf(slope2, 32.0f, c); }
            } else {
#pragma unroll
                for (int r = 0; r < 16; ++r) { p0[r] = 0.f; p1[r] = 0.f; }
            }
#pragma unroll
            for (int ds = 0; ds < 4; ++ds) {
                const bf16x8 k0f = *(const LAS bf16x8*)(sb + koff + ds * 32);
                const bf16x8 k1f = *(const LAS bf16x8*)(sb + koff + 32 * KSTR + ds * 32);
                p0 = MFMA32(k0f, qf[ds], p0); p1 = MFMA32(k1f, qf[ds], p1);
            }
            const bool diag = (MODE == 0) ? (k0 + 63 > tw0) : (k0 + 63 >= tw0);
            bf16x8 pf0, pf1, pf2, pf3;
            if (MODE == 0) {
                if (diag) {
#pragma unroll
                    for (int r = 0; r < 16; ++r) { const int key = k0 + crow(r, hi); if (key > t) p0[r] = -INFINITY; if (key + 32 > t) p1[r] = -INFINITY; }
                }
                float mx;
                { float a0 = max3f(p0[0], p0[1], p0[2]), a1 = max3f(p0[3], p0[4], p0[5]), a2 = max3f(p0[6], p0[7], p0[8]), a3 = max3f(p0[9], p0[10], p0[11]);
                  float a4 = max3f(p0[12], p0[13], p0[14]), a5 = max3f(p0[15], p1[0], p1[1]), a6 = max3f(p1[2], p1[3], p1[4]), a7 = max3f(p1[5], p1[6], p1[7]);
                  float a8 = max3f(p1[8], p1[9], p1[10]), a9 = max3f(p1[11], p1[12], p1[13]), a10 = max3f(p1[14], p1[15], a0);
                  a1 = max3f(a1, a2, a3); a4 = max3f(a4, a5, a6); a7 = max3f(a7, a8, a9);
                  mx = xhalf_max(max3f(max3f(a1, a4, a7), a10, a10)); }
                if (first || __any(mx > 6.0f)) {
                    const float dl = first ? mx : fmaxf(mx, 0.f);
#pragma unroll
                    for (int r = 0; r < 16; ++r) { p0[r] -= dl; p1[r] -= dl; }
                    mrun += dl;
                    if (!first) { const float alpha = __builtin_amdgcn_exp2f(-dl); lrun *= alpha;
#pragma unroll
                        for (int d = 0; d < NACC; ++d)
#pragma unroll
                            for (int r = 0; r < 16; ++r) o[d][r] *= alpha; }
                    first = false;
                }
#pragma unroll
                for (int r = 0; r < 16; ++r) { p0[r] = __builtin_amdgcn_exp2f(p0[r]); p1[r] = __builtin_amdgcn_exp2f(p1[r]); }
                { float s0 = p0[0] + p1[0], s1 = p0[1] + p1[1], s2 = p0[2] + p1[2], s3 = p0[3] + p1[3];
#pragma unroll
                  for (int r = 4; r < 16; r += 4) { s0 += p0[r] + p1[r]; s1 += p0[r + 1] + p1[r + 1]; s2 += p0[r + 2] + p1[r + 2]; s3 += p0[r + 3] + p1[r + 3]; }
                  lrun += (s0 + s1) + (s2 + s3); }
                pf0 = pack8(p0, 0); pf1 = pack8(p0, 8); pf2 = pack8(p1, 0); pf3 = pack8(p1, 8);
                wdone = __all(rowc - slope2 * (float)(t - k0 + 1) < mrun - 32.0f) != 0;
            } else {
                float ts = 0.f;
                f32x16 l0, l1;
#pragma unroll
                for (int r = 0; r < 16; ++r) {
                    { const float z = p0[r]; const float e = __builtin_amdgcn_exp2f(-fabsf(z)); const float sp = fmaxf(-z, 0.f) + __builtin_amdgcn_logf(1.0f + e);
                      const float lb = -sp; float lm = lb - z; if (diag && !(k0 + crow(r, hi) < t)) lm = 0.f; l0[r] = lm; ts += lm; p0[r] = lb + carry; }
                    { const float z = p1[r]; const float e = __builtin_amdgcn_exp2f(-fabsf(z)); const float sp = fmaxf(-z, 0.f) + __builtin_amdgcn_logf(1.0f + e);
                      const float lb = -sp; float lm = lb - z; if (diag && !(k0 + 32 + crow(r, hi) < t)) lm = 0.f; l1[r] = lm; ts += lm; p1[r] = lb + carry; }
                }
                const bf16x8 L0a = pack8(l0, 0), L0b = pack8(l0, 8), L1a = pack8(l1, 0), L1b = pack8(l1, 8);
                p0 = MFMA32(ut0, L0a, p0); p0 = MFMA32(ut1, L0b, p0); p0 = MFMA32(uone, L1a, p0); p0 = MFMA32(uone, L1b, p0);
                p1 = MFMA32(ut0, L1a, p1); p1 = MFMA32(ut1, L1b, p1);
#pragma unroll
                for (int r = 0; r < 16; ++r) {
                    float a0 = __builtin_amdgcn_exp2f(p0[r]), a1 = __builtin_amdgcn_exp2f(p1[r]);
                    if (diag) { if (!(k0 + crow(r, hi) < t)) a0 = 0.f; if (!(k0 + 32 + crow(r, hi) < t)) a1 = 0.f; }
                    p0[r] = a0; p1[r] = a1;
                }
                ts = xhalf_sum(ts);
                carry += ts;
                pf0 = pack8(p0, 0); pf1 = pack8(p0, 8); pf2 = pack8(p1, 0); pf3 = pack8(p1, 8);
                wdone = __all(carry < THR) != 0;
            }
#pragma unroll
            for (int d = 0; d < NDB; ++d) {
                const LAS unsigned char* vb = sb + KBUFB + d * 32 * KSTR + koff;
                const bf16x8 v0 = *(const LAS bf16x8*)(vb), v1 = *(const LAS bf16x8*)(vb + 32), v2 = *(const LAS bf16x8*)(vb + 64), v3 = *(const LAS bf16x8*)(vb + 96);
                o[d] = MFMA32(v0, pf0, o[d]); o[d] = MFMA32(v1, pf1, o[d]); o[d] = MFMA32(v2, pf2, o[d]); o[d] = MFMA32(v3, pf3, o[d]);
            }
        }
        if (hasn) ATT_STORE(hh ^ 1, hh ^ 1);
        if (lane == 0) flags[hh * 8 + wid] = wdone ? 1u : 0u;
        __syncthreads();
        if (!hasn) { fin = true; break; }
        { const unsigned f = flags[hh * 8 + (lane & 7)]; if (__all(f != 0u)) { fin = true; break; } }
        --kt;
      }
      if (fin) break;
    }
#undef ATT_LOAD
#undef ATT_STORE
    if (MODE == 0) {
        const float inv = 1.0f / xhalf_sum(lrun);
        bf16* op = (bf16*)Of + (rowbase + t) * 1024 + ocol + 4 * hi;
#pragma unroll
        for (int d = 0; d < NDB; ++d)
#pragma unroll
            for (int g = 0; g < 4; ++g) { u32x2 w; w.x = pk_bf16(o[d][4 * g] * inv, o[d][4 * g + 1] * inv); w.y = pk_bf16(o[d][4 * g + 2] * inv, o[d][4 * g + 3] * inv); *(GAS u32x2*)(op + 32 * d + 8 * g) = w; }
    } else {
        bf16* op = Ob + (rowbase + t) * 512 + ocol + 4 * hi;
#pragma unroll
        for (int d = 0; d < NDB; ++d)
#pragma unroll
            for (int g = 0; g < 4; ++g) { u32x2 w; w.x = pk_bf16(o[d][4 * g], o[d][4 * g + 1]); w.y = pk_bf16(o[d][4 * g + 2], o[d][4 * g + 3]); *(GAS u32x2*)(op + 32 * d + 8 * g) = w; }
    }
}
#undef MFMA32
}

#define XB_TMO      128
#define XB_XCNT(j)  (256  + 64 * (j))
#define XB_XSUB(j)  (1280 + 64 * (j))
#define XB_XGEN(j)  (2304 + 64 * (j))
#define XB_TOP      3328
#define XB_TOPGEN   3392
#define XCD_BAR_WORDS 3456
#define XB_SPIN_CAP (1u << 18)

__device__ __forceinline__ unsigned xb_ld(unsigned* p)              { return __hip_atomic_load(p, __ATOMIC_RELAXED, __HIP_MEMORY_SCOPE_AGENT); }
__device__ __forceinline__ unsigned xb_add(unsigned* p, unsigned v) { return __hip_atomic_fetch_add(p, v, __ATOMIC_RELAXED, __HIP_MEMORY_SCOPE_AGENT); }
__device__ __forceinline__ unsigned xb_xcc_id() { return (unsigned)__builtin_amdgcn_s_getreg((3 << 11) | 20) & 0xFu; }
#define XB_SPIN(cond, bar) do { unsigned _sp = 0; while (cond) { __builtin_amdgcn_s_sleep(1); \
    if ((++_sp & 255u) == 0u) { if (xb_ld(&(bar)[XB_TMO])) break; if (_sp > XB_SPIN_CAP) { atomicAdd(&(bar)[XB_TMO], 1u); break; } } } } while (0)

struct XcdBarrier {
    unsigned* bar; unsigned x;
    volatile LAS unsigned* st;
};

__device__ __forceinline__ XcdBarrier xcd_barrier_post(unsigned* bar, volatile LAS unsigned* st) {
    XcdBarrier b; b.bar = bar; b.x = xb_xcc_id(); b.st = st;
    if (threadIdx.x == 0) (void)xb_add(&bar[XB_XCNT(b.x)], 1u);
    return b;
}
__device__ __forceinline__ void xcd_barrier_complete(unsigned* bar, unsigned x, unsigned& nloc, unsigned& nx) {
    const unsigned G = gridDim.x * gridDim.y * gridDim.z;
    unsigned sum, cnt, mine, sp = 0u;
    for (;;) {
        sum = 0u; cnt = 0u; mine = 0u;
#pragma unroll
        for (unsigned j = 0; j < 16; ++j) { const unsigned c = xb_ld(&bar[XB_XCNT(j)]); sum += c; cnt += (c > 0u) ? 1u : 0u; mine = (j == x) ? c : mine; }
        if (sum == G) break;
        __builtin_amdgcn_s_sleep(1);
        if ((++sp & 255u) == 0u) { if (xb_ld(&bar[XB_TMO])) break; if (sp > XB_SPIN_CAP) { atomicAdd(&bar[XB_TMO], 1u); break; } }
    }
    nloc = mine > 0u ? mine : 1u; nx = cnt > 0u ? cnt : 1u;
}

__device__ __forceinline__ void xcd_barrier(const XcdBarrier& b) {
    asm volatile("s_waitcnt vmcnt(0)" ::: "memory");
    __syncthreads();
    if (threadIdx.x == 0) {
        unsigned* bar = b.bar;
        __builtin_amdgcn_s_waitcnt(0);
        unsigned nloc = b.st[0], nx = b.st[1];
        if (nloc == 0u) { xcd_barrier_complete(bar, b.x, nloc, nx); b.st[0] = nloc; b.st[1] = nx; }
        const unsigned old = xb_add(&bar[XB_XSUB(b.x)], 1u);
        const unsigned gen = old / nloc;
        if (old + 1u == (gen + 1u) * nloc) {
            __builtin_amdgcn_fence(__ATOMIC_RELEASE, "agent");
            asm volatile("s_waitcnt vmcnt(0)" ::: "memory");
            const unsigned og = xb_add(&bar[XB_TOP], 1u);
            const unsigned tg = og / nx;
            if (og + 1u == (tg + 1u) * nx) xb_add(&bar[XB_TOPGEN], 1u);
            else XB_SPIN(xb_ld(&bar[XB_TOPGEN]) == tg, bar);
            __builtin_amdgcn_fence(__ATOMIC_ACQUIRE, "agent");
            xb_add(&bar[XB_XGEN(b.x)], 1u);
            asm volatile("s_waitcnt vmcnt(0)" ::: "memory");
        } else {
            XB_SPIN(xb_ld(&bar[XB_XGEN(b.x)]) == gen, bar);
            __builtin_amdgcn_fence(__ATOMIC_ACQUIRE, "agent");
            asm volatile("s_waitcnt vmcnt(0)" ::: "memory");
        }
    }
    __syncthreads();
}

#ifndef WGM_GU
#define WGM_GU 4
#endif
#ifndef WGM_N1K
#define WGM_N1K 4
#endif
#ifndef WGM_IN
#define WGM_IN 4
#endif
#ifndef PHASE_MASK
#define PHASE_MASK 0xFFFF
#endif
#define PH(n) (((PHASE_MASK) >> (n)) & 1)
#ifndef DUP_MASK
#define DUP_MASK 0
#endif
#ifndef ATT_DUP
#define ATT_DUP 0
#endif
#define REP(n) for (int rep_ = 0; rep_ < 1 + (((DUP_MASK) >> (n)) & 1); ++rep_)
#ifndef ATT_PASS_MASK
#define ATT_PASS_MASK 3
#endif
struct Args { const float* in[24]; float* out; unsigned char* ws; };

__device__ __forceinline__ void transpose_item(const float* __restrict__ W, int K, int N, bf16* __restrict__ WT, int mode, LAS float* scr, int item, int lane) {
    const int nblk = N / 32, kb = item / nblk, nb = item % nblk, k0 = 64 * kb, n0 = 32 * nb;
#pragma unroll
    for (int i = 0; i < 8; ++i) { const int kk = 8 * i + (lane >> 3), nq = 4 * (lane & 7);
        const f32x4 v = __builtin_nontemporal_load((const GAS f32x4*)(W + (size_t)(k0 + kk) * N + n0 + nq)); LAS float* d = scr + kk * 33 + nq; d[0] = v.x; d[1] = v.y; d[2] = v.z; d[3] = v.w; }
    asm volatile("s_waitcnt lgkmcnt(0)" ::: "memory");
    const int c = lane & 7;
#pragma unroll
    for (int j = 0; j < 4; ++j) { const int n = (lane >> 3) + 8 * j; const LAS float* s = scr + (8 * c) * 33 + n;
        u32x4 o; o.x = pk_bf16(s[0 * 33], s[1 * 33]); o.y = pk_bf16(s[2 * 33], s[3 * 33]); o.z = pk_bf16(s[4 * 33], s[5 * 33]); o.w = pk_bf16(s[6 * 33], s[7 * 33]);
        const int ng = n0 + n; const int nr = (mode == 0) ? ng : (256 * (ng >> 7) + (ng & 127) + (mode == 2 ? 128 : 0));
        *(GAS u32x4*)(WT + (size_t)nr * K + k0 + 8 * c) = o; }
    asm volatile("s_waitcnt lgkmcnt(0)" ::: "memory");
}

template <bool HAS_F, bool HAS_H, bool XIN_B = false, bool XOUT_B = false>
__device__ __forceinline__ void rowpass(const void* xin_, const bf16* __restrict__ Fb, void* xout_, bf16* __restrict__ H,
                                        const float* __restrict__ gpost, const float* __restrict__ modp, int gi  , float resw,
                                        const float* __restrict__ gpre, int sci, int shi, int gw, int lane) {
    constexpr int RPW = M / 2048;
    const int row_lo = gw * RPW; const int b = row_lo / SEQ;
    const float* mb = modp + (size_t)b * (NMOD * DM);
    f32x4 Cg[4], A[4], Sh[4];
#pragma unroll
    for (int j = 0; j < 4; ++j) { const int col = 256 * j + 4 * lane;
        if (HAS_F) { const f32x4 g = *(const GAS f32x4*)(mb + gi * DM + col), gp = *(const GAS f32x4*)(gpost + col); Cg[j] = g * gp * resw; }
        if (HAS_H) { const f32x4 s = *(const GAS f32x4*)(mb + sci * DM + col), gp = *(const GAS f32x4*)(gpre + col); A[j] = gp * (s + 1.0f); Sh[j] = *(const GAS f32x4*)(mb + shi * DM + col); } }
    const float* xin = (const float*)xin_; const bf16* xinb = (const bf16*)xin_; float* xout = (float*)xout_; bf16* xoutb = (bf16*)xout_;
#define RP_LDX(dst, r, j) do { if (XIN_B) { const u32x2 w_ = __builtin_nontemporal_load((const GAS u32x2*)(xinb + (size_t)(r) * DM + 256 * (j) + 4 * lane)); \
        dst = (f32x4){__uint_as_float(w_.x << 16), __uint_as_float(w_.x & 0xffff0000u), __uint_as_float(w_.y << 16), __uint_as_float(w_.y & 0xffff0000u)}; } \
      else dst = __builtin_nontemporal_load((const GAS f32x4*)(xin + (size_t)(r) * DM + 256 * (j) + 4 * lane)); } while (0)
    f32x4 xn[4]; u32x2 fn[4];
#pragma unroll
    for (int j = 0; j < 4; ++j) { RP_LDX(xn[j], row_lo, j); if (HAS_F) fn[j] = __builtin_nontemporal_load((const GAS u32x2*)(Fb + (size_t)row_lo * DM + 256 * j + 4 * lane)); }
    for (int row = row_lo; row < row_lo + RPW; ++row) {
        f32x4 x[4]; u32x2 fwv[4];
#pragma unroll
        for (int j = 0; j < 4; ++j) { x[j] = xn[j]; if (HAS_F) fwv[j] = fn[j]; }
        { const int rn = (row + 1 < row_lo + RPW) ? row + 1 : row;
#pragma unroll
          for (int j = 0; j < 4; ++j) { RP_LDX(xn[j], rn, j); if (HAS_F) fn[j] = __builtin_nontemporal_load((const GAS u32x2*)(Fb + (size_t)rn * DM + 256 * j + 4 * lane)); } }
        if (HAS_F) {
            f32x4 f[4]; float ss = 0.f;
#pragma unroll
            for (int j = 0; j < 4; ++j) { const u32x2 fw = fwv[j];
                f[j] = (f32x4){__uint_as_float(fw.x << 16), __uint_as_float(fw.x & 0xffff0000u), __uint_as_float(fw.y << 16), __uint_as_float(fw.y & 0xffff0000u)}; ss += (f[j].x * f[j].x + f[j].y * f[j].y) + (f[j].z * f[j].z + f[j].w * f[j].w); }
            const float rstd = 1.0f / sqrtf(wave_sum(ss) * (1.0f / DM) + RMS_EPS);
#pragma unroll
            for (int j = 0; j < 4; ++j) { x[j] = x[j] + f[j] * rstd * Cg[j];
                if (XOUT_B) { u32x2 w; w.x = pk_bf16(x[j].x, x[j].y); w.y = pk_bf16(x[j].z, x[j].w); *(GAS u32x2*)(xoutb + (size_t)row * DM + 256 * j + 4 * lane) = w;
                    x[j] = (f32x4){__uint_as_float(w.x << 16), __uint_as_float(w.x & 0xffff0000u), __uint_as_float(w.y << 16), __uint_as_float(w.y & 0xffff0000u)}; }
                else __builtin_nontemporal_store(x[j], (GAS f32x4*)(xout + (size_t)row * DM + 256 * j + 4 * lane)); }
        }
        if (HAS_H) {
            float ss = 0.f;
#pragma unroll
            for (int j = 0; j < 4; ++j) ss += (x[j].x * x[j].x + x[j].y * x[j].y) + (x[j].z * x[j].z + x[j].w * x[j].w);
            const float rstd = 1.0f / sqrtf(wave_sum(ss) * (1.0f / DM) + RMS_EPS);
#pragma unroll
            for (int j = 0; j < 4; ++j) { const f32x4 h = x[j] * rstd * A[j] + Sh[j]; u32x2 w; w.x = pk_bf16(h.x, h.y); w.y = pk_bf16(h.z, h.w);
                *(GAS u32x2*)(H + (size_t)row * DM + 256 * j + 4 * lane) = w; }
        }
    }
}
#undef RP_LDX

__device__ __forceinline__ void rowpass_attn(const float* __restrict__ Od, const bf16* __restrict__ Os, bf16* __restrict__ H, const float* __restrict__ subln,
                                             const float* __restrict__ sbeta, float lam, int gw, int lane) {
    constexpr int RPW = M / 2048;
    const int hd = lane >> 4, e0 = 8 * (lane & 15);
    const f32x4 sl0 = *(const GAS f32x4*)(subln + e0), sl1 = *(const GAS f32x4*)(subln + e0 + 4);
    const f32x4 be0 = *(const GAS f32x4*)(sbeta + 8 * lane), be1 = *(const GAS f32x4*)(sbeta + 8 * lane + 4);
#define RA_UNPK(W_, V_) do { V_[0] = __uint_as_float(W_.x << 16); V_[1] = __uint_as_float(W_.x & 0xffff0000u); V_[2] = __uint_as_float(W_.y << 16); V_[3] = __uint_as_float(W_.y & 0xffff0000u); \
        V_[4] = __uint_as_float(W_.z << 16); V_[5] = __uint_as_float(W_.z & 0xffff0000u); V_[6] = __uint_as_float(W_.w << 16); V_[7] = __uint_as_float(W_.w & 0xffff0000u); } while (0)
    const int row_lo = gw * RPW;
    u32x4 n0 = __builtin_nontemporal_load((const GAS u32x4*)((const bf16*)Od + (size_t)row_lo * 1024 + hd * 256 + e0)), n1 = __builtin_nontemporal_load((const GAS u32x4*)((const bf16*)Od + (size_t)row_lo * 1024 + hd * 256 + 128 + e0));
    u32x4 ns = __builtin_nontemporal_load((const GAS u32x4*)(Os + (size_t)row_lo * 512 + 8 * lane));
    for (int row = row_lo; row < row_lo + RPW; ++row) {
        const u32x4 w0 = n0, w1 = n1, ws = ns;
        { const int rn = (row + 1 < row_lo + RPW) ? row + 1 : row;
          n0 = __builtin_nontemporal_load((const GAS u32x4*)((const bf16*)Od + (size_t)rn * 1024 + hd * 256 + e0)); n1 = __builtin_nontemporal_load((const GAS u32x4*)((const bf16*)Od + (size_t)rn * 1024 + hd * 256 + 128 + e0));
          ns = __builtin_nontemporal_load((const GAS u32x4*)(Os + (size_t)rn * 512 + 8 * lane)); }
        float a0[8], a1[8], v[8], sv[8];
        RA_UNPK(w0, a0); RA_UNPK(w1, a1); RA_UNPK(ws, sv);
        float ss = 0.f, s2 = 0.f;
#pragma unroll
        for (int i = 0; i < 8; ++i) { v[i] = a0[i] - a1[i] * lam; ss += v[i] * v[i]; s2 += sv[i] * sv[i]; }
        ss = row16_sum(ss);
        const float rstd = 0.8f / sqrtf(ss * (1.0f / 128.0f) + RMS_EPS);
        u32x4 od; od.x = pk_bf16(v[0] * rstd * sl0.x, v[1] * rstd * sl0.y); od.y = pk_bf16(v[2] * rstd * sl0.z, v[3] * rstd * sl0.w);
        od.z = pk_bf16(v[4] * rstd * sl1.x, v[5] * rstd * sl1.y); od.w = pk_bf16(v[6] * rstd * sl1.z, v[7] * rstd * sl1.w);
        *(GAS u32x4*)(H + (size_t)row * 1024 + hd * 128 + e0) = od;
        const float rstd2 = 1.0f / sqrtf(wave_sum(s2) * (1.0f / 512.0f) + RMS_EPS);
        u32x4 o; o.x = pk_bf16(sv[0] * rstd2 * be0.x, sv[1] * rstd2 * be0.y); o.y = pk_bf16(sv[2] * rstd2 * be0.z, sv[3] * rstd2 * be0.w);
        o.z = pk_bf16(sv[4] * rstd2 * be1.x, sv[5] * rstd2 * be1.y); o.w = pk_bf16(sv[6] * rstd2 * be1.z, sv[7] * rstd2 * be1.w);
        *(GAS u32x4*)(H + (size_t)row * 1024 + 512 + 8 * lane) = o;
    }
#undef RA_UNPK
}

#define KAS __attribute__((address_space(4)))
__device__ __forceinline__ const float* karg(int i) { const KAS char* ka = (const KAS char*)__builtin_amdgcn_kernarg_segment_ptr(); return (const float*)(*(const volatile KAS unsigned long long*)(ka + 8 * i)); }
#define AIN(i) karg(i)
__device__ __forceinline__ int fresh_tid() { int t = threadIdx.x; asm volatile("" : "+v"(t)); return t; }
__global__ void __launch_bounds__(512) fwd_megakernel(Args args) {
    extern __shared__ __attribute__((aligned(16))) unsigned char lds_raw[];
    cg::grid_group grid = cg::this_grid();
    LAS unsigned char* lds = (LAS unsigned char*)lds_raw;
    const int wave = __builtin_amdgcn_readfirstlane((int)threadIdx.x >> 6);
#define tid (fresh_tid())
#define lane (fresh_tid() & 63)
    const int G = gridDim.x, bx = blockIdx.x;
    const int vcu = (G % 8 == 0) ? (bx % 8) * (G / 8) + bx / 8 : bx;
    const int gw = vcu * 8 + wave, NGW = G * 8;
    unsigned* ctlw = (unsigned*)((unsigned char*)karg(25) + WS_CTLW);
    volatile LAS unsigned* MISC = (volatile LAS unsigned*)(lds + GEMM_LDS);
    if (tid < 64) MISC[tid] = 0u;
    __syncthreads();
    XcdBarrier bar = xcd_barrier_post(ctlw, MISC + 8);
#define WSP(off) ((unsigned char*)karg(25) + (off))
#define ctl ((float*)WSP(WS_CTL))
#define modp (((float*)WSP(WS_CTL)) + 1024)
#define out ((float*)karg(24))
#define Wgu1 ((bf16*)WSP(WS_WGU1))
#define Wd1 ((bf16*)WSP(WS_WD1))
#define Win ((bf16*)WSP(WS_WIN))
#define Wout ((bf16*)WSP(WS_WOUT))
#define Wgu2 ((bf16*)WSP(WS_WGU2))
#define Wd2 ((bf16*)WSP(WS_WD2))
#define H ((bf16*)WSP(WS_H))
#define F ((float*)WSP(WS_F))
#define ACT ((bf16*)WSP(WS_ACT))
#define QK ((bf16*)WSP(WS_ACT))
#define VtD ((bf16*)WSP(WS_VTD))
#define VtS ((bf16*)WSP(WS_VTS))
#define Osb ((bf16*)WSP(WS_OSB))
#define XB ((bf16*)WSP(WS_XB))
    if (PH(0)) REP(0) {
        if (bx < 144) {
            LAS float* sc = (LAS float*)lds;
            LAS float* red = sc + 4096;
            const float* c = AIN(1);
            for (int i = tid; i < 4096; i += 512) { const float v = c[i]; sc[i] = v / (1.0f + __expf(-v)); }
            __syncthreads();
            const int col = bx * 64 + (tid & 63), kg = tid >> 6;
            const float* wp = AIN(2) + (size_t)(kg * 128) * (NMOD * DM) + col;
            float a0 = 0.f, a1 = 0.f, a2 = 0.f, a3 = 0.f;
#pragma unroll 8
            for (int k = 0; k < 128; ++k) { const float w = __builtin_nontemporal_load((const GAS float*)wp + (size_t)k * (NMOD * DM)); const int kk = kg * 128 + k;
                a0 += sc[kk] * w; a1 += sc[1024 + kk] * w; a2 += sc[2048 + kk] * w; a3 += sc[3072 + kk] * w; }
            red[(kg * 4 + 0) * 64 + (tid & 63)] = a0; red[(kg * 4 + 1) * 64 + (tid & 63)] = a1; red[(kg * 4 + 2) * 64 + (tid & 63)] = a2; red[(kg * 4 + 3) * 64 + (tid & 63)] = a3;
            __syncthreads();
            if (tid < 256) { const int b = tid >> 6, cc = tid & 63; float s = 0.f;
#pragma unroll
                for (int g = 0; g < 8; ++g) s += red[(g * 4 + b) * 64 + cc];
                modp[(size_t)b * (NMOD * DM) + bx * 64 + cc] = s + AIN(3)[bx * 64 + cc]; }
            __syncthreads();
        }
        if (bx == G - 1 && wave == 0) {
            const float s1 = wave_sum(AIN(13)[lane] * AIN(14)[lane]), s2 = wave_sum(AIN(15)[lane] * AIN(16)[lane]);
            if (lane == 0) ctl[0] = __expf(s1) - __expf(s2) + 0.2f;
        }
        LAS float* scr = (LAS float*)(lds + wave * 16384);
        constexpr int I_G = (DM / 64) * (DFF / 32), I_D = (DFF / 64) * (DM / 32), I_IN = (DM / 64) * (3 * DM / 32), I_OUT = (DM / 64) * (DM / 32);
        constexpr int NITEMS = 6 * I_G + I_IN + I_OUT;
        static_assert(I_G == I_D, "item counts");
        for (int itx = gw; itx < NITEMS; itx += NGW) {
            int r = itx;
            if (r < I_G) { transpose_item(AIN(6), DM, DFF, Wgu1, 1, scr, r, lane); continue; } r -= I_G;
            if (r < I_G) { transpose_item(AIN(7), DM, DFF, Wgu1, 2, scr, r, lane); continue; } r -= I_G;
            if (r < I_D) { transpose_item(AIN(8), DFF, DM, Wd1, 0, scr, r, lane); continue; } r -= I_D;
            if (r < I_G) { transpose_item(AIN(21), DM, DFF, Wgu2, 1, scr, r, lane); continue; } r -= I_G;
            if (r < I_G) { transpose_item(AIN(22), DM, DFF, Wgu2, 2, scr, r, lane); continue; } r -= I_G;
            if (r < I_D) { transpose_item(AIN(23), DFF, DM, Wd2, 0, scr, r, lane); continue; } r -= I_D;
            if (r < I_IN) { transpose_item(AIN(11), DM, 3 * DM, Win, 0, scr, r, lane); continue; } r -= I_IN;
            transpose_item(AIN(12), DM, DM, Wout, 0, scr, r, lane);
        }
    }
    if (G == 0x7ffffff0) grid.sync();
    xcd_barrier(bar);
#ifdef EXTRA_SYNCS
    for (int es = 0; es < EXTRA_SYNCS; ++es) xcd_barrier(bar);
#endif
    if (PH(1)) REP(1) rowpass<false, true>(AIN(0), nullptr, nullptr, H, nullptr, modp, 0, 0.f, AIN(4), 1, 0, gw, lane);
    xcd_barrier(bar);
    if (PH(2)) REP(2) { pg8::Gemm g{H, Wgu1, M, 2 * DFF, DM}; pg8::StaticOrder S; S.init(M, 2 * DFF, G, bx, WGM_GU); pg8::EpiSwiglu E{ACT, DFF};
      pg8::gemm_phase<pg8::EpiSwiglu, pg8::StaticOrder, true, true>(lds, g, S, E); }
    xcd_barrier(bar);
    if (PH(3)) REP(3) { pg8::Gemm g{ACT, Wd1, M, DM, DFF}; pg8::StaticOrder S; S.init(M, DM, G, bx, WGM_N1K); pg8::EpiBf16Out E{(bf16*)F, DM};
      pg8::gemm_phase<pg8::EpiBf16Out, pg8::StaticOrder, true, true>(lds, g, S, E); }
    xcd_barrier(bar);
    if (PH(4)) REP(4) rowpass<true, true, false, true>(AIN(0), (const bf16*)F, XB, H, AIN(5), modp, 2, 0.5f, AIN(9), 4, 3, gw, lane);
    xcd_barrier(bar);
    if (PH(5)) REP(5) { pg8::Gemm g{H, Win, M, 3 * DM, DM}; pg8::StaticOrder S; S.init(M, 3 * DM, G, bx, WGM_IN); pg8::EpiProj E{QK, VtD, VtS, C2, SEQ, ctlw + CW_KINF};
      pg8::gemm_phase<pg8::EpiProj, pg8::StaticOrder, true, true>(lds, g, S, E); }
    xcd_barrier(bar);
    if (PH(6)) {
        const unsigned* kinfw = ctlw + CW_KINF;
        LAS unsigned* uslot = (LAS unsigned*)(lds + att::FLAG_OFF + 128);
        const unsigned myx = xb_xcc_id() & 7u;
        for (int qi = 0; qi < 8; ++qi) {
            const unsigned xq = (myx + (unsigned)qi) & 7u;
            unsigned* qctr = ctlw + CW_QUEUE + 64 * xq;
            for (;;) {
                if (tid == 0) *uslot = atomicAdd(qctr, 1u);
                __syncthreads();
                const unsigned u = *uslot;
                __syncthreads();
                if (u >= 128u) break;
                const int h = 3 - (int)(u >> 5), qb = 31 - (int)(u & 31), b = (int)(xq >> 1), vh = 2 * h + (int)(xq & 1);
                const float slope2 = 1.4426950408889634f * exp2f(-2.0f * (float)(h + 1));
                const float kinfa = __uint_as_float(kinfw[(b * 8 + vh) * 2]), kinfb = __uint_as_float(kinfw[(b * 8 + vh) * 2 + 1]);
                att::attn_unit<0, 128>(lds, QK, vh * 64, 512 + vh * 64, VtD + ((size_t)(b * 512 + h * 128)) * SEQ, (size_t)b * SEQ, qb, slope2, kinfa, kinfb, F, nullptr, vh * 128);
            }
        }
        {
            unsigned* qctr = ctlw + CW_QUEUE + 64 * 8;
            for (;;) {
                if (tid == 0) *uslot = atomicAdd(qctr, 1u);
                __syncthreads();
                const unsigned u = *uslot;
                __syncthreads();
                if (u >= 1024u) break;
                const int v = (int)u, qb = 31 - (v >> 5), b = (v & 31) >> 3, h = v & 7;
                att::attn_unit<1, 64>(lds, QK, 1024 + h * 64, 1536 + h * 64, VtS + ((size_t)(b * 512 + h * 64)) * SEQ, (size_t)b * SEQ, qb, 0.f, 0.f, 0.f, nullptr, Osb, h * 64);
            }
        }
    }
    xcd_barrier(bar);
    if (PH(7)) REP(7) rowpass_attn(F, Osb, H, AIN(17), AIN(18), ctl[0], gw, lane);
    xcd_barrier(bar);
    if (PH(8)) REP(8) { pg8::Gemm g{H, Wout, M, DM, DM}; pg8::StaticOrder S; S.init(M, DM, G, bx, WGM_N1K); pg8::EpiBf16Out E{(bf16*)F, DM};
      pg8::gemm_phase<pg8::EpiBf16Out, pg8::StaticOrder, true, true>(lds, g, S, E); }
    xcd_barrier(bar);
    if (PH(9)) REP(9) rowpass<true, true, true, true>(XB, (const bf16*)F, XB, H, AIN(10), modp, 5, 1.0f, AIN(19), 7, 6, gw, lane);
    xcd_barrier(bar);
    if (PH(10)) REP(10) { pg8::Gemm g{H, Wgu2, M, 2 * DFF, DM}; pg8::StaticOrder S; S.init(M, 2 * DFF, G, bx, WGM_GU); pg8::EpiSwiglu E{ACT, DFF};
      pg8::gemm_phase<pg8::EpiSwiglu, pg8::StaticOrder, true, true>(lds, g, S, E); }
    xcd_barrier(bar);
    if (PH(11)) REP(11) { pg8::Gemm g{ACT, Wd2, M, DM, DFF}; pg8::StaticOrder S; S.init(M, DM, G, bx, WGM_N1K); pg8::EpiBf16Out E{(bf16*)F, DM};
      pg8::gemm_phase<pg8::EpiBf16Out, pg8::StaticOrder, true, true>(lds, g, S, E); }
    xcd_barrier(bar);
    if (PH(12)) REP(12) rowpass<true, false, true, false>(XB, (const bf16*)F, out, nullptr, AIN(20), modp, 8, 0.5f, nullptr, 0, 0, gw, lane);
}
#undef ctl
#undef modp
#undef out
#undef Wgu1
#undef Wd1
#undef Win
#undef Wout
#undef Wgu2
#undef Wd2
#undef H
#undef F
#undef ACT
#undef QK
#undef VtD
#undef VtS
#undef Osb
#undef XB

#undef tid
#undef lane
extern "C" void kernel_launch(void* const* d_in, const int* in_sizes, int n_in, void* d_out, int out_size, void* d_ws, size_t ws_size, hipStream_t stream) {
    static int grid = 0;
    if (grid == 0) {
        if (n_in != 24 || out_size != M * DM || ws_size < WS_END) { fprintf(stderr, "kernel_launch: unexpected shapes (n_in %d out %d ws %zu)\n", n_in, out_size, ws_size); grid = -1; return; }
        int dev = 0, cus = 0, per_cu = 0;
        hipGetDevice(&dev); hipDeviceGetAttribute(&cus, hipDeviceAttributeMultiprocessorCount, dev);
        if (hipFuncSetAttribute((const void*)fwd_megakernel, hipFuncAttributeMaxDynamicSharedMemorySize, LDS_BYTES) != hipSuccess) { fprintf(stderr, "kernel_launch: hipFuncSetAttribute failed\n"); grid = -1; return; }
        if (hipOccupancyMaxActiveBlocksPerMultiprocessor(&per_cu, (const void*)fwd_megakernel, 512, LDS_BYTES) != hipSuccess || per_cu < 1) { fprintf(stderr, "kernel_launch: occupancy query says %d blocks per CU\n", per_cu); per_cu = 1; }
        (void)hipGetLastError();
        if (cus < 256) { fprintf(stderr, "kernel_launch: built for a 256-CU device (got %d CUs)\n", cus); grid = -1; return; }
        grid = 256;
    }
    if (grid < 0) return;
    if (hipMemsetAsync((char*)d_ws + WS_CTLW, 0, CTLW_BYTES, stream) != hipSuccess) { fprintf(stderr, "kernel_launch: memset of the control words failed\n"); return; }
    Args a{};
    for (int i = 0; i < 24; ++i) a.in[i] = (const float*)d_in[i];
    a.out = (float*)d_out; a.ws = (unsigned char*)d_ws;
    void* kargs[] = {&a};
    hipError_t e = hipLaunchCooperativeKernel((const void*)fwd_megakernel, dim3(grid), dim3(512), kargs, LDS_BYTES, stream);
    if (e != hipSuccess) fprintf(stderr, "cooperative launch failed: %s (grid %d)\n", hipGetErrorString(e), grid);
}
```

```cpp
#include <hip/hip_runtime.h>
#include <hip/hip_cooperative_groups.h>
#include <cstdio>
#include <cstdint>
#include <cmath>
namespace cg = cooperative_groups;
namespace pg8 {
#define PG8_LAS __attribute__((address_space(3)))
typedef unsigned short bf16_t;
typedef short bf16x8 __attribute__((ext_vector_type(8)));
typedef float f32x4 __attribute__((ext_vector_type(4)));
typedef unsigned u32x4 __attribute__((ext_vector_type(4)));
constexpr int BM = 256, BK = 64, HALF = 128, HTB = HALF * BK * 2  , STAGE_BYTES = 8 * HTB, NXCD = 8, WGM = 8;

__host__ __device__ __forceinline__ int lds_byte(int r, int c) { const int st = (r >> 4) * 2 + (c >> 5), rr = r & 15, cc = c & 31, ob = rr * 64 + cc * 2; return st * 1024 + (ob ^ (((ob >> 9) & 1) << 5)); }
__host__ __device__ __forceinline__ void stage_rc(int b, int& R, int& C) { const int st = b / 1024, sb = b % 1024, swz = sb ^ (((sb >> 9) & 1) << 5); R = (st >> 1) * 16 + swz / 64; C = (st & 1) * 32 + (swz % 64) / 2; }
__host__ __device__ __forceinline__ int perm32(int rho) { const int n = rho >> 4, i = rho & 15; return 8 * (i >> 2) + 4 * n + (i & 3); }

struct Unit { int pm, pn; };
struct Gemm { const bf16_t* A; const bf16_t* Bt; int M, N, K; };

struct StaticOrder {
    int nM, nN, nwg, G, c, wgm, rev;
    __host__ __device__ void init(int M, int N, int G_, int c_, int wgm_ = WGM, int rev_ = 0) { nM = M / BM; nN = N / BM; nwg = nM * nN; G = G_; c = c_; wgm = wgm_; rev = rev_; }
    __host__ __device__ bool next(int i, Unit& u) const {
        const long L = (long)i * G + c; if (L >= nwg) return false;
        int wgid = (int)L; { const int q = nwg / NXCD, r = nwg % NXCD, xcd = wgid % NXCD, off = wgid / NXCD; wgid = (xcd < r ? xcd * (q + 1) : r * (q + 1) + (xcd - r) * q) + off; }
        if (rev) wgid = nwg - 1 - wgid;
        const int nig = wgm * nN, gid = wgid / nig, fm = gid * wgm, gsz = (nM - fm) < wgm ? (nM - fm) : wgm;
        u.pm = fm + ((wgid % nig) % gsz); u.pn = (wgid % nig) / gsz; return true;
    }
    __device__ __forceinline__ void a_ready(const Unit&) const {}
    __device__ __forceinline__ void done(const Unit&) const {}
};

__device__ __forceinline__ unsigned cvt_pk_bf16(float lo, float hi) { unsigned r; asm volatile("v_cvt_pk_bf16_f32 %0, %1, %2" : "=v"(r) : "v"(lo), "v"(hi)); return r; }
#define PG8_GAS __attribute__((address_space(1)))
__device__ __forceinline__ float silu_mul(float g, float u) { const float e = __builtin_amdgcn_exp2f(g * -1.4426950408889634f); return g * __builtin_amdgcn_rcpf(1.0f + e) * u; }
struct EpiSwiglu {
    static constexpr bool PERM = true, AFTER_DRAIN = false;
    bf16_t* O; int ldc;
    __device__ __forceinline__ void operator()(const f32x4 (&acc)[2][2][4][2], const Unit& u, int wr, int wc, int fr, int fq) const {
        const int row0 = u.pm * BM + wr * 64 + fr; const int col0 = u.pn * HALF + wc * 32 + 8 * fq;
#pragma unroll
        for (int ai = 0; ai < 2; ++ai)
#pragma unroll
            for (int m = 0; m < 4; ++m) { bf16_t* rowp = O + (size_t)(row0 + ai * HALF + m * 16) * ldc + col0;
                const f32x4 g0 = acc[ai][0][m][0], g1 = acc[ai][0][m][1], u0 = acc[ai][1][m][0], u1 = acc[ai][1][m][1];
                u32x4 w; w.x = cvt_pk_bf16(silu_mul(g0[0], u0[0]), silu_mul(g0[1], u0[1])); w.y = cvt_pk_bf16(silu_mul(g0[2], u0[2]), silu_mul(g0[3], u0[3]));
                w.z = cvt_pk_bf16(silu_mul(g1[0], u1[0]), silu_mul(g1[1], u1[1])); w.w = cvt_pk_bf16(silu_mul(g1[2], u1[2]), silu_mul(g1[3], u1[3]));
                *(PG8_GAS u32x4*)rowp = w; }
    }
};
struct EpiBf16Out {
    static constexpr bool PERM = true, AFTER_DRAIN = false;
    bf16_t* O; int ldc;
    __device__ __forceinline__ void operator()(const f32x4 (&acc)[2][2][4][2], const Unit& u, int wr, int wc, int fr, int fq) const {
        const int row0 = u.pm * BM + wr * 64 + fr; const int col0 = u.pn * BM + wc * 32 + 8 * fq;
#pragma unroll
        for (int ai = 0; ai < 2; ++ai)
#pragma unroll
            for (int m = 0; m < 4; ++m) { bf16_t* rowp = O + (size_t)(row0 + ai * HALF + m * 16) * ldc + col0;
#pragma unroll
                for (int bj = 0; bj < 2; ++bj) { const f32x4 v0 = acc[ai][bj][m][0], v1 = acc[ai][bj][m][1];
                    u32x4 w; w.x = cvt_pk_bf16(v0[0], v0[1]); w.y = cvt_pk_bf16(v0[2], v0[3]); w.z = cvt_pk_bf16(v1[0], v1[1]); w.w = cvt_pk_bf16(v1[2], v1[3]);
                    *(PG8_GAS u32x4*)(rowp + bj * HALF) = w; } }
    }
};
struct EpiProj {
    static constexpr bool PERM = true, AFTER_DRAIN = false;
    bf16_t* QK; bf16_t* VtD; bf16_t* VtS; float qscale; int S; unsigned* kinf;
    __device__ __forceinline__ void operator()(const f32x4 (&acc)[2][2][4][2], const Unit& u, int wr, int wc, int fr, int fq) const {
        const int seg = u.pn >> 1, half = u.pn & 1;
        if (seg == 2 || seg == 5) {
            bf16_t* Vt = (seg == 2) ? VtD : VtS;
            const int row_t = u.pm * BM; const int b = row_t / S, t0 = row_t - b * S;
#pragma unroll
            for (int ai = 0; ai < 2; ++ai)
#pragma unroll
                for (int m = 0; m < 4; ++m) { const int t = t0 + ai * HALF + wr * 64 + m * 16 + fr; const int pos = (t & ~12) | ((t & 4) << 1) | ((t & 8) >> 1);
#pragma unroll
                    for (int bj = 0; bj < 2; ++bj)
#pragma unroll
                        for (int n = 0; n < 2; ++n) { const int ch = 256 * half + 128 * bj + 32 * wc + 8 * fq + 4 * n;
                            const f32x4 v = acc[ai][bj][m][n]; const unsigned w0 = cvt_pk_bf16(v[0], v[1]), w1 = cvt_pk_bf16(v[2], v[3]);
                            const unsigned snd = (fr & 1) ? w0 : w1;
                            const unsigned rcv = (unsigned)__builtin_amdgcn_update_dpp(0, (int)snd, 0xB1, 0xF, 0xF, true);
                            const unsigned lo = (fr & 1) ? rcv : w0, hi2 = (fr & 1) ? w1 : rcv;
                            const unsigned s0 = (lo & 0xffffu) | (hi2 << 16), s1 = (lo >> 16) | (hi2 & 0xffff0000u);
                            PG8_GAS bf16_t* p = (PG8_GAS bf16_t*)(Vt + ((size_t)(b * 512 + ch + 2 * (fr & 1))) * S + (pos & ~1));
                            *(PG8_GAS unsigned*)p = s0; *(PG8_GAS unsigned*)(p + (size_t)S) = s1; } }
        } else {
            const int cbase = ((seg == 0) ? 0 : (seg == 1) ? 512 : (seg == 3) ? 1024 : 1536) + 256 * half + wc * 32 + 8 * fq;
            const float sc = (seg == 0 || seg == 3) ? qscale : 1.0f;
            const int row0 = u.pm * BM + wr * 64 + fr;
#pragma unroll
            for (int ai = 0; ai < 2; ++ai)
#pragma unroll
                for (int m = 0; m < 4; ++m) { bf16_t* rowp = QK + (size_t)(row0 + ai * HALF + m * 16) * 2048 + cbase;
#pragma unroll
                    for (int bj = 0; bj < 2; ++bj) { const f32x4 v0 = acc[ai][bj][m][0] * sc, v1 = acc[ai][bj][m][1] * sc;
                        u32x4 w; w.x = cvt_pk_bf16(v0[0], v0[1]); w.y = cvt_pk_bf16(v0[2], v0[3]); w.z = cvt_pk_bf16(v1[0], v1[1]); w.w = cvt_pk_bf16(v1[2], v1[3]);
                        *(PG8_GAS u32x4*)(rowp + bj * HALF) = w; } }
            if (seg == 1) {
                const int b = (u.pm * BM) / S;
#pragma unroll
                for (int bj = 0; bj < 2; ++bj) { float v = 0.f;
#pragma unroll
                    for (int ai = 0; ai < 2; ++ai)
#pragma unroll
                        for (int m = 0; m < 4; ++m) { const f32x4 x = acc[ai][bj][m][0], y = acc[ai][bj][m][1];
                            float s2 = (x[0] * x[0] + x[1] * x[1]) + (x[2] * x[2] + x[3] * x[3]) + (y[0] * y[0] + y[1] * y[1]) + (y[2] * y[2] + y[3] * y[3]);
                            s2 += __shfl_xor(s2, 16); s2 += __shfl_xor(s2, 32);
                            v = fmaxf(v, s2); }
#pragma unroll
                    for (int o = 1; o < 16; o <<= 1) v = fmaxf(v, __shfl_xor(v, o));
                    if (fr == 0 && fq == 0) atomicMax(kinf + (b * 8 + 4 * half + 2 * bj + (wc >> 1)) * 2 + (wc & 1), __float_as_uint(v)); }
            }
        }
    }
};

template <class Epi, class Sched, bool ALIGN_EPI = false, bool SP2 = false>
__device__ __forceinline__ void gemm_phase(PG8_LAS unsigned char* lds, const Gemm g, const Sched& S, const Epi& E) {
    int tid_l = threadIdx.x; asm volatile("" : "+v"(tid_l));
    const int tid = tid_l, wid = __builtin_amdgcn_readfirstlane(tid >> 6), lane = tid & 63, wr = wid >> 2, wc = wid & 3, fr = lane & 15, fq = lane >> 4;
    const int K = g.K, nt = K / BK;
    unsigned voffA[2], voffB[2];
#pragma unroll
    for (int i = 0; i < 2; ++i) { int R, C; stage_rc(tid * 16 + i * 8192, R, C); const int Rb = Epi::PERM ? ((R & ~31) + perm32(R & 31)) : R;
        voffA[i] = (unsigned)(R * K + C) * 2u; voffB[i] = (unsigned)(Rb * K + C) * 2u; }
    const size_t kstep = (size_t)(BK * 2);
    const size_t hstep = (size_t)HALF * K * 2;
    const size_t tstep = 2 * hstep;
    const unsigned ldsw = (unsigned)wid * 1024u;
    const int aoff = lds_byte(wr * 64 + fr, fq * 8), boff = lds_byte(wc * 32 + fr, fq * 8);
#define PG8_SA(b, h) (((b) * 2 + (h)) * HTB)
#define PG8_SB(b, h) ((4 + (b) * 2 + (h)) * HTB)
#define PG8_STAGE(bufoff, gbase, voff) do { _Pragma("unroll") for (int _i = 0; _i < 2; ++_i) \
        __builtin_amdgcn_global_load_lds((const unsigned*)((const char*)(gbase) + (voff)[_i]), (PG8_LAS unsigned*)(lds + (bufoff) + ldsw + _i * 8192), 16, 0, 0); } while (0)
#define PG8_LDA(dst, b, h) do { _Pragma("unroll") for (int m = 0; m < 4; ++m) _Pragma("unroll") for (int k = 0; k < 2; ++k) dst[m][k] = *(const PG8_LAS bf16x8*)(lds + PG8_SA(b, h) + aoff + m * 2048 + k * 1024); } while (0)
#define PG8_LDB(dst, b, h) do { _Pragma("unroll") for (int n = 0; n < 2; ++n) _Pragma("unroll") for (int k = 0; k < 2; ++k) dst[n][k] = *(const PG8_LAS bf16x8*)(lds + PG8_SB(b, h) + boff + n * 2048 + k * 1024); } while (0)
#define PG8_MMA(ai, bj, At, Bt) do { __builtin_amdgcn_s_setprio(1); _Pragma("unroll") for (int m = 0; m < 4; ++m) _Pragma("unroll") for (int n = 0; n < 2; ++n) _Pragma("unroll") for (int k = 0; k < 2; ++k) \
        acc[ai][bj][m][n] = __builtin_amdgcn_mfma_f32_16x16x32_bf16(Bt[n][k], At[m][k], acc[ai][bj][m][n], 0, 0, 0); __builtin_amdgcn_s_setprio(0); } while (0)
#define PG8_WAIT_V(n) asm volatile("s_waitcnt vmcnt(" #n ")" ::: "memory")
#define PG8_WAIT_L(n) asm volatile("s_waitcnt lgkmcnt(" #n ")" ::: "memory")
#define PG8_BAR __builtin_amdgcn_s_barrier()
#define PG8_SCHED __builtin_amdgcn_sched_barrier(0)
    Unit cur, nxt; int ui = 0;
    if (!S.next(0, cur)) return;
    f32x4 acc[2][2][4][2];
#pragma unroll
    for (int a = 0; a < 2; ++a)
#pragma unroll
        for (int b = 0; b < 2; ++b)
#pragma unroll
            for (int m = 0; m < 4; ++m)
#pragma unroll
                for (int n = 0; n < 2; ++n) acc[a][b][m][n] = (f32x4){0.f, 0.f, 0.f, 0.f};
    bf16x8 At[4][2], B0[2][2], B1[2][2];
    const char* cA = (const char*)g.A + (size_t)cur.pm * tstep; const char* cB = (const char*)g.Bt + (size_t)cur.pn * tstep;
    S.a_ready(cur);
    if constexpr (SP2) {
        PG8_STAGE(PG8_SB(0, 0), cB, voffB); PG8_STAGE(PG8_SB(0, 1), cB + hstep, voffB); PG8_STAGE(PG8_SA(0, 0), cA, voffA); PG8_STAGE(PG8_SA(0, 1), cA + hstep, voffA);
        if (wr == 1) PG8_BAR;
        PG8_WAIT_V(2); PG8_BAR;
        PG8_STAGE(PG8_SB(1, 0), cB + kstep, voffB); PG8_STAGE(PG8_SA(1, 0), cA + kstep, voffA); PG8_STAGE(PG8_SB(1, 1), cB + hstep + kstep, voffB);
        PG8_WAIT_V(6); PG8_BAR;
    } else {
        PG8_STAGE(PG8_SB(0, 0), cB, voffB); PG8_STAGE(PG8_SA(0, 0), cA, voffA); PG8_STAGE(PG8_SB(0, 1), cB + hstep, voffB); PG8_STAGE(PG8_SA(0, 1), cA + hstep, voffA);
        if (wr == 1) PG8_BAR;
        PG8_WAIT_V(4); PG8_BAR;
        PG8_STAGE(PG8_SB(1, 0), cB + kstep, voffB); PG8_STAGE(PG8_SA(1, 0), cA + kstep, voffA); PG8_STAGE(PG8_SB(1, 1), cB + hstep + kstep, voffB);
        PG8_WAIT_V(6); PG8_BAR;
    }
    for (;;) {
        const bool has_next = S.next(ui + 1, nxt);
        const char* nA = has_next ? (const char*)g.A + (size_t)nxt.pm * tstep : cA; const char* nB = has_next ? (const char*)g.Bt + (size_t)nxt.pn * tstep : cB;
        for (int t = 0; t < nt; t += 2) {
            const bool last = (t == nt - 2);
            const char* a1 = cA + (size_t)(t + 1) * kstep;
            const char* a2 = last ? nA : cA + (size_t)(t + 2) * kstep; const char* b2 = last ? nB : cB + (size_t)(t + 2) * kstep;
            const char* a3 = a2 + kstep; const char* b3 = b2 + kstep;
            if (last && has_next) S.a_ready(nxt);
            if constexpr (SP2) {
            PG8_LDB(B0, 0, 0); PG8_LDB(B1, 0, 1); PG8_SCHED; PG8_LDA(At, 0, 0); PG8_STAGE(PG8_SA(1, 1), a1 + hstep, voffA);
            PG8_WAIT_V(8); PG8_WAIT_L(0); PG8_BAR; PG8_MMA(0, 0, At, B0); PG8_MMA(0, 1, At, B1); PG8_BAR; PG8_SCHED;
            PG8_LDA(At, 0, 1); PG8_STAGE(PG8_SB(0, 0), b2, voffB); PG8_STAGE(PG8_SB(0, 1), b2 + hstep, voffB); PG8_STAGE(PG8_SA(0, 0), a2, voffA);
            PG8_WAIT_V(8); PG8_WAIT_L(0); PG8_BAR; PG8_MMA(1, 0, At, B0); PG8_MMA(1, 1, At, B1); PG8_BAR; PG8_SCHED;
            PG8_LDB(B0, 1, 0); PG8_LDB(B1, 1, 1); PG8_SCHED; PG8_LDA(At, 1, 0); PG8_STAGE(PG8_SA(0, 1), a2 + hstep, voffA);
            PG8_WAIT_V(8); PG8_WAIT_L(0); PG8_BAR; PG8_MMA(0, 0, At, B0); PG8_MMA(0, 1, At, B1); PG8_BAR; PG8_SCHED;
            PG8_LDA(At, 1, 1); PG8_STAGE(PG8_SB(1, 0), b3, voffB); PG8_STAGE(PG8_SB(1, 1), b3 + hstep, voffB); PG8_STAGE(PG8_SA(1, 0), a3, voffA);
            PG8_WAIT_V(8); PG8_WAIT_L(0); PG8_BAR; PG8_MMA(1, 0, At, B0); PG8_MMA(1, 1, At, B1); PG8_BAR; PG8_SCHED;
            } else {
            PG8_LDB(B0, 0, 0); PG8_SCHED; PG8_LDA(At, 0, 0); PG8_STAGE(PG8_SA(1, 1), a1 + hstep, voffA);
            PG8_WAIT_L(8); PG8_BAR; PG8_WAIT_L(0); PG8_MMA(0, 0, At, B0); PG8_BAR; PG8_SCHED;
            PG8_LDB(B1, 0, 1); PG8_STAGE(PG8_SB(0, 0), b2, voffB);
            PG8_BAR; PG8_WAIT_L(0); PG8_MMA(0, 1, At, B1); PG8_BAR;
            PG8_LDA(At, 0, 1); PG8_STAGE(PG8_SA(0, 0), a2, voffA);
            PG8_BAR; PG8_WAIT_L(0); PG8_MMA(1, 0, At, B0); PG8_BAR; PG8_SCHED;
            PG8_STAGE(PG8_SB(0, 1), b2 + hstep, voffB);
            PG8_WAIT_V(6); PG8_BAR; PG8_MMA(1, 1, At, B1); PG8_BAR;
            PG8_LDB(B0, 1, 0); PG8_SCHED; PG8_LDA(At, 1, 0); PG8_STAGE(PG8_SA(0, 1), a2 + hstep, voffA);
            PG8_WAIT_L(8); PG8_BAR; PG8_WAIT_L(0); PG8_MMA(0, 0, At, B0); PG8_BAR; PG8_SCHED;
            PG8_LDB(B1, 1, 1); PG8_STAGE(PG8_SB(1, 0), b3, voffB);
            PG8_BAR; PG8_WAIT_L(0); PG8_MMA(0, 1, At, B1); PG8_BAR;
            PG8_LDA(At, 1, 1); PG8_STAGE(PG8_SA(1, 0), a3, voffA);
            PG8_BAR; PG8_WAIT_L(0); PG8_MMA(1, 0, At, B0); PG8_BAR; PG8_SCHED;
            PG8_STAGE(PG8_SB(1, 1), b3 + hstep, voffB);
            PG8_WAIT_V(6); PG8_BAR; PG8_MMA(1, 1, At, B1); PG8_BAR;
            }
        }
        if constexpr (ALIGN_EPI) { if (wr == 0) PG8_BAR; }
        if constexpr (!Epi::AFTER_DRAIN) { E(acc, cur, wr, wc, fr, fq); S.done(cur); }
        if (!has_next) break;
#pragma unroll
        for (int a = 0; a < 2; ++a)
#pragma unroll
            for (int b = 0; b < 2; ++b)
#pragma unroll
                for (int m = 0; m < 4; ++m)
#pragma unroll
                    for (int n = 0; n < 2; ++n) acc[a][b][m][n] = (f32x4){0.f, 0.f, 0.f, 0.f};
        cur = nxt; cA = nA; cB = nB; ++ui;
        if constexpr (ALIGN_EPI) { if (wr == 1) PG8_BAR; }
    }
    PG8_WAIT_V(0);
    if constexpr (!ALIGN_EPI) { if (wr == 0) PG8_BAR; }
    PG8_BAR;
    if constexpr (Epi::AFTER_DRAIN) { E.fused(acc, cur, wr, wc, fr, fq, lds, wid, lane); S.done(cur); }
#undef PG8_SA
#undef PG8_SB
#undef PG8_STAGE
#undef PG8_LDA
#undef PG8_LDB
#undef PG8_MMA
#undef PG8_WAIT_V
#undef PG8_WAIT_L
#undef PG8_BAR
#undef PG8_SCHED
}
}

#define LAS __attribute__((address_space(3)))
#define GAS __attribute__((address_space(1)))
typedef unsigned short bf16;
typedef float f32x4 __attribute__((ext_vector_type(4)));
typedef float f32x2 __attribute__((ext_vector_type(2)));
typedef float f32x16 __attribute__((ext_vector_type(16)));
typedef short bf16x8 __attribute__((ext_vector_type(8)));
typedef unsigned u32x4 __attribute__((ext_vector_type(4)));
typedef unsigned u32x2 __attribute__((ext_vector_type(2)));
constexpr int NB = 4, SEQ = 8192, DM = 1024, DFF = 2816, M = NB * SEQ, NMOD = 9;
constexpr float RMS_EPS = 1e-6f;
constexpr float C2 = 0.125f * 1.4426950408889634f;
constexpr size_t MiB = 1u << 20;
constexpr size_t WS_CTL = 0;
constexpr size_t WS_WGU1 = 1 * MiB, WS_WD1 = 12 * MiB, WS_WIN = 18 * MiB, WS_WOUT = 24 * MiB, WS_WGU2 = 26 * MiB, WS_WD2 = 37 * MiB;
constexpr size_t WS_H = 48 * MiB;
constexpr size_t WS_F = 112 * MiB;
constexpr size_t WS_XB = 176 * MiB;
constexpr size_t WS_ACT = 240 * MiB;
constexpr size_t WS_VTD = 416 * MiB, WS_VTS = 448 * MiB;
constexpr size_t WS_OSB = 480 * MiB;
constexpr size_t WS_END = 512 * MiB;
constexpr int GEMM_LDS = 131072, LDS_BYTES = GEMM_LDS + 1024;
constexpr size_t WS_CTLW = 512 * 1024, CTLW_BYTES = 32 * 1024;
constexpr int CW_KINF = 4096, CW_QUEUE = 4160;

template <int CTRL> __device__ __forceinline__ float dpp_f(float v) { return __builtin_bit_cast(float, __builtin_amdgcn_update_dpp(0, __builtin_bit_cast(int, v), CTRL, 0xF, 0xF, true)); }
__device__ __forceinline__ float row16_sum(float v) {
    v += dpp_f<0xB1>(v);
    v += dpp_f<0x4E>(v);
    v += dpp_f<0x141>(v);
    v += dpp_f<0x140>(v);
    return v;
}
__device__ __forceinline__ float xrow_sum(float v) {
    { auto rr = __builtin_amdgcn_permlane16_swap(__float_as_uint(v), __float_as_uint(v), false, false); v = __uint_as_float(rr[0]) + __uint_as_float(rr[1]); }
    { auto rr = __builtin_amdgcn_permlane32_swap(__float_as_uint(v), __float_as_uint(v), false, false); v = __uint_as_float(rr[0]) + __uint_as_float(rr[1]); }
    return v;
}
__device__ __forceinline__ float wave_sum(float v) { return xrow_sum(row16_sum(v)); }
__device__ __forceinline__ unsigned pk_bf16(float lo, float hi) { return pg8::cvt_pk_bf16(lo, hi); }
__device__ __forceinline__ float bf2f(unsigned short h) { return __uint_as_float(((unsigned)h) << 16); }

namespace att {
constexpr int KSTR = 144;
constexpr int KBUFB = 64 * KSTR, STAGEB = KBUFB + 128 * KSTR;
constexpr int FLAG_OFF = 2 * STAGEB;
constexpr float THR = -48.0f;
__device__ __forceinline__ int crow(int r, int hi) { return (r & 3) + 8 * (r >> 2) + 4 * hi; }
typedef __bf16 bf16x2_t __attribute__((ext_vector_type(2)));
__device__ __forceinline__ unsigned cvtpk_c(float lo, float hi) { const f32x2 v = {lo, hi}; const bf16x2_t b = __builtin_convertvector(v, bf16x2_t); return __builtin_bit_cast(unsigned, b); }
__device__ __forceinline__ bf16x8 pack8(const f32x16& p, int b) {
    u32x4 w; w.x = cvtpk_c(p[b], p[b + 1]); w.y = cvtpk_c(p[b + 2], p[b + 3]); w.z = cvtpk_c(p[b + 4], p[b + 5]); w.w = cvtpk_c(p[b + 6], p[b + 7]);
    return __builtin_bit_cast(bf16x8, w);
}
#define MFMA32(a, b, c) __builtin_amdgcn_mfma_f32_32x32x16_bf16((a), (b), (c), 0, 0, 0)
__device__ __forceinline__ float max3f(float a, float b, float c) { float r; asm("v_max3_f32 %0, %1, %2, %3" : "=v"(r) : "v"(a), "v"(b), "v"(c)); return r; }
__device__ __forceinline__ float xhalf_max(float m) { auto rr = __builtin_amdgcn_permlane32_swap(__float_as_uint(m), __float_as_uint(m), false, false); return fmaxf(__uint_as_float(rr[0]), __uint_as_float(rr[1])); }
__device__ __forceinline__ float xhalf_sum(float m) { auto rr = __builtin_amdgcn_permlane32_swap(__float_as_uint(m), __float_as_uint(m), false, false); return __uint_as_float(rr[0]) + __uint_as_float(rr[1]); }

template <int MODE, int DV>
__device__ __forceinline__ void attn_unit(LAS unsigned char* lds, const bf16* __restrict__ QK, int qcol, int kcol, const bf16* __restrict__ Vt,
                                          size_t rowbase, int qb, float slope2, float kinfa, float kinfb, float* __restrict__ Of, bf16* __restrict__ Ob, int ocol) {
    constexpr int NDB = DV / 32, NVC = DV / 64, NACC = NDB;
    int tid_l = threadIdx.x; asm volatile("" : "+v"(tid_l));
    const int tid = tid_l, lane = tid & 63, r32 = lane & 31, hi = lane >> 5;
    const int wid = __builtin_amdgcn_readfirstlane(tid >> 6);
    const int q0 = qb * 256, tw0 = q0 + 32 * wid, t = tw0 + r32;
    const int NT = 4 * qb + 4;
    bf16x8 qf[4];
    { const bf16* qp = QK + (rowbase + t) * 2048 + qcol + hi * 8;
#pragma unroll
      for (int ds = 0; ds < 4; ++ds) qf[ds] = *(const GAS bf16x8*)(qp + ds * 16); }
    float rowc = 0.f;
    if (MODE == 0) {
        float sa = 0.f, sb2 = 0.f;
#pragma unroll
        for (int ds = 0; ds < 4; ++ds) { const u32x4 w = __builtin_bit_cast(u32x4, qf[ds]);
            const float e0 = __uint_as_float(w.x << 16), e1 = __uint_as_float(w.x & 0xffff0000u), e2 = __uint_as_float(w.y << 16), e3 = __uint_as_float(w.y & 0xffff0000u);
            const float e4 = __uint_as_float(w.z << 16), e5 = __uint_as_float(w.z & 0xffff0000u), e6 = __uint_as_float(w.w << 16), e7 = __uint_as_float(w.w & 0xffff0000u);
            const float q2 = (e0 * e0 + e1 * e1) + (e2 * e2 + e3 * e3) + (e4 * e4 + e5 * e5) + (e6 * e6 + e7 * e7);
            if (ds < 2) sa += q2; else sb2 += q2; }
        sa = xhalf_sum(sa); sb2 = xhalf_sum(sb2);
        rowc = (sqrtf(sa * kinfa) + sqrtf(sb2 * kinfb)) * 1.02f;
    }
    const int krow = tid >> 3, kch = tid & 7;
    const bf16* ksrc = QK + (rowbase + krow) * 2048 + kcol + kch * 8;
    const unsigned kdst = krow * KSTR + kch * 16;
    const bf16* vsrc = Vt + (size_t)krow * SEQ + kch * 8;
    const unsigned vdst = KBUFB + krow * KSTR + kch * 16;
    const unsigned koff = r32 * KSTR + hi * 16;
    LAS unsigned* flags = (LAS unsigned*)(lds + FLAG_OFF);

    f32x16 o[NACC];
#pragma unroll
    for (int d = 0; d < NACC; ++d)
#pragma unroll
        for (int r = 0; r < 16; ++r) o[d][r] = 0.f;
    float mrun = 0.f, carry = 0.f, lrun = 0.f;
    bool wdone = false, first = true;
    bf16x8 ut0, ut1, uone;
    { const u32x4 c = {0x3F803F80u, 0x3F803F80u, 0x3F803F80u, 0x3F803F80u}; uone = __builtin_bit_cast(bf16x8, c); }
    if (MODE == 1) {
        u32x4 a, b;
        unsigned e0[8], e1[8];
#pragma unroll
        for (int j = 0; j < 8; ++j) { const int jj = 8 * (j >> 2) + 4 * hi + (j & 3); e0[j] = (jj > r32) ? 0x3F80u : 0u; e1[j] = (16 + jj > r32) ? 0x3F80u : 0u; }
        a.x = e0[0] | (e0[1] << 16); a.y = e0[2] | (e0[3] << 16); a.z = e0[4] | (e0[5] << 16); a.w = e0[6] | (e0[7] << 16);
        b.x = e1[0] | (e1[1] << 16); b.y = e1[2] | (e1[3] << 16); b.z = e1[4] | (e1[5] << 16); b.w = e1[6] | (e1[7] << 16);
        ut0 = __builtin_bit_cast(bf16x8, a); ut1 = __builtin_bit_cast(bf16x8, b);
    }
    u32x4 kreg[2], vreg[2][NVC];
#define ATT_LOAD(set_, kt_) do { kreg[set_] = *(const GAS u32x4*)(ksrc + (size_t)(kt_) * 64 * 2048); \
        _Pragma("unroll") for (int i_ = 0; i_ < NVC; ++i_) vreg[set_][i_] = *(const GAS u32x4*)(vsrc + (size_t)i_ * 64 * SEQ + (kt_) * 64); } while (0)
#define ATT_STORE(set_, stg_) do { *(LAS u32x4*)(lds + (stg_) * STAGEB + kdst) = kreg[set_]; \
        _Pragma("unroll") for (int i_ = 0; i_ < NVC; ++i_) *(LAS u32x4*)(lds + (stg_) * STAGEB + vdst + i_ * 64 * KSTR) = vreg[set_][i_]; } while (0)
    ATT_LOAD(0, NT - 1); ATT_LOAD(1, (NT - 2 > 0) ? NT - 2 : 0); ATT_STORE(0, 0);
    __syncthreads();
    int kt = NT - 1; bool fin = false;
    for (;;) {
#pragma unroll
      for (int hh = 0; hh < 2; ++hh) {
        const bool hasn = (kt > 0);
        ATT_LOAD(hh, (kt - 2 > 0) ? kt - 2 : 0);
        const int k0 = kt * 64;
        const LAS unsigned char* sb = lds + hh * STAGEB;
        const bool active = ((MODE == 0) ? (k0 <= tw0 + 31) : (k0 < tw0 + 31)) && !wdone;
        if (active) {
            f32x16 p0, p1;
            if (MODE == 0) {
                const float bb = slope2 * (float)(k0 + 4 * hi - t) - mrun;
#pragma unroll
                for (int r = 0; r < 16; ++r) { const float c = __builtin_fmaf(slope2, (float)((r & 3) + 8 * (r >> 2)), bb); p0[r] = c; p1[r] = __builtin_fmaf(slope2, 32.0f, c); }
            } else {
#pragma unroll
                for (int r = 0; r < 16; ++r) { p0[r] = 0.f; p1[r] = 0.f; }
            }
#pragma unroll
            for (int ds = 0; ds < 4; ++ds) {
                const bf16x8 k0f = *(const LAS bf16x8*)(sb + koff + ds * 32);
                const bf16x8 k1f = *(const LAS bf16x8*)(sb + koff + 32 * KSTR + ds * 32);
                p0 = MFMA32(k0f, qf[ds], p0); p1 = MFMA32(k1f, qf[ds], p1);
            }
            const bool diag = (MODE == 0) ? (k0 + 63 > tw0) : (k0 + 63 >= tw0);
            bf16x8 pf0, pf1, pf2, pf3;
            if (MODE == 0) {
                if (diag) {
#pragma unroll
                    for (int r = 0; r < 16; ++r) { const int key = k0 + crow(r, hi); if (key > t) p0[r] = -INFINITY; if (key + 32 > t) p1[r] = -INFINITY; }
                }
                float mx;
                { float a0 = max3f(p0[0], p0[1], p0[2]), a1 = max3f(p0[3], p0[4], p0[5]), a2 = max3f(p0[6], p0[7], p0[8]), a3 = max3f(p0[9], p0[10], p0[11]);
                  float a4 = max3f(p0[12], p0[13], p0[14]), a5 = max3f(p0[15], p1[0], p1[1]), a6 = max3f(p1[2], p1[3], p1[4]), a7 = max3f(p1[5], p1[6], p1[7]);
                  float a8 = max3f(p1[8], p1[9], p1[10]), a9 = max3f(p1[11], p1[12], p1[13]), a10 = max3f(p1[14], p1[15], a0);
                  a1 = max3f(a1, a2, a3); a4 = max3f(a4, a5, a6); a7 = max3f(a7, a8, a9);
                  mx = xhalf_max(max3f(max3f(a1, a4, a7), a10, a10)); }
                if (first || __any(mx > 6.0f)) {
                    const float dl = first ? mx : fmaxf(mx, 0.f);
#pragma unroll
                    for (int r = 0; r < 16; ++r) { p0[r] -= dl; p1[r] -= dl; }
                    mrun += dl;
                    if (!first) { const float alpha = __builtin_amdgcn_exp2f(-dl); lrun *= alpha;
#pragma unroll
                        for (int d = 0; d < NACC; ++d)
#pragma unroll
                            for (int r = 0; r < 16; ++r) o[d][r] *= alpha; }
                    first = false;
                }
#pragma unroll
                for (int r = 0; r < 16; ++r) { p0[r] = __builtin_amdgcn_exp2f(p0[r]); p1[r] = __builtin_amdgcn_exp2f(p1[r]); }
                { float s0 = p0[0] + p1[0], s1 = p0[1] + p1[1], s2 = p0[2] + p1[2], s3 = p0[3] + p1[3];
#pragma unroll
                  for (int r = 4; r < 16; r += 4) { s0 += p0[r] + p1[r]; s1 += p0[r + 1] + p1[r + 1]; s2 += p0[r + 2] + p1[r + 2]; s3 += p0[r + 3] + p1[r + 3]; }
                  lrun += (s0 + s1) + (s2 + s3); }
                pf0 = pack8(p0, 0); pf1 = pack8(p0, 8); pf2 = pack8(p1, 0); pf3 = pack8(p1, 8);
                wdone = __all(rowc - slope2 * (float)(t - k0 + 1) < mrun - 32.0f) != 0;
            } else {
                float ts = 0.f;
                f32x16 l0, l1;
#pragma unroll
                for (int r = 0; r < 16; ++r) {
                    { const float z = p0[r]; const float e = __builtin_amdgcn_exp2f(-fabsf(z)); const float sp = fmaxf(-z, 0.f) + __builtin_amdgcn_logf(1.0f + e);
                      const float lb = -sp; float lm = lb - z; if (diag && !(k0 + crow(r, hi) < t)) lm = 0.f; l0[r] = lm; ts += lm; p0[r] = lb + carry; }
                    { const float z = p1[r]; const float e = __builtin_amdgcn_exp2f(-fabsf(z)); const float sp = fmaxf(-z, 0.f) + __builtin_amdgcn_logf(1.0f + e);
                      const float lb = -sp; float lm = lb - z; if (diag && !(k0 + 32 + crow(r, hi) < t)) lm = 0.f; l1[r] = lm; ts += lm; p1[r] = lb + carry; }
                }
                const bf16x8 L0a = pack8(l0, 0), L0b = pack8(l0, 8), L1a = pack8(l1, 0), L1b = pack8(l1, 8);
                p0 = MFMA32(ut0, L0a, p0); p0 = MFMA32(ut1, L0b, p0); p0 = MFMA32(uone, L1a, p0); p0 = MFMA32(uone, L1b, p0);
                p1 = MFMA32(ut0, L1a, p1); p1 = MFMA32(ut1, L1b, p1);
#pragma unroll
                for (int r = 0; r < 16; ++r) {
                    float a0 = __builtin_amdgcn_exp2f(p0[r]), a1 = __builtin_amdgcn_exp2f(p1[r]);
                    if (diag) { if (!(k0 + crow(r, hi) < t)) a0 = 0.f; if (!(k0 + 32 + crow(r, hi) < t)) a1 = 0.f; }
                    p0[r] = a0; p1[r] = a1;
                }
                ts = xhalf_sum(ts);
                carry += ts;
                pf0 = pack8(p0, 0); pf1 = pack8(p0, 8); pf2 = pack8(p1, 0); pf3 = pack8(p1, 8);
                wdone = __all(carry < THR) != 0;
            }
#pragma unroll
            for (int d = 0; d < NDB; ++d) {
                const LAS unsigned char* vb = sb + KBUFB + d * 32 * KSTR + koff;
                const bf16x8 v0 = *(const LAS bf16x8*)(vb), v1 = *(const LAS bf16x8*)(vb + 32), v2 = *(const LAS bf16x8*)(vb + 64), v3 = *(const LAS bf16x8*)(vb + 96);
                o[d] = MFMA32(v0, pf0, o[d]); o[d] = MFMA32(v1, pf1, o[d]); o[d] = MFMA32(v2, pf2, o[d]); o[d] = MFMA32(v3, pf3, o[d]);
            }
        }
        if (hasn) ATT_STORE(hh ^ 1, hh ^ 1);
        if (lane == 0) flags[hh * 8 + wid] = wdone ? 1u : 0u;
        __syncthreads();
        if (!hasn) { fin = true; break; }
        { const unsigned f = flags[hh * 8 + (lane & 7)]; if (__all(f != 0u)) { fin = true; break; } }
        --kt;
      }
      if (fin) break;
    }
#undef ATT_LOAD
#undef ATT_STORE
    if (MODE == 0) {
        const float inv = 1.0f / xhalf_sum(lrun);
        bf16* op = (bf16*)Of + (rowbase + t) * 1024 + ocol + 4 * hi;
#pragma unroll
        for (int d = 0; d < NDB; ++d)
#pragma unroll
            for (int g = 0; g < 4; ++g) { u32x2 w; w.x = pk_bf16(o[d][4 * g] * inv, o[d][4 * g + 1] * inv); w.y = pk_bf16(o[d][4 * g + 2] * inv, o[d][4 * g + 3] * inv); *(GAS u32x2*)(op + 32 * d + 8 * g) = w; }
    } else {
        bf16* op = Ob + (rowbase + t) * 512 + ocol + 4 * hi;
#pragma unroll
        for (int d = 0; d < NDB; ++d)
#pragma unroll
            for (int g = 0; g < 4; ++g) { u32x2 w; w.x = pk_bf16(o[d][4 * g], o[d][4 * g + 1]); w.y = pk_bf16(o[d][4 * g + 2], o[d][4 * g + 3]); *(GAS u32x2*)(op + 32 * d + 8 * g) = w; }
    }
}
#undef MFMA32
}

#define XB_TMO      128
#define XB_XCNT(j)  (256  + 64 * (j))
#define XB_XSUB(j)  (1280 + 64 * (j))
#define XB_XGEN(j)  (2304 + 64 * (j))
#define XB_TOP      3328
#define XB_TOPGEN   3392
#define XCD_BAR_WORDS 3456
#define XB_SPIN_CAP (1u << 18)

__device__ __forceinline__ unsigned xb_ld(unsigned* p)              { return __hip_atomic_load(p, __ATOMIC_RELAXED, __HIP_MEMORY_SCOPE_AGENT); }
__device__ __forceinline__ unsigned xb_add(unsigned* p, unsigned v) { return __hip_atomic_fetch_add(p, v, __ATOMIC_RELAXED, __HIP_MEMORY_SCOPE_AGENT); }
__device__ __forceinline__ unsigned xb_xcc_id() { return (unsigned)__builtin_amdgcn_s_getreg((3 << 11) | 20) & 0xFu; }
#define XB_SPIN(cond, bar) do { unsigned _sp = 0; while (cond) { __builtin_amdgcn_s_sleep(1); \
    if ((++_sp & 255u) == 0u) { if (xb_ld(&(bar)[XB_TMO])) break; if (_sp > XB_SPIN_CAP) { atomicAdd(&(bar)[XB_TMO], 1u); break; } } } } while (0)

struct XcdBarrier {
    unsigned* bar; unsigned x;
    volatile LAS unsigned* st;
};

__device__ __forceinline__ XcdBarrier xcd_barrier_post(unsigned* bar, volatile LAS unsigned* st) {
    XcdBarrier b; b.bar = bar; b.x = xb_xcc_id(); b.st = st;
    if (threadIdx.x == 0) (void)xb_add(&bar[XB_XCNT(b.x)], 1u);
    return b;
}
__device__ __forceinline__ void xcd_barrier_complete(unsigned* bar, unsigned x, unsigned& nloc, unsigned& nx) {
    const unsigned G = gridDim.x * gridDim.y * gridDim.z;
    unsigned sum, cnt, mine, sp = 0u;
    for (;;) {
        sum = 0u; cnt = 0u; mine = 0u;
#pragma unroll
        for (unsigned j = 0; j < 16; ++j) { const unsigned c = xb_ld(&bar[XB_XCNT(j)]); sum += c; cnt += (c > 0u) ? 1u : 0u; mine = (j == x) ? c : mine; }
        if (sum == G) break;
        __builtin_amdgcn_s_sleep(1);
        if ((++sp & 255u) == 0u) { if (xb_ld(&bar[XB_TMO])) break; if (sp > XB_SPIN_CAP) { atomicAdd(&bar[XB_TMO], 1u); break; } }
    }
    nloc = mine > 0u ? mine : 1u; nx = cnt > 0u ? cnt : 1u;
}

__device__ __forceinline__ void xcd_barrier(const XcdBarrier& b) {
    asm volatile("s_waitcnt vmcnt(0)" ::: "memory");
    __syncthreads();
    if (threadIdx.x == 0) {
        unsigned* bar = b.bar;
        __builtin_amdgcn_s_waitcnt(0);
        unsigned nloc = b.st[0], nx = b.st[1];
        if (nloc == 0u) { xcd_barrier_complete(bar, b.x, nloc, nx); b.st[0] = nloc; b.st[1] = nx; }
        const unsigned old = xb_add(&bar[XB_XSUB(b.x)], 1u);
        const unsigned gen = old / nloc;
        if (old + 1u == (gen + 1u) * nloc) {
            __builtin_amdgcn_fence(__ATOMIC_RELEASE, "agent");
            asm volatile("s_waitcnt vmcnt(0)" ::: "memory");
            const unsigned og = xb_add(&bar[XB_TOP], 1u);
            const unsigned tg = og / nx;
            if (og + 1u == (tg + 1u) * nx) xb_add(&bar[XB_TOPGEN], 1u);
            else XB_SPIN(xb_ld(&bar[XB_TOPGEN]) == tg, bar);
            __builtin_amdgcn_fence(__ATOMIC_ACQUIRE, "agent");
            xb_add(&bar[XB_XGEN(b.x)], 1u);
            asm volatile("s_waitcnt vmcnt(0)" ::: "memory");
        } else {
            XB_SPIN(xb_ld(&bar[XB_XGEN(b.x)]) == gen, bar);
            __builtin_amdgcn_fence(__ATOMIC_ACQUIRE, "agent");
            asm volatile("s_waitcnt vmcnt(0)" ::: "memory");
        }
    }
    __syncthreads();
}

#ifndef WGM_GU
#define WGM_GU 4
#endif
#ifndef WGM_N1K
#define WGM_N1K 4
#endif
#ifndef WGM_IN
#define WGM_IN 4
#endif
#ifndef PHASE_MASK
#define PHASE_MASK 0xFFFF
#endif
#define PH(n) (((PHASE_MASK) >> (n)) & 1)
#ifndef DUP_MASK
#define DUP_MASK 0
#endif
#ifndef ATT_DUP
#define ATT_DUP 0
#endif
#define REP(n) for (int rep_ = 0; rep_ < 1 + (((DUP_MASK) >> (n)) & 1); ++rep_)
#ifndef ATT_PASS_MASK
#define ATT_PASS_MASK 3
#endif
struct Args { const float* in[24]; float* out; unsigned char* ws; };

__device__ __forceinline__ void transpose_item(const float* __restrict__ W, int K, int N, bf16* __restrict__ WT, int mode, LAS float* scr, int item, int lane) {
    const int nblk = N / 32, kb = item / nblk, nb = item % nblk, k0 = 64 * kb, n0 = 32 * nb;
#pragma unroll
    for (int i = 0; i < 8; ++i) { const int kk = 8 * i + (lane >> 3), nq = 4 * (lane & 7);
        const f32x4 v = __builtin_nontemporal_load((const GAS f32x4*)(W + (size_t)(k0 + kk) * N + n0 + nq)); LAS float* d = scr + kk * 33 + nq; d[0] = v.x; d[1] = v.y; d[2] = v.z; d[3] = v.w; }
    asm volatile("s_waitcnt lgkmcnt(0)" ::: "memory");
    const int c = lane & 7;
#pragma unroll
    for (int j = 0; j < 4; ++j) { const int n = (lane >> 3) + 8 * j; const LAS float* s = scr + (8 * c) * 33 + n;
        u32x4 o; o.x = pk_bf16(s[0 * 33], s[1 * 33]); o.y = pk_bf16(s[2 * 33], s[3 * 33]); o.z = pk_bf16(s[4 * 33], s[5 * 33]); o.w = pk_bf16(s[6 * 33], s[7 * 33]);
        const int ng = n0 + n; const int nr = (mode == 0) ? ng : (256 * (ng >> 7) + (ng & 127) + (mode == 2 ? 128 : 0));
        *(GAS u32x4*)(WT + (size_t)nr * K + k0 + 8 * c) = o; }
    asm volatile("s_waitcnt lgkmcnt(0)" ::: "memory");
}

template <bool HAS_F, bool HAS_H, bool XIN_B = false, bool XOUT_B = false>
__device__ __forceinline__ void rowpass(const void* xin_, const bf16* __restrict__ Fb, void* xout_, bf16* __restrict__ H,
                                        const float* __restrict__ gpost, const float* __restrict__ modp, int gi  , float resw,
                                        const float* __restrict__ gpre, int sci, int shi, int gw, int lane) {
    constexpr int RPW = M / 2048;
    const int row_lo = gw * RPW; const int b = row_lo / SEQ;
    const float* mb = modp + (size_t)b * (NMOD * DM);
    f32x4 Cg[4], A[4], Sh[4];
#pragma unroll
    for (int j = 0; j < 4; ++j) { const int col = 256 * j + 4 * lane;
        if (HAS_F) { const f32x4 g = *(const GAS f32x4*)(mb + gi * DM + col), gp = *(const GAS f32x4*)(gpost + col); Cg[j] = g * gp * resw; }
        if (HAS_H) { const f32x4 s = *(const GAS f32x4*)(mb + sci * DM + col), gp = *(const GAS f32x4*)(gpre + col); A[j] = gp * (s + 1.0f); Sh[j] = *(const GAS f32x4*)(mb + shi * DM + col); } }
    const float* xin = (const float*)xin_; const bf16* xinb = (const bf16*)xin_; float* xout = (float*)xout_; bf16* xoutb = (bf16*)xout_;
#define RP_LDX(dst, r, j) do { if (XIN_B) { const u32x2 w_ = __builtin_nontemporal_load((const GAS u32x2*)(xinb + (size_t)(r) * DM + 256 * (j) + 4 * lane)); \
        dst = (f32x4){__uint_as_float(w_.x << 16), __uint_as_float(w_.x & 0xffff0000u), __uint_as_float(w_.y << 16), __uint_as_float(w_.y & 0xffff0000u)}; } \
      else dst = __builtin_nontemporal_load((const GAS f32x4*)(xin + (size_t)(r) * DM + 256 * (j) + 4 * lane)); } while (0)
    f32x4 xn[4]; u32x2 fn[4];
#pragma unroll
    for (int j = 0; j < 4; ++j) { RP_LDX(xn[j], row_lo, j); if (HAS_F) fn[j] = __builtin_nontemporal_load((const GAS u32x2*)(Fb + (size_t)row_lo * DM + 256 * j + 4 * lane)); }
    for (int row = row_lo; row < row_lo + RPW; ++row) {
        f32x4 x[4]; u32x2 fwv[4];
#pragma unroll
        for (int j = 0; j < 4; ++j) { x[j] = xn[j]; if (HAS_F) fwv[j] = fn[j]; }
        { const int rn = (row + 1 < row_lo + RPW) ? row + 1 : row;
#pragma unroll
          for (int j = 0; j < 4; ++j) { RP_LDX(xn[j], rn, j); if (HAS_F) fn[j] = __builtin_nontemporal_load((const GAS u32x2*)(Fb + (size_t)rn * DM + 256 * j + 4 * lane)); } }
        if (HAS_F) {
            f32x4 f[4]; float ss = 0.f;
#pragma unroll
            for (int j = 0; j < 4; ++j) { const u32x2 fw = fwv[j];
                f[j] = (f32x4){__uint_as_float(fw.x << 16), __uint_as_float(fw.x & 0xffff0000u), __uint_as_float(fw.y << 16), __uint_as_float(fw.y & 0xffff0000u)}; ss += (f[j].x * f[j].x + f[j].y * f[j].y) + (f[j].z * f[j].z + f[j].w * f[j].w); }
            const float rstd = 1.0f / sqrtf(wave_sum(ss) * (1.0f / DM) + RMS_EPS);
#pragma unroll
            for (int j = 0; j < 4; ++j) { x[j] = x[j] + f[j] * rstd * Cg[j];
                if (XOUT_B) { u32x2 w; w.x = pk_bf16(x[j].x, x[j].y); w.y = pk_bf16(x[j].z, x[j].w); *(GAS u32x2*)(xoutb + (size_t)row * DM + 256 * j + 4 * lane) = w;
                    x[j] = (f32x4){__uint_as_float(w.x << 16), __uint_as_float(w.x & 0xffff0000u), __uint_as_float(w.y << 16), __uint_as_float(w.y & 0xffff0000u)}; }
                else __builtin_nontemporal_store(x[j], (GAS f32x4*)(xout + (size_t)row * DM + 256 * j + 4 * lane)); }
        }
        if (HAS_H) {
            float ss = 0.f;
#pragma unroll
            for (int j = 0; j < 4; ++j) ss += (x[j].x * x[j].x + x[j].y * x[j].y) + (x[j].z * x[j].z + x[j].w * x[j].w);
            const float rstd = 1.0f / sqrtf(wave_sum(ss) * (1.0f / DM) + RMS_EPS);
#pragma unroll
            for (int j = 0; j < 4; ++j) { const f32x4 h = x[j] * rstd * A[j] + Sh[j]; u32x2 w; w.x = pk_bf16(h.x, h.y); w.y = pk_bf16(h.z, h.w);
                *(GAS u32x2*)(H + (size_t)row * DM + 256 * j + 4 * lane) = w; }
        }
    }
}
#undef RP_LDX

__device__ __forceinline__ void rowpass_attn(const float* __restrict__ Od, const bf16* __restrict__ Os, bf16* __restrict__ H, const float* __restrict__ subln,
                                             const float* __restrict__ sbeta, float lam, int gw, int lane) {
    constexpr int RPW = M / 2048;
    const int hd = lane >> 4, e0 = 8 * (lane & 15);
    const f32x4 sl0 = *(const GAS f32x4*)(subln + e0), sl1 = *(const GAS f32x4*)(subln + e0 + 4);
    const f32x4 be0 = *(const GAS f32x4*)(sbeta + 8 * lane), be1 = *(const GAS f32x4*)(sbeta + 8 * lane + 4);
#define RA_UNPK(W_, V_) do { V_[0] = __uint_as_float(W_.x << 16); V_[1] = __uint_as_float(W_.x & 0xffff0000u); V_[2] = __uint_as_float(W_.y << 16); V_[3] = __uint_as_float(W_.y & 0xffff0000u); \
        V_[4] = __uint_as_float(W_.z << 16); V_[5] = __uint_as_float(W_.z & 0xffff0000u); V_[6] = __uint_as_float(W_.w << 16); V_[7] = __uint_as_float(W_.w & 0xffff0000u); } while (0)
    const int row_lo = gw * RPW;
    u32x4 n0 = __builtin_nontemporal_load((const GAS u32x4*)((const bf16*)Od + (size_t)row_lo * 1024 + hd * 256 + e0)), n1 = __builtin_nontemporal_load((const GAS u32x4*)((const bf16*)Od + (size_t)row_lo * 1024 + hd * 256 + 128 + e0));
    u32x4 ns = __builtin_nontemporal_load((const GAS u32x4*)(Os + (size_t)row_lo * 512 + 8 * lane));
    for (int row = row_lo; row < row_lo + RPW; ++row) {
        const u32x4 w0 = n0, w1 = n1, ws = ns;
        { const int rn = (row + 1 < row_lo + RPW) ? row + 1 : row;
          n0 = __builtin_nontemporal_load((const GAS u32x4*)((const bf16*)Od + (size_t)rn * 1024 + hd * 256 + e0)); n1 = __builtin_nontemporal_load((const GAS u32x4*)((const bf16*)Od + (size_t)rn * 1024 + hd * 256 + 128 + e0));
          ns = __builtin_nontemporal_load((const GAS u32x4*)(Os + (size_t)rn * 512 + 8 * lane)); }
        float a0[8], a1[8], v[8], sv[8];
        RA_UNPK(w0, a0); RA_UNPK(w1, a1); RA_UNPK(ws, sv);
        float ss = 0.f, s2 = 0.f;
#pragma unroll
        for (int i = 0; i < 8; ++i) { v[i] = a0[i] - a1[i] * lam; ss += v[i] * v[i]; s2 += sv[i] * sv[i]; }
        ss = row16_sum(ss);
        const float rstd = 0.8f / sqrtf(ss * (1.0f / 128.0f) + RMS_EPS);
        u32x4 od; od.x = pk_bf16(v[0] * rstd * sl0.x, v[1] * rstd * sl0.y); od.y = pk_bf16(v[2] * rstd * sl0.z, v[3] * rstd * sl0.w);
        od.z = pk_bf16(v[4] * rstd * sl1.x, v[5] * rstd * sl1.y); od.w = pk_bf16(v[6] * rstd * sl1.z, v[7] * rstd * sl1.w);
        *(GAS u32x4*)(H + (size_t)row * 1024 + hd * 128 + e0) = od;
        const float rstd2 = 1.0f / sqrtf(wave_sum(s2) * (1.0f / 512.0f) + RMS_EPS);
        u32x4 o; o.x = pk_bf16(sv[0] * rstd2 * be0.x, sv[1] * rstd2 * be0.y); o.y = pk_bf16(sv[2] * rstd2 * be0.z, sv[3] * rstd2 * be0.w);
        o.z = pk_bf16(sv[4] * rstd2 * be1.x, sv[5] * rstd2 * be1.y); o.w = pk_bf16(sv[6] * rstd2 * be1.z, sv[7] * rstd2 * be1.w);
        *(GAS u32x4*)(H + (size_t)row * 1024 + 512 + 8 * lane) = o;
    }
#undef RA_UNPK
}

#define KAS __attribute__((address_space(4)))
__device__ __forceinline__ const float* karg(int i) { const KAS char* ka = (const KAS char*)__builtin_amdgcn_kernarg_segment_ptr(); return (const float*)(*(const volatile KAS unsigned long long*)(ka + 8 * i)); }
#define AIN(i) karg(i)
__device__ __forceinline__ int fresh_tid() { int t = threadIdx.x; asm volatile("" : "+v"(t)); return t; }
__global__ void __launch_bounds__(512) fwd_megakernel(Args args) {
    extern __shared__ __attribute__((aligned(16))) unsigned char lds_raw[];
    cg::grid_group grid = cg::this_grid();
    LAS unsigned char* lds = (LAS unsigned char*)lds_raw;
    const int wave = __builtin_amdgcn_readfirstlane((int)threadIdx.x >> 6);
#define tid (fresh_tid())
#define lane (fresh_tid() & 63)
    const int G = gridDim.x, bx = blockIdx.x;
    const int vcu = (G % 8 == 0) ? (bx % 8) * (G / 8) + bx / 8 : bx;
    const int gw = vcu * 8 + wave, NGW = G * 8;
    unsigned* ctlw = (unsigned*)((unsigned char*)karg(25) + WS_CTLW);
    volatile LAS unsigned* MISC = (volatile LAS unsigned*)(lds + GEMM_LDS);
    if (tid < 64) MISC[tid] = 0u;
    __syncthreads();
    XcdBarrier bar = xcd_barrier_post(ctlw, MISC + 8);
#define WSP(off) ((unsigned char*)karg(25) + (off))
#define ctl ((float*)WSP(WS_CTL))
#define modp (((float*)WSP(WS_CTL)) + 1024)
#define out ((float*)karg(24))
#define Wgu1 ((bf16*)WSP(WS_WGU1))
#define Wd1 ((bf16*)WSP(WS_WD1))
#define Win ((bf16*)WSP(WS_WIN))
#define Wout ((bf16*)WSP(WS_WOUT))
#define Wgu2 ((bf16*)WSP(WS_WGU2))
#define Wd2 ((bf16*)WSP(WS_WD2))
#define H ((bf16*)WSP(WS_H))
#define F ((float*)WSP(WS_F))
#define ACT ((bf16*)WSP(WS_ACT))
#define QK ((bf16*)WSP(WS_ACT))
#define VtD ((bf16*)WSP(WS_VTD))
#define VtS ((bf16*)WSP(WS_VTS))
#define Osb ((bf16*)WSP(WS_OSB))
#define XB ((bf16*)WSP(WS_XB))
    if (PH(0)) REP(0) {
        if (bx < 144) {
            LAS float* sc = (LAS float*)lds;
            LAS float* red = sc + 4096;
            const float* c = AIN(1);
            for (int i = tid; i < 4096; i += 512) { const float v = c[i]; sc[i] = v / (1.0f + __expf(-v)); }
            __syncthreads();
            const int col = bx * 64 + (tid & 63), kg = tid >> 6;
            const float* wp = AIN(2) + (size_t)(kg * 128) * (NMOD * DM) + col;
            float a0 = 0.f, a1 = 0.f, a2 = 0.f, a3 = 0.f;
#pragma unroll 8
            for (int k = 0; k < 128; ++k) { const float w = __builtin_nontemporal_load((const GAS float*)wp + (size_t)k * (NMOD * DM)); const int kk = kg * 128 + k;
                a0 += sc[kk] * w; a1 += sc[1024 + kk] * w; a2 += sc[2048 + kk] * w; a3 += sc[3072 + kk] * w; }
            red[(kg * 4 + 0) * 64 + (tid & 63)] = a0; red[(kg * 4 + 1) * 64 + (tid & 63)] = a1; red[(kg * 4 + 2) * 64 + (tid & 63)] = a2; red[(kg * 4 + 3) * 64 + (tid & 63)] = a3;
            __syncthreads();
            if (tid < 256) { const int b = tid >> 6, cc = tid & 63; float s = 0.f;
#pragma unroll
                for (int g = 0; g < 8; ++g) s += red[(g * 4 + b) * 64 + cc];
                modp[(size_t)b * (NMOD * DM) + bx * 64 + cc] = s + AIN(3)[bx * 64 + cc]; }
            __syncthreads();
        }
        if (bx == G - 1 && wave == 0) {
            const float s1 = wave_sum(AIN(13)[lane] * AIN(14)[lane]), s2 = wave_sum(AIN(15)[lane] * AIN(16)[lane]);
            if (lane == 0) ctl[0] = __expf(s1) - __expf(s2) + 0.2f;
        }
        LAS float* scr = (LAS float*)(lds + wave * 16384);
        constexpr int I_G = (DM / 64) * (DFF / 32), I_D = (DFF / 64) * (DM / 32), I_IN = (DM / 64) * (3 * DM / 32), I_OUT = (DM / 64) * (DM / 32);
        constexpr int NITEMS = 6 * I_G + I_IN + I_OUT;
        static_assert(I_G == I_D, "item counts");
        for (int itx = gw; itx < NITEMS; itx += NGW) {
            int r = itx;
            if (r < I_G) { transpose_item(AIN(6), DM, DFF, Wgu1, 1, scr, r, lane); continue; } r -= I_G;
            if (r < I_G) { transpose_item(AIN(7), DM, DFF, Wgu1, 2, scr, r, lane); continue; } r -= I_G;
            if (r < I_D) { transpose_item(AIN(8), DFF, DM, Wd1, 0, scr, r, lane); continue; } r -= I_D;
            if (r < I_G) { transpose_item(AIN(21), DM, DFF, Wgu2, 1, scr, r, lane); continue; } r -= I_G;
            if (r < I_G) { transpose_item(AIN(22), DM, DFF, Wgu2, 2, scr, r, lane); continue; } r -= I_G;
            if (r < I_D) { transpose_item(AIN(23), DFF, DM, Wd2, 0, scr, r, lane); continue; } r -= I_D;
            if (r < I_IN) { transpose_item(AIN(11), DM, 3 * DM, Win, 0, scr, r, lane); continue; } r -= I_IN;
            transpose_item(AIN(12), DM, DM, Wout, 0, scr, r, lane);
        }
    }
    if (G == 0x7ffffff0) grid.sync();
    xcd_barrier(bar);
#ifdef EXTRA_SYNCS
    for (int es = 0; es < EXTRA_SYNCS; ++es) xcd_barrier(bar);
#endif
    if (PH(1)) REP(1) rowpass<false, true>(AIN(0), nullptr, nullptr, H, nullptr, modp, 0, 0.f, AIN(4), 1, 0, gw, lane);
    xcd_barrier(bar);
    if (PH(2)) REP(2) { pg8::Gemm g{H, Wgu1, M, 2 * DFF, DM}; pg8::StaticOrder S; S.init(M, 2 * DFF, G, bx, WGM_GU); pg8::EpiSwiglu E{ACT, DFF};
      pg8::gemm_phase<pg8::EpiSwiglu, pg8::StaticOrder, true, true>(lds, g, S, E); }
    xcd_barrier(bar);
    if (PH(3)) REP(3) { pg8::Gemm g{ACT, Wd1, M, DM, DFF}; pg8::StaticOrder S; S.init(M, DM, G, bx, WGM_N1K, 1); pg8::EpiBf16Out E{(bf16*)F, DM};
      pg8::gemm_phase<pg8::EpiBf16Out, pg8::StaticOrder, true, true>(lds, g, S, E); }
    xcd_barrier(bar);
    if (PH(4)) REP(4) rowpass<true, true, false, true>(AIN(0), (const bf16*)F, XB, H, AIN(5), modp, 2, 0.5f, AIN(9), 4, 3, gw, lane);
    xcd_barrier(bar);
    if (PH(5)) REP(5) { pg8::Gemm g{H, Win, M, 3 * DM, DM}; pg8::StaticOrder S; S.init(M, 3 * DM, G, bx, WGM_IN); pg8::EpiProj E{QK, VtD, VtS, C2, SEQ, ctlw + CW_KINF};
      pg8::gemm_phase<pg8::EpiProj, pg8::StaticOrder, true, true>(lds, g, S, E); }
    xcd_barrier(bar);
    if (PH(6)) {
        const unsigned* kinfw = ctlw + CW_KINF;
        LAS unsigned* uslot = (LAS unsigned*)(lds + att::FLAG_OFF + 128);
        const unsigned myx = xb_xcc_id() & 7u;
        for (int qi = 0; qi < 8; ++qi) {
            const unsigned xq = (myx + (unsigned)qi) & 7u;
            unsigned* qctr = ctlw + CW_QUEUE + 64 * xq;
            for (;;) {
                if (tid == 0) *uslot = atomicAdd(qctr, 1u);
                __syncthreads();
                const unsigned u = *uslot;
                __syncthreads();
                if (u >= 128u) break;
                const int h = 3 - (int)(u >> 5), qb = 31 - (int)(u & 31), b = (int)(xq >> 1), vh = 2 * h + (int)(xq & 1);
                const float slope2 = 1.4426950408889634f * exp2f(-2.0f * (float)(h + 1));
                const float kinfa = __uint_as_float(kinfw[(b * 8 + vh) * 2]), kinfb = __uint_as_float(kinfw[(b * 8 + vh) * 2 + 1]);
                att::attn_unit<0, 128>(lds, QK, vh * 64, 512 + vh * 64, VtD + ((size_t)(b * 512 + h * 128)) * SEQ, (size_t)b * SEQ, qb, slope2, kinfa, kinfb, F, nullptr, vh * 128);
            }
        }
        {
            unsigned* qctr = ctlw + CW_QUEUE + 64 * 8;
            for (;;) {
                if (tid == 0) *uslot = atomicAdd(qctr, 1u);
                __syncthreads();
                const unsigned u = *uslot;
                __syncthreads();
                if (u >= 1024u) break;
                const int v = (int)u, qb = 31 - (v >> 5), b = (v & 31) >> 3, h = v & 7;
                att::attn_unit<1, 64>(lds, QK, 1024 + h * 64, 1536 + h * 64, VtS + ((size_t)(b * 512 + h * 64)) * SEQ, (size_t)b * SEQ, qb, 0.f, 0.f, 0.f, nullptr, Osb, h * 64);
            }
        }
    }
    xcd_barrier(bar);
    if (PH(7)) REP(7) rowpass_attn(F, Osb, H, AIN(17), AIN(18), ctl[0], gw, lane);
    xcd_barrier(bar);
    if (PH(8)) REP(8) { pg8::Gemm g{H, Wout, M, DM, DM}; pg8::StaticOrder S; S.init(M, DM, G, bx, WGM_N1K); pg8::EpiBf16Out E{(bf16*)F, DM};
      pg8::gemm_phase<pg8::EpiBf16Out, pg8::StaticOrder, true, true>(lds, g, S, E); }
    xcd_barrier(bar);
    if (PH(9)) REP(9) rowpass<true, true, true, true>(XB, (const bf16*)F, XB, H, AIN(10), modp, 5, 1.0f, AIN(19), 7, 6, gw, lane);
    xcd_barrier(bar);
    if (PH(10)) REP(10) { pg8::Gemm g{H, Wgu2, M, 2 * DFF, DM}; pg8::StaticOrder S; S.init(M, 2 * DFF, G, bx, WGM_GU); pg8::EpiSwiglu E{ACT, DFF};
      pg8::gemm_phase<pg8::EpiSwiglu, pg8::StaticOrder, true, true>(lds, g, S, E); }
    xcd_barrier(bar);
    if (PH(11)) REP(11) { pg8::Gemm g{ACT, Wd2, M, DM, DFF}; pg8::StaticOrder S; S.init(M, DM, G, bx, WGM_N1K, 1); pg8::EpiBf16Out E{(bf16*)F, DM};
      pg8::gemm_phase<pg8::EpiBf16Out, pg8::StaticOrder, true, true>(lds, g, S, E); }
    xcd_barrier(bar);
    if (PH(12)) REP(12) rowpass<true, false, true, false>(XB, (const bf16*)F, out, nullptr, AIN(20), modp, 8, 0.5f, nullptr, 0, 0, gw, lane);
}
#undef ctl
#undef modp
#undef out
#undef Wgu1
#undef Wd1
#undef Win
#undef Wout
#undef Wgu2
#undef Wd2
#undef H
#undef F
#undef ACT
#undef QK
#undef VtD
#undef VtS
#undef Osb
#undef XB

#undef tid
#undef lane
extern "C" void kernel_launch(void* const* d_in, const int* in_sizes, int n_in, void* d_out, int out_size, void* d_ws, size_t ws_size, hipStream_t stream) {
    static int grid = 0;
    if (grid == 0) {
        if (n_in != 24 || out_size != M * DM || ws_size < WS_END) { fprintf(stderr, "kernel_launch: unexpected shapes (n_in %d out %d ws %zu)\n", n_in, out_size, ws_size); grid = -1; return; }
        int dev = 0, cus = 0, per_cu = 0;
        hipGetDevice(&dev); hipDeviceGetAttribute(&cus, hipDeviceAttributeMultiprocessorCount, dev);
        if (hipFuncSetAttribute((const void*)fwd_megakernel, hipFuncAttributeMaxDynamicSharedMemorySize, LDS_BYTES) != hipSuccess) { fprintf(stderr, "kernel_launch: hipFuncSetAttribute failed\n"); grid = -1; return; }
        if (hipOccupancyMaxActiveBlocksPerMultiprocessor(&per_cu, (const void*)fwd_megakernel, 512, LDS_BYTES) != hipSuccess || per_cu < 1) { fprintf(stderr, "kernel_launch: occupancy query says %d blocks per CU\n", per_cu); per_cu = 1; }
        (void)hipGetLastError();
        if (cus < 256) { fprintf(stderr, "kernel_launch: built for a 256-CU device (got %d CUs)\n", cus); grid = -1; return; }
        grid = 256;
    }
    if (grid < 0) return;
    if (hipMemsetAsync((char*)d_ws + WS_CTLW, 0, CTLW_BYTES, stream) != hipSuccess) { fprintf(stderr, "kernel_launch: memset of the control words failed\n"); return; }
    Args a{};
    for (int i = 0; i < 24; ++i) a.in[i] = (const float*)d_in[i];
    a.out = (float*)d_out; a.ws = (unsigned char*)d_ws;
    void* kargs[] = {&a};
    hipError_t e = hipLaunchCooperativeKernel((const void*)fwd_megakernel, dim3(grid), dim3(512), kargs, LDS_BYTES, stream);
    if (e != hipSuccess) fprintf(stderr, "cooperative launch failed: %s (grid %d)\n", hipGetErrorString(e), grid);
}
```

```cpp
#include <hip/hip_runtime.h>
#include <hip/hip_cooperative_groups.h>
#include <cstdio>
#include <cstdint>
#include <cmath>
namespace cg = cooperative_groups;
namespace pg8 {
#define PG8_LAS __attribute__((address_space(3)))
typedef unsigned short bf16_t;
typedef short bf16x8 __attribute__((ext_vector_type(8)));
typedef float f32x4 __attribute__((ext_vector_type(4)));
typedef unsigned u32x4 __attribute__((ext_vector_type(4)));
constexpr int BM = 256, BK = 64, HALF = 128, HTB = HALF * BK * 2  , STAGE_BYTES = 8 * HTB, NXCD = 8, WGM = 8;

__host__ __device__ __forceinline__ int lds_byte(int r, int c) { const int st = (r >> 4) * 2 + (c >> 5), rr = r & 15, cc = c & 31, ob = rr * 64 + cc * 2; return st * 1024 + (ob ^ (((ob >> 9) & 1) << 5)); }
__host__ __device__ __forceinline__ void stage_rc(int b, int& R, int& C) { const int st = b / 1024, sb = b % 1024, swz = sb ^ (((sb >> 9) & 1) << 5); R = (st >> 1) * 16 + swz / 64; C = (st & 1) * 32 + (swz % 64) / 2; }
__host__ __device__ __forceinline__ int perm32(int rho) { const int n = rho >> 4, i = rho & 15; return 8 * (i >> 2) + 4 * n + (i & 3); }

struct Unit { int pm, pn; };
struct Gemm { const bf16_t* A; const bf16_t* Bt; int M, N, K; };

struct StaticOrder {
    int nM, nN, nwg, G, c, wgm, rev;
    __host__ __device__ void init(int M, int N, int G_, int c_, int wgm_ = WGM, int rev_ = 0) { nM = M / BM; nN = N / BM; nwg = nM * nN; G = G_; c = c_; wgm = wgm_; rev = rev_; }
    __host__ __device__ bool next(int i, Unit& u) const {
        const long L = (long)i * G + c; if (L >= nwg) return false;
        int wgid = (int)L; { const int q = nwg / NXCD, r = nwg % NXCD, xcd = wgid % NXCD, off = wgid / NXCD; wgid = (xcd < r ? xcd * (q + 1) : r * (q + 1) + (xcd - r) * q) + off; }
        if (rev) wgid = nwg - 1 - wgid;
        const int nig = wgm * nN, gid = wgid / nig, fm = gid * wgm, gsz = (nM - fm) < wgm ? (nM - fm) : wgm;
        u.pm = fm + ((wgid % nig) % gsz); u.pn = (wgid % nig) / gsz; return true;
    }
    __device__ __forceinline__ void a_ready(const Unit&) const {}
    __device__ __forceinline__ void done(const Unit&) const {}
};

__device__ __forceinline__ unsigned cvt_pk_bf16(float lo, float hi) { unsigned r; asm volatile("v_cvt_pk_bf16_f32 %0, %1, %2" : "=v"(r) : "v"(lo), "v"(hi)); return r; }
#define PG8_GAS __attribute__((address_space(1)))
__device__ __forceinline__ float silu_mul(float g, float u) { const float e = __builtin_amdgcn_exp2f(g * -1.4426950408889634f); return g * __builtin_amdgcn_rcpf(1.0f + e) * u; }
struct EpiSwiglu {
    static constexpr bool PERM = true, AFTER_DRAIN = false;
    bf16_t* O; int ldc;
    __device__ __forceinline__ void operator()(const f32x4 (&acc)[2][2][4][2], const Unit& u, int wr, int wc, int fr, int fq) const {
        const int row0 = u.pm * BM + wr * 64 + fr; const int col0 = u.pn * HALF + wc * 32 + 8 * fq;
#pragma unroll
        for (int ai = 0; ai < 2; ++ai)
#pragma unroll
            for (int m = 0; m < 4; ++m) { bf16_t* rowp = O + (size_t)(row0 + ai * HALF + m * 16) * ldc + col0;
                const f32x4 g0 = acc[ai][0][m][0], g1 = acc[ai][0][m][1], u0 = acc[ai][1][m][0], u1 = acc[ai][1][m][1];
                u32x4 w; w.x = cvt_pk_bf16(silu_mul(g0[0], u0[0]), silu_mul(g0[1], u0[1])); w.y = cvt_pk_bf16(silu_mul(g0[2], u0[2]), silu_mul(g0[3], u0[3]));
                w.z = cvt_pk_bf16(silu_mul(g1[0], u1[0]), silu_mul(g1[1], u1[1])); w.w = cvt_pk_bf16(silu_mul(g1[2], u1[2]), silu_mul(g1[3], u1[3]));
                *(PG8_GAS u32x4*)rowp = w; }
    }
};
struct EpiBf16Out {
    static constexpr bool PERM = true, AFTER_DRAIN = false;
    bf16_t* O; int ldc;
    __device__ __forceinline__ void operator()(const f32x4 (&acc)[2][2][4][2], const Unit& u, int wr, int wc, int fr, int fq) const {
        const int row0 = u.pm * BM + wr * 64 + fr; const int col0 = u.pn * BM + wc * 32 + 8 * fq;
#pragma unroll
        for (int ai = 0; ai < 2; ++ai)
#pragma unroll
            for (int m = 0; m < 4; ++m) { bf16_t* rowp = O + (size_t)(row0 + ai * HALF + m * 16) * ldc + col0;
#pragma unroll
                for (int bj = 0; bj < 2; ++bj) { const f32x4 v0 = acc[ai][bj][m][0], v1 = acc[ai][bj][m][1];
                    u32x4 w; w.x = cvt_pk_bf16(v0[0], v0[1]); w.y = cvt_pk_bf16(v0[2], v0[3]); w.z = cvt_pk_bf16(v1[0], v1[1]); w.w = cvt_pk_bf16(v1[2], v1[3]);
                    *(PG8_GAS u32x4*)(rowp + bj * HALF) = w; } }
    }
};
struct EpiProj {
    static constexpr bool PERM = true, AFTER_DRAIN = false;
    bf16_t* QK; bf16_t* VtD; bf16_t* VtS; float qscale; int S; unsigned* kinf;
    __device__ __forceinline__ void operator()(const f32x4 (&acc)[2][2][4][2], const Unit& u, int wr, int wc, int fr, int fq) const {
        const int seg = u.pn >> 1, half = u.pn & 1;
        if (seg == 2 || seg == 5) {
            bf16_t* Vt = (seg == 2) ? VtD : VtS;
            const int row_t = u.pm * BM; const int b = row_t / S, t0 = row_t - b * S;
#pragma unroll
            for (int ai = 0; ai < 2; ++ai)
#pragma unroll
                for (int m = 0; m < 4; ++m) { const int t = t0 + ai * HALF + wr * 64 + m * 16 + fr; const int pos = (t & ~12) | ((t & 4) << 1) | ((t & 8) >> 1);
#pragma unroll
                    for (int bj = 0; bj < 2; ++bj)
#pragma unroll
                        for (int n = 0; n < 2; ++n) { const int ch = 256 * half + 128 * bj + 32 * wc + 8 * fq + 4 * n;
                            const f32x4 v = acc[ai][bj][m][n]; const unsigned w0 = cvt_pk_bf16(v[0], v[1]), w1 = cvt_pk_bf16(v[2], v[3]);
                            const unsigned snd = (fr & 1) ? w0 : w1;
                            const unsigned rcv = (unsigned)__builtin_amdgcn_update_dpp(0, (int)snd, 0xB1, 0xF, 0xF, true);
                            const unsigned lo = (fr & 1) ? rcv : w0, hi2 = (fr & 1) ? w1 : rcv;
                            const unsigned s0 = (lo & 0xffffu) | (hi2 << 16), s1 = (lo >> 16) | (hi2 & 0xffff0000u);
                            PG8_GAS bf16_t* p = (PG8_GAS bf16_t*)(Vt + ((size_t)(b * 512 + ch + 2 * (fr & 1))) * S + (pos & ~1));
                            *(PG8_GAS unsigned*)p = s0; *(PG8_GAS unsigned*)(p + (size_t)S) = s1; } }
        } else {
            const int cbase = ((seg == 0) ? 0 : (seg == 1) ? 512 : (seg == 3) ? 1024 : 1536) + 256 * half + wc * 32 + 8 * fq;
            const float sc = (seg == 0 || seg == 3) ? qscale : 1.0f;
            const int row0 = u.pm * BM + wr * 64 + fr;
#pragma unroll
            for (int ai = 0; ai < 2; ++ai)
#pragma unroll
                for (int m = 0; m < 4; ++m) { bf16_t* rowp = QK + (size_t)(row0 + ai * HALF + m * 16) * 2048 + cbase;
#pragma unroll
                    for (int bj = 0; bj < 2; ++bj) { const f32x4 v0 = acc[ai][bj][m][0] * sc, v1 = acc[ai][bj][m][1] * sc;
                        u32x4 w; w.x = cvt_pk_bf16(v0[0], v0[1]); w.y = cvt_pk_bf16(v0[2], v0[3]); w.z = cvt_pk_bf16(v1[0], v1[1]); w.w = cvt_pk_bf16(v1[2], v1[3]);
                        *(PG8_GAS u32x4*)(rowp + bj * HALF) = w; } }
            if (seg == 1) {
                const int b = (u.pm * BM) / S;
#pragma unroll
                for (int bj = 0; bj < 2; ++bj) { float v = 0.f;
#pragma unroll
                    for (int ai = 0; ai < 2; ++ai)
#pragma unroll
                        for (int m = 0; m < 4; ++m) { const f32x4 x = acc[ai][bj][m][0], y = acc[ai][bj][m][1];
                            float s2 = (x[0] * x[0] + x[1] * x[1]) + (x[2] * x[2] + x[3] * x[3]) + (y[0] * y[0] + y[1] * y[1]) + (y[2] * y[2] + y[3] * y[3]);
                            s2 += __shfl_xor(s2, 16); s2 += __shfl_xor(s2, 32);
                            v = fmaxf(v, s2); }
#pragma unroll
                    for (int o = 1; o < 16; o <<= 1) v = fmaxf(v, __shfl_xor(v, o));
                    if (fr == 0 && fq == 0) atomicMax(kinf + (b * 8 + 4 * half + 2 * bj + (wc >> 1)) * 2 + (wc & 1), __float_as_uint(v)); }
            }
        }
    }
};

template <class Epi, class Sched, bool ALIGN_EPI = false, bool SP2 = false>
__device__ __forceinline__ void gemm_phase(PG8_LAS unsigned char* lds, const Gemm g, const Sched& S, const Epi& E) {
    int tid_l = threadIdx.x; asm volatile("" : "+v"(tid_l));
    const int tid = tid_l, wid = __builtin_amdgcn_readfirstlane(tid >> 6), lane = tid & 63, wr = wid >> 2, wc = wid & 3, fr = lane & 15, fq = lane >> 4;
    const int K = g.K, nt = K / BK;
    unsigned voffA[2], voffB[2];
#pragma unroll
    for (int i = 0; i < 2; ++i) { int R, C; stage_rc(tid * 16 + i * 8192, R, C); const int Rb = Epi::PERM ? ((R & ~31) + perm32(R & 31)) : R;
        voffA[i] = (unsigned)(R * K + C) * 2u; voffB[i] = (unsigned)(Rb * K + C) * 2u; }
    const size_t kstep = (size_t)(BK * 2);
    const size_t hstep = (size_t)HALF * K * 2;
    const size_t tstep = 2 * hstep;
    const unsigned ldsw = (unsigned)wid * 1024u;
    const int aoff = lds_byte(wr * 64 + fr, fq * 8), boff = lds_byte(wc * 32 + fr, fq * 8);
#define PG8_SA(b, h) (((b) * 2 + (h)) * HTB)
#define PG8_SB(b, h) ((4 + (b) * 2 + (h)) * HTB)
#define PG8_STAGE(bufoff, gbase, voff) do { _Pragma("unroll") for (int _i = 0; _i < 2; ++_i) \
        __builtin_amdgcn_global_load_lds((const unsigned*)((const char*)(gbase) + (voff)[_i]), (PG8_LAS unsigned*)(lds + (bufoff) + ldsw + _i * 8192), 16, 0, 0); } while (0)
#define PG8_LDA(dst, b, h) do { _Pragma("unroll") for (int m = 0; m < 4; ++m) _Pragma("unroll") for (int k = 0; k < 2; ++k) dst[m][k] = *(const PG8_LAS bf16x8*)(lds + PG8_SA(b, h) + aoff + m * 2048 + k * 1024); } while (0)
#define PG8_LDB(dst, b, h) do { _Pragma("unroll") for (int n = 0; n < 2; ++n) _Pragma("unroll") for (int k = 0; k < 2; ++k) dst[n][k] = *(const PG8_LAS bf16x8*)(lds + PG8_SB(b, h) + boff + n * 2048 + k * 1024); } while (0)
#define PG8_MMA(ai, bj, At, Bt) do { __builtin_amdgcn_s_setprio(1); _Pragma("unroll") for (int m = 0; m < 4; ++m) _Pragma("unroll") for (int n = 0; n < 2; ++n) _Pragma("unroll") for (int k = 0; k < 2; ++k) \
        acc[ai][bj][m][n] = __builtin_amdgcn_mfma_f32_16x16x32_bf16(Bt[n][k], At[m][k], acc[ai][bj][m][n], 0, 0, 0); __builtin_amdgcn_s_setprio(0); } while (0)
#define PG8_WAIT_V(n) asm volatile("s_waitcnt vmcnt(" #n ")" ::: "memory")
#define PG8_WAIT_L(n) asm volatile("s_waitcnt lgkmcnt(" #n ")" ::: "memory")
#define PG8_BAR __builtin_amdgcn_s_barrier()
#define PG8_SCHED __builtin_amdgcn_sched_barrier(0)
    Unit cur, nxt; int ui = 0;
    if (!S.next(0, cur)) return;
    f32x4 acc[2][2][4][2];
#pragma unroll
    for (int a = 0; a < 2; ++a)
#pragma unroll
        for (int b = 0; b < 2; ++b)
#pragma unroll
            for (int m = 0; m < 4; ++m)
#pragma unroll
                for (int n = 0; n < 2; ++n) acc[a][b][m][n] = (f32x4){0.f, 0.f, 0.f, 0.f};
    bf16x8 At[4][2], B0[2][2], B1[2][2];
    const char* cA = (const char*)g.A + (size_t)cur.pm * tstep; const char* cB = (const char*)g.Bt + (size_t)cur.pn * tstep;
    S.a_ready(cur);
    if constexpr (SP2) {
        PG8_STAGE(PG8_SB(0, 0), cB, voffB); PG8_STAGE(PG8_SB(0, 1), cB + hstep, voffB); PG8_STAGE(PG8_SA(0, 0), cA, voffA); PG8_STAGE(PG8_SA(0, 1), cA + hstep, voffA);
        if (wr == 1) PG8_BAR;
        PG8_WAIT_V(2); PG8_BAR;
        PG8_STAGE(PG8_SB(1, 0), cB + kstep, voffB); PG8_STAGE(PG8_SA(1, 0), cA + kstep, voffA); PG8_STAGE(PG8_SB(1, 1), cB + hstep + kstep, voffB);
        PG8_WAIT_V(6); PG8_BAR;
    } else {
        PG8_STAGE(PG8_SB(0, 0), cB, voffB); PG8_STAGE(PG8_SA(0, 0), cA, voffA); PG8_STAGE(PG8_SB(0, 1), cB + hstep, voffB); PG8_STAGE(PG8_SA(0, 1), cA + hstep, voffA);
        if (wr == 1) PG8_BAR;
        PG8_WAIT_V(4); PG8_BAR;
        PG8_STAGE(PG8_SB(1, 0), cB + kstep, voffB); PG8_STAGE(PG8_SA(1, 0), cA + kstep, voffA); PG8_STAGE(PG8_SB(1, 1), cB + hstep + kstep, voffB);
        PG8_WAIT_V(6); PG8_BAR;
    }
    for (;;) {
        const bool has_next = S.next(ui + 1, nxt);
        const char* nA = has_next ? (const char*)g.A + (size_t)nxt.pm * tstep : cA; const char* nB = has_next ? (const char*)g.Bt + (size_t)nxt.pn * tstep : cB;
        for (int t = 0; t < nt; t += 2) {
            const bool last = (t == nt - 2);
            const char* a1 = cA + (size_t)(t + 1) * kstep;
            const char* a2 = last ? nA : cA + (size_t)(t + 2) * kstep; const char* b2 = last ? nB : cB + (size_t)(t + 2) * kstep;
            const char* a3 = a2 + kstep; const char* b3 = b2 + kstep;
            if (last && has_next) S.a_ready(nxt);
            if constexpr (SP2) {
            PG8_LDB(B0, 0, 0); PG8_LDB(B1, 0, 1); PG8_SCHED; PG8_LDA(At, 0, 0); PG8_STAGE(PG8_SA(1, 1), a1 + hstep, voffA);
            PG8_WAIT_V(8); PG8_WAIT_L(0); PG8_BAR; PG8_MMA(0, 0, At, B0); PG8_MMA(0, 1, At, B1); PG8_BAR; PG8_SCHED;
            PG8_LDA(At, 0, 1); PG8_STAGE(PG8_SB(0, 0), b2, voffB); PG8_STAGE(PG8_SB(0, 1), b2 + hstep, voffB); PG8_STAGE(PG8_SA(0, 0), a2, voffA);
            PG8_WAIT_V(8); PG8_WAIT_L(0); PG8_BAR; PG8_MMA(1, 0, At, B0); PG8_MMA(1, 1, At, B1); PG8_BAR; PG8_SCHED;
            PG8_LDB(B0, 1, 0); PG8_LDB(B1, 1, 1); PG8_SCHED; PG8_LDA(At, 1, 0); PG8_STAGE(PG8_SA(0, 1), a2 + hstep, voffA);
            PG8_WAIT_V(8); PG8_WAIT_L(0); PG8_BAR; PG8_MMA(0, 0, At, B0); PG8_MMA(0, 1, At, B1); PG8_BAR; PG8_SCHED;
            PG8_LDA(At, 1, 1); PG8_STAGE(PG8_SB(1, 0), b3, voffB); PG8_STAGE(PG8_SB(1, 1), b3 + hstep, voffB); PG8_STAGE(PG8_SA(1, 0), a3, voffA);
            PG8_WAIT_V(8); PG8_WAIT_L(0); PG8_BAR; PG8_MMA(1, 0, At, B0); PG8_MMA(1, 1, At, B1); PG8_BAR; PG8_SCHED;
            } else {
            PG8_LDB(B0, 0, 0); PG8_SCHED; PG8_LDA(At, 0, 0); PG8_STAGE(PG8_SA(1, 1), a1 + hstep, voffA);
            PG8_WAIT_L(8); PG8_BAR; PG8_WAIT_L(0); PG8_MMA(0, 0, At, B0); PG8_BAR; PG8_SCHED;
            PG8_LDB(B1, 0, 1); PG8_STAGE(PG8_SB(0, 0), b2, voffB);
            PG8_BAR; PG8_WAIT_L(0); PG8_MMA(0, 1, At, B1); PG8_BAR;
            PG8_LDA(At, 0, 1); PG8_STAGE(PG8_SA(0, 0), a2, voffA);
            PG8_BAR; PG8_WAIT_L(0); PG8_MMA(1, 0, At, B0); PG8_BAR; PG8_SCHED;
            PG8_STAGE(PG8_SB(0, 1), b2 + hstep, voffB);
            PG8_WAIT_V(6); PG8_BAR; PG8_MMA(1, 1, At, B1); PG8_BAR;
            PG8_LDB(B0, 1, 0); PG8_SCHED; PG8_LDA(At, 1, 0); PG8_STAGE(PG8_SA(0, 1), a2 + hstep, voffA);
            PG8_WAIT_L(8); PG8_BAR; PG8_WAIT_L(0); PG8_MMA(0, 0, At, B0); PG8_BAR; PG8_SCHED;
            PG8_LDB(B1, 1, 1); PG8_STAGE(PG8_SB(1, 0), b3, voffB);
            PG8_BAR; PG8_WAIT_L(0); PG8_MMA(0, 1, At, B1); PG8_BAR;
            PG8_LDA(At, 1, 1); PG8_STAGE(PG8_SA(1, 0), a3, voffA);
            PG8_BAR; PG8_WAIT_L(0); PG8_MMA(1, 0, At, B0); PG8_BAR; PG8_SCHED;
            PG8_STAGE(PG8_SB(1, 1), b3 + hstep, voffB);
            PG8_WAIT_V(6); PG8_BAR; PG8_MMA(1, 1, At, B1); PG8_BAR;
            }
        }
        if constexpr (ALIGN_EPI) { if (wr == 0) PG8_BAR; }
        if constexpr (!Epi::AFTER_DRAIN) { E(acc, cur, wr, wc, fr, fq); S.done(cur); }
        if (!has_next) break;
#pragma unroll
        for (int a = 0; a < 2; ++a)
#pragma unroll
            for (int b = 0; b < 2; ++b)
#pragma unroll
                for (int m = 0; m < 4; ++m)
#pragma unroll
                    for (int n = 0; n < 2; ++n) acc[a][b][m][n] = (f32x4){0.f, 0.f, 0.f, 0.f};
        cur = nxt; cA = nA; cB = nB; ++ui;
        if constexpr (ALIGN_EPI) { if (wr == 1) PG8_BAR; }
    }
    PG8_WAIT_V(0);
    if constexpr (!ALIGN_EPI) { if (wr == 0) PG8_BAR; }
    PG8_BAR;
    if constexpr (Epi::AFTER_DRAIN) { E.fused(acc, cur, wr, wc, fr, fq, lds, wid, lane); S.done(cur); }
#undef PG8_SA
#undef PG8_SB
#undef PG8_STAGE
#undef PG8_LDA
#undef PG8_LDB
#undef PG8_MMA
#undef PG8_WAIT_V
#undef PG8_WAIT_L
#undef PG8_BAR
#undef PG8_SCHED
}
}

#define LAS __attribute__((address_space(3)))
#define GAS __attribute__((address_space(1)))
typedef unsigned short bf16;
typedef float f32x4 __attribute__((ext_vector_type(4)));
typedef float f32x2 __attribute__((ext_vector_type(2)));
typedef float f32x16 __attribute__((ext_vector_type(16)));
typedef short bf16x8 __attribute__((ext_vector_type(8)));
typedef unsigned u32x4 __attribute__((ext_vector_type(4)));
typedef unsigned u32x2 __attribute__((ext_vector_type(2)));
constexpr int NB = 4, SEQ = 8192, DM = 1024, DFF = 2816, M = NB * SEQ, NMOD = 9;
constexpr float RMS_EPS = 1e-6f;
constexpr float C2 = 0.125f * 1.4426950408889634f;
constexpr size_t MiB = 1u << 20;
constexpr size_t WS_CTL = 0;
constexpr size_t WS_WGU1 = 1 * MiB, WS_WD1 = 12 * MiB, WS_WIN = 18 * MiB, WS_WOUT = 24 * MiB, WS_WGU2 = 26 * MiB, WS_WD2 = 37 * MiB;
constexpr size_t WS_H = 48 * MiB;
constexpr size_t WS_F = 112 * MiB;
constexpr size_t WS_XB = 176 * MiB;
constexpr size_t WS_ACT = 240 * MiB;
constexpr size_t WS_VTD = 416 * MiB, WS_VTS = 448 * MiB;
constexpr size_t WS_OSB = 480 * MiB;
constexpr size_t WS_END = 512 * MiB;
constexpr int GEMM_LDS = 131072, LDS_BYTES = GEMM_LDS + 1024;
constexpr size_t WS_CTLW = 512 * 1024, CTLW_BYTES = 32 * 1024;
constexpr int CW_KINF = 4096, CW_QUEUE = 4160;

template <int CTRL> __device__ __forceinline__ float dpp_f(float v) { return __builtin_bit_cast(float, __builtin_amdgcn_update_dpp(0, __builtin_bit_cast(int, v), CTRL, 0xF, 0xF, true)); }
__device__ __forceinline__ float row16_sum(float v) {
    v += dpp_f<0xB1>(v);
    v += dpp_f<0x4E>(v);
    v += dpp_f<0x141>(v);
    v += dpp_f<0x140>(v);
    return v;
}
__device__ __forceinline__ float xrow_sum(float v) {
    { auto rr = __builtin_amdgcn_permlane16_swap(__float_as_uint(v), __float_as_uint(v), false, false); v = __uint_as_float(rr[0]) + __uint_as_float(rr[1]); }
    { auto rr = __builtin_amdgcn_permlane32_swap(__float_as_uint(v), __float_as_uint(v), false, false); v = __uint_as_float(rr[0]) + __uint_as_float(rr[1]); }
    return v;
}
__device__ __forceinline__ float wave_sum(float v) { return xrow_sum(row16_sum(v)); }
__device__ __forceinline__ unsigned pk_bf16(float lo, float hi) { return pg8::cvt_pk_bf16(lo, hi); }
__device__ __forceinline__ float bf2f(unsigned short h) { return __uint_as_float(((unsigned)h) << 16); }

namespace att {
constexpr int KSTR = 144;
constexpr int KBUFB = 64 * KSTR, STAGEB = KBUFB + 128 * KSTR;
constexpr int FLAG_OFF = 2 * STAGEB;
constexpr float THR = -48.0f;
__device__ __forceinline__ int crow(int r, int hi) { return (r & 3) + 8 * (r >> 2) + 4 * hi; }
typedef __bf16 bf16x2_t __attribute__((ext_vector_type(2)));
__device__ __forceinline__ unsigned cvtpk_c(float lo, float hi) { const f32x2 v = {lo, hi}; const bf16x2_t b = __builtin_convertvector(v, bf16x2_t); return __builtin_bit_cast(unsigned, b); }
__device__ __forceinline__ bf16x8 pack8(const f32x16& p, int b) {
    u32x4 w; w.x = cvtpk_c(p[b], p[b + 1]); w.y = cvtpk_c(p[b + 2], p[b + 3]); w.z = cvtpk_c(p[b + 4], p[b + 5]); w.w = cvtpk_c(p[b + 6], p[b + 7]);
    return __builtin_bit_cast(bf16x8, w);
}
#define MFMA32(a, b, c) __builtin_amdgcn_mfma_f32_32x32x16_bf16((a), (b), (c), 0, 0, 0)
__device__ __forceinline__ float max3f(float a, float b, float c) { float r; asm("v_max3_f32 %0, %1, %2, %3" : "=v"(r) : "v"(a), "v"(b), "v"(c)); return r; }
__device__ __forceinline__ float xhalf_max(float m) { auto rr = __builtin_amdgcn_permlane32_swap(__float_as_uint(m), __float_as_uint(m), false, false); return fmaxf(__uint_as_float(rr[0]), __uint_as_float(rr[1])); }
__device__ __forceinline__ float xhalf_sum(float m) { auto rr = __builtin_amdgcn_permlane32_swap(__float_as_uint(m), __float_as_uint(m), false, false); return __uint_as_float(rr[0]) + __uint_as_float(rr[1]); }

template <int MODE, int DV>
__device__ __forceinline__ void attn_unit(LAS unsigned char* lds, const bf16* __restrict__ QK, int qcol, int kcol, const bf16* __restrict__ Vt,
                                          size_t rowbase, int qb, float slope2, float kinfa, float kinfb, float* __restrict__ Of, bf16* __restrict__ Ob, int ocol) {
    constexpr int NDB = DV / 32, NVC = DV / 64, NACC = NDB;
    int tid_l = threadIdx.x; asm volatile("" : "+v"(tid_l));
    const int tid = tid_l, lane = tid & 63, r32 = lane & 31, hi = lane >> 5;
    const int wid = __builtin_amdgcn_readfirstlane(tid >> 6);
    const int q0 = qb * 256, tw0 = q0 + 32 * wid, t = tw0 + r32;
    const int NT = 4 * qb + 4;
    bf16x8 qf[4];
    { const bf16* qp = QK + (rowbase + t) * 2048 + qcol + hi * 8;
#pragma unroll
      for (int ds = 0; ds < 4; ++ds) qf[ds] = *(const GAS bf16x8*)(qp + ds * 16); }
    float rowc = 0.f;
    if (MODE == 0) {
        float sa = 0.f, sb2 = 0.f;
#pragma unroll
        for (int ds = 0; ds < 4; ++ds) { const u32x4 w = __builtin_bit_cast(u32x4, qf[ds]);
            const float e0 = __uint_as_float(w.x << 16), e1 = __uint_as_float(w.x & 0xffff0000u), e2 = __uint_as_float(w.y << 16), e3 = __uint_as_float(w.y & 0xffff0000u);
            const float e4 = __uint_as_float(w.z << 16), e5 = __uint_as_float(w.z & 0xffff0000u), e6 = __uint_as_float(w.w << 16), e7 = __uint_as_float(w.w & 0xffff0000u);
            const float q2 = (e0 * e0 + e1 * e1) + (e2 * e2 + e3 * e3) + (e4 * e4 + e5 * e5) + (e6 * e6 + e7 * e7);
            if (ds < 2) sa += q2; else sb2 += q2; }
        sa = xhalf_sum(sa); sb2 = xhalf_sum(sb2);
        rowc = (sqrtf(sa * kinfa) + sqrtf(sb2 * kinfb)) * 1.02f;
    }
    const int krow = tid >> 3, kch = tid & 7;
    const bf16* ksrc = QK + (rowbase + krow) * 2048 + kcol + kch * 8;
    const unsigned kdst = krow * KSTR + kch * 16;
    const bf16* vsrc = Vt + (size_t)krow * SEQ + kch * 8;
    const unsigned vdst = KBUFB + krow * KSTR + kch * 16;
    const unsigned koff = r32 * KSTR + hi * 16;
    LAS unsigned* flags = (LAS unsigned*)(lds + FLAG_OFF);

    f32x16 o[NACC];
#pragma unroll
    for (int d = 0; d < NACC; ++d)
#pragma unroll
        for (int r = 0; r < 16; ++r) o[d][r] = 0.f;
    float mrun = 0.f, carry = 0.f, lrun = 0.f;
    bool wdone = false, first = true;
    bf16x8 ut0, ut1, uone;
    { const u32x4 c = {0x3F803F80u, 0x3F803F80u, 0x3F803F80u, 0x3F803F80u}; uone = __builtin_bit_cast(bf16x8, c); }
    if (MODE == 1) {
        u32x4 a, b;
        unsigned e0[8], e1[8];
#pragma unroll
        for (int j = 0; j < 8; ++j) { const int jj = 8 * (j >> 2) + 4 * hi + (j & 3); e0[j] = (jj > r32) ? 0x3F80u : 0u; e1[j] = (16 + jj > r32) ? 0x3F80u : 0u; }
        a.x = e0[0] | (e0[1] << 16); a.y = e0[2] | (e0[3] << 16); a.z = e0[4] | (e0[5] << 16); a.w = e0[6] | (e0[7] << 16);
        b.x = e1[0] | (e1[1] << 16); b.y = e1[2] | (e1[3] << 16); b.z = e1[4] | (e1[5] << 16); b.w = e1[6] | (e1[7] << 16);
        ut0 = __builtin_bit_cast(bf16x8, a); ut1 = __builtin_bit_cast(bf16x8, b);
    }
    u32x4 kreg[2], vreg[2][NVC];
#define ATT_LOAD(set_, kt_) do { kreg[set_] = *(const GAS u32x4*)(ksrc + (size_t)(kt_) * 64 * 2048); \
        _Pragma("unroll") for (int i_ = 0; i_ < NVC; ++i_) vreg[set_][i_] = *(const GAS u32x4*)(vsrc + (size_t)i_ * 64 * SEQ + (kt_) * 64); } while (0)
#define ATT_STORE(set_, stg_) do { *(LAS u32x4*)(lds + (stg_) * STAGEB + kdst) = kreg[set_]; \
        _Pragma("unroll") for (int i_ = 0; i_ < NVC; ++i_) *(LAS u32x4*)(lds + (stg_) * STAGEB + vdst + i_ * 64 * KSTR) = vreg[set_][i_]; } while (0)
    ATT_LOAD(0, NT - 1); ATT_LOAD(1, (NT - 2 > 0) ? NT - 2 : 0); ATT_STORE(0, 0);
    __syncthreads();
    int kt = NT - 1; bool fin = false;
    for (;;) {
#pragma unroll
      for (int hh = 0; hh < 2; ++hh) {
        const bool hasn = (kt > 0);
        ATT_LOAD(hh, (kt - 2 > 0) ? kt - 2 : 0);
        const int k0 = kt * 64;
        const LAS unsigned char* sb = lds + hh * STAGEB;
        const bool active = ((MODE == 0) ? (k0 <= tw0 + 31) : (k0 < tw0 + 31)) && !wdone;
        if (active) {
            f32x16 p0, p1;
            if (MODE == 0) {
                const float bb = slope2 * (float)(k0 + 4 * hi - t) - mrun;
#pragma unroll
                for (int r = 0; r < 16; ++r) { const float c = __builtin_fmaf(slope2, (float)((r & 3) + 8 * (r >> 2)), bb); p0[r] = c; p1[r] = __builtin_fmaf(slope2, 32.0f, c); }
            } else {
#pragma unroll
                for (int r = 0; r < 16; ++r) { p0[r] = 0.f; p1[r] = 0.f; }
            }
#pragma unroll
            for (int ds = 0; ds < 4; ++ds) {
                const bf16x8 k0f = *(const LAS bf16x8*)(sb + koff + ds * 32);
                const bf16x8 k1f = *(const LAS bf16x8*)(sb + koff + 32 * KSTR + ds * 32);
                p0 = MFMA32(k0f, qf[ds], p0); p1 = MFMA32(k1f, qf[ds], p1);
            }
            const bool diag = (MODE == 0) ? (k0 + 63 > tw0) : (k0 + 63 >= tw0);
            bf16x8 pf0, pf1, pf2, pf3;
            if (MODE == 0) {
                if (diag) {
#pragma unroll
                    for (int r = 0; r < 16; ++r) { const int key = k0 + crow(r, hi); if (key > t) p0[r] = -INFINITY; if (key + 32 > t) p1[r] = -INFINITY; }
                }
                float mx;
                { float a0 = max3f(p0[0], p0[1], p0[2]), a1 = max3f(p0[3], p0[4], p0[5]), a2 = max3f(p0[6], p0[7], p0[8]), a3 = max3f(p0[9], p0[10], p0[11]);
                  float a4 = max3f(p0[12], p0[13], p0[14]), a5 = max3f(p0[15], p1[0], p1[1]), a6 = max3f(p1[2], p1[3], p1[4]), a7 = max3f(p1[5], p1[6], p1[7]);
                  float a8 = max3f(p1[8], p1[9], p1[10]), a9 = max3f(p1[11], p1[12], p1[13]), a10 = max3f(p1[14], p1[15], a0);
                  a1 = max3f(a1, a2, a3); a4 = max3f(a4, a5, a6); a7 = max3f(a7, a8, a9);
                  mx = xhalf_max(max3f(max3f(a1, a4, a7), a10, a10)); }
                if (first || __any(mx > 6.0f)) {
                    const float dl = first ? mx : fmaxf(mx, 0.f);
#pragma unroll
                    for (int r = 0; r < 16; ++r) { p0[r] -= dl; p1[r] -= dl; }
                    mrun += dl;
                    if (!first) { const float alpha = __builtin_amdgcn_exp2f(-dl); lrun *= alpha;
#pragma unroll
                        for (int d = 0; d < NACC; ++d)
#pragma unroll
                            for (int r = 0; r < 16; ++r) o[d][r] *= alpha; }
                    first = false;
                }
#pragma unroll
                for (int r = 0; r < 16; ++r) { p0[r] = __builtin_amdgcn_exp2f(p0[r]); p1[r] = __builtin_amdgcn_exp2f(p1[r]); }
                { float s0 = p0[0] + p1[0], s1 = p0[1] + p1[1], s2 = p0[2] + p1[2], s3 = p0[3] + p1[3];
#pragma unroll
                  for (int r = 4; r < 16; r += 4) { s0 += p0[r] + p1[r]; s1 += p0[r + 1] + p1[r + 1]; s2 += p0[r + 2] + p1[r + 2]; s3 += p0[r + 3] + p1[r + 3]; }
                  lrun += (s0 + s1) + (s2 + s3); }
                pf0 = pack8(p0, 0); pf1 = pack8(p0, 8); pf2 = pack8(p1, 0); pf3 = pack8(p1, 8);
                wdone = __all(rowc - slope2 * (float)(t - k0 + 1) < mrun - 32.0f) != 0;
            } else {
                float ts = 0.f;
                f32x16 l0, l1;
#pragma unroll
                for (int r = 0; r < 16; ++r) {
                    { const float z = p0[r]; const float e = __builtin_amdgcn_exp2f(-fabsf(z)); const float sp = fmaxf(-z, 0.f) + __builtin_amdgcn_logf(1.0f + e);
                      const float lb = -sp; float lm = lb - z; if (diag && !(k0 + crow(r, hi) < t)) lm = 0.f; l0[r] = lm; ts += lm; p0[r] = lb + carry; }
                    { const float z = p1[r]; const float e = __builtin_amdgcn_exp2f(-fabsf(z)); const float sp = fmaxf(-z, 0.f) + __builtin_amdgcn_logf(1.0f + e);
                      const float lb = -sp; float lm = lb - z; if (diag && !(k0 + 32 + crow(r, hi) < t)) lm = 0.f; l1[r] = lm; ts += lm; p1[r] = lb + carry; }
                }
                const bf16x8 L0a = pack8(l0, 0), L0b = pack8(l0, 8), L1a = pack8(l1, 0), L1b = pack8(l1, 8);
                p0 = MFMA32(ut0, L0a, p0); p0 = MFMA32(ut1, L0b, p0); p0 = MFMA32(uone, L1a, p0); p0 = MFMA32(uone, L1b, p0);
                p1 = MFMA32(ut0, L1a, p1); p1 = MFMA32(ut1, L1b, p1);
#pragma unroll
                for (int r = 0; r < 16; ++r) {
                    float a0 = __builtin_amdgcn_exp2f(p0[r]), a1 = __builtin_amdgcn_exp2f(p1[r]);
                    if (diag) { if (!(k0 + crow(r, hi) < t)) a0 = 0.f; if (!(k0 + 32 + crow(r, hi) < t)) a1 = 0.f; }
                    p0[r] = a0; p1[r] = a1;
                }
                ts = xhalf_sum(ts);
                carry += ts;
                pf0 = pack8(p0, 0); pf1 = pack8(p0, 8); pf2 = pack8(p1, 0); pf3 = pack8(p1, 8);
                wdone = __all(carry < THR) != 0;
            }
#pragma unroll
            for (int d = 0; d < NDB; ++d) {
                const LAS unsigned char* vb = sb + KBUFB + d * 32 * KSTR + koff;
                const bf16x8 v0 = *(const LAS bf16x8*)(vb), v1 = *(const LAS bf16x8*)(vb + 32), v2 = *(const LAS bf16x8*)(vb + 64), v3 = *(const LAS bf16x8*)(vb + 96);
                o[d] = MFMA32(v0, pf0, o[d]); o[d] = MFMA32(v1, pf1, o[d]); o[d] = MFMA32(v2, pf2, o[d]); o[d] = MFMA32(v3, pf3, o[d]);
            }
        }
        if (hasn) ATT_STORE(hh ^ 1, hh ^ 1);
        if (lane == 0) flags[hh * 8 + wid] = wdone ? 1u : 0u;
        __syncthreads();
        if (!hasn) { fin = true; break; }
        { const unsigned f = flags[hh * 8 + (lane & 7)]; if (__all(f != 0u)) { fin = true; break; } }
        --kt;
      }
      if (fin) break;
    }
#undef ATT_LOAD
#undef ATT_STORE
    if (MODE == 0) {
        const float inv = 1.0f / xhalf_sum(lrun);
        bf16* op = (bf16*)Of + (rowbase + t) * 1024 + ocol + 4 * hi;
#pragma unroll
        for (int d = 0; d < NDB; ++d)
#pragma unroll
            for (int g = 0; g < 4; ++g) { u32x2 w; w.x = pk_bf16(o[d][4 * g] * inv, o[d][4 * g + 1] * inv); w.y = pk_bf16(o[d][4 * g + 2] * inv, o[d][4 * g + 3] * inv); *(GAS u32x2*)(op + 32 * d + 8 * g) = w; }
    } else {
        bf16* op = Ob + (rowbase + t) * 512 + ocol + 4 * hi;
#pragma unroll
        for (int d = 0; d < NDB; ++d)
#pragma unroll
            for (int g = 0; g < 4; ++g) { u32x2 w; w.x = pk_bf16(o[d][4 * g], o[d][4 * g + 1]); w.y = pk_bf16(o[d][4 * g + 2], o[d][4 * g + 3]); *(GAS u32x2*)(op + 32 * d + 8 * g) = w; }
    }
}
#undef MFMA32
}

#define XB_TMO      128
#define XB_XCNT(j)  (256  + 64 * (j))
#define XB_XSUB(j)  (1280 + 64 * (j))
#define XB_XGEN(j)  (2304 + 64 * (j))
#define XB_TOP      3328
#define XB_TOPGEN   3392
#define XCD_BAR_WORDS 3456
#define XB_SPIN_CAP (1u << 18)

__device__ __forceinline__ unsigned xb_ld(unsigned* p)              { return __hip_atomic_load(p, __ATOMIC_RELAXED, __HIP_MEMORY_SCOPE_AGENT); }
__device__ __forceinline__ unsigned xb_add(unsigned* p, unsigned v) { return __hip_atomic_fetch_add(p, v, __ATOMIC_RELAXED, __HIP_MEMORY_SCOPE_AGENT); }
__device__ __forceinline__ unsigned xb_xcc_id() { return (unsigned)__builtin_amdgcn_s_getreg((3 << 11) | 20) & 0xFu; }
#define XB_SPIN(cond, bar) do { unsigned _sp = 0; while (cond) { __builtin_amdgcn_s_sleep(1); \
    if ((++_sp & 255u) == 0u) { if (xb_ld(&(bar)[XB_TMO])) break; if (_sp > XB_SPIN_CAP) { atomicAdd(&(bar)[XB_TMO], 1u); break; } } } } while (0)

struct XcdBarrier {
    unsigned* bar; unsigned x;
    volatile LAS unsigned* st;
};

__device__ __forceinline__ XcdBarrier xcd_barrier_post(unsigned* bar, volatile LAS unsigned* st) {
    XcdBarrier b; b.bar = bar; b.x = xb_xcc_id(); b.st = st;
    if (threadIdx.x == 0) (void)xb_add(&bar[XB_XCNT(b.x)], 1u);
    return b;
}
__device__ __forceinline__ void xcd_barrier_complete(unsigned* bar, unsigned x, unsigned& nloc, unsigned& nx) {
    const unsigned G = gridDim.x * gridDim.y * gridDim.z;
    unsigned sum, cnt, mine, sp = 0u;
    for (;;) {
        sum = 0u; cnt = 0u; mine = 0u;
#pragma unroll
        for (unsigned j = 0; j < 16; ++j) { const unsigned c = xb_ld(&bar[XB_XCNT(j)]); sum += c; cnt += (c > 0u) ? 1u : 0u; mine = (j == x) ? c : mine; }
        if (sum == G) break;
        __builtin_amdgcn_s_sleep(1);
        if ((++sp & 255u) == 0u) { if (xb_ld(&bar[XB_TMO])) break; if (sp > XB_SPIN_CAP) { atomicAdd(&bar[XB_TMO], 1u); break; } }
    }
    nloc = mine > 0u ? mine : 1u; nx = cnt > 0u ? cnt : 1u;
}

__device__ __forceinline__ void xcd_barrier(const XcdBarrier& b) {
    asm volatile("s_waitcnt vmcnt(0)" ::: "memory");
    __syncthreads();
    if (threadIdx.x == 0) {
        unsigned* bar = b.bar;
        __builtin_amdgcn_s_waitcnt(0);
        unsigned nloc = b.st[0], nx = b.st[1];
        if (nloc == 0u) { xcd_barrier_complete(bar, b.x, nloc, nx); b.st[0] = nloc; b.st[1] = nx; }
        const unsigned old = xb_add(&bar[XB_XSUB(b.x)], 1u);
        const unsigned gen = old / nloc;
        if (old + 1u == (gen + 1u) * nloc) {
            __builtin_amdgcn_fence(__ATOMIC_RELEASE, "agent");
            asm volatile("s_waitcnt vmcnt(0)" ::: "memory");
            const unsigned og = xb_add(&bar[XB_TOP], 1u);
            const unsigned tg = og / nx;
            if (og + 1u == (tg + 1u) * nx) xb_add(&bar[XB_TOPGEN], 1u);
            else XB_SPIN(xb_ld(&bar[XB_TOPGEN]) == tg, bar);
            __builtin_amdgcn_fence(__ATOMIC_ACQUIRE, "agent");
            xb_add(&bar[XB_XGEN(b.x)], 1u);
            asm volatile("s_waitcnt vmcnt(0)" ::: "memory");
        } else {
            XB_SPIN(xb_ld(&bar[XB_XGEN(b.x)]) == gen, bar);
            __builtin_amdgcn_fence(__ATOMIC_ACQUIRE, "agent");
            asm volatile("s_waitcnt vmcnt(0)" ::: "memory");
        }
    }
    __syncthreads();
}

#ifndef WGM_GU
#define WGM_GU 4
#endif
#ifndef WGM_N1K
#define WGM_N1K 4
#endif
#ifndef WGM_IN
#define WGM_IN 4
#endif
#ifndef PHASE_MASK
#define PHASE_MASK 0xFFFF
#endif
#define PH(n) (((PHASE_MASK) >> (n)) & 1)
#ifndef DUP_MASK
#define DUP_MASK 0
#endif
#ifndef ATT_DUP
#define ATT_DUP 0
#endif
#define REP(n) for (int rep_ = 0; rep_ < 1 + (((DUP_MASK) >> (n)) & 1); ++rep_)
#ifndef ATT_PASS_MASK
#define ATT_PASS_MASK 3
#endif
struct Args { const float* in[24]; float* out; unsigned char* ws; };

__device__ __forceinline__ void transpose_item(const float* __restrict__ W, int K, int N, bf16* __restrict__ WT, int mode, LAS float* scr, int item, int lane) {
    const int nblk = N / 32, kb = item / nblk, nb = item % nblk, k0 = 64 * kb, n0 = 32 * nb;
#pragma unroll
    for (int i = 0; i < 8; ++i) { const int kk = 8 * i + (lane >> 3), nq = 4 * (lane & 7);
        const f32x4 v = __builtin_nontemporal_load((const GAS f32x4*)(W + (size_t)(k0 + kk) * N + n0 + nq)); LAS float* d = scr + kk * 33 + nq; d[0] = v.x; d[1] = v.y; d[2] = v.z; d[3] = v.w; }
    asm volatile("s_waitcnt lgkmcnt(0)" ::: "memory");
    const int c = lane & 7;
#pragma unroll
    for (int j = 0; j < 4; ++j) { const int n = (lane >> 3) + 8 * j; const LAS float* s = scr + (8 * c) * 33 + n;
        u32x4 o; o.x = pk_bf16(s[0 * 33], s[1 * 33]); o.y = pk_bf16(s[2 * 33], s[3 * 33]); o.z = pk_bf16(s[4 * 33], s[5 * 33]); o.w = pk_bf16(s[6 * 33], s[7 * 33]);
        const int ng = n0 + n; const int nr = (mode == 0) ? ng : (256 * (ng >> 7) + (ng & 127) + (mode == 2 ? 128 : 0));
        *(GAS u32x4*)(WT + (size_t)nr * K + k0 + 8 * c) = o; }
    asm volatile("s_waitcnt lgkmcnt(0)" ::: "memory");
}

template <bool HAS_F, bool HAS_H, bool XIN_B = false, bool XOUT_B = false>
__device__ __forceinline__ void rowpass(const void* xin_, const bf16* __restrict__ Fb, void* xout_, bf16* __restrict__ H,
                                        const float* __restrict__ gpost, const float* __restrict__ modp, int gi  , float resw,
                                        const float* __restrict__ gpre, int sci, int shi, int gw, int lane) {
    constexpr int RPW = M / 2048;
    const int row_lo = gw * RPW; const int b = row_lo / SEQ;
    const float* mb = modp + (size_t)b * (NMOD * DM);
    f32x4 Cg[4], A[4], Sh[4];
#pragma unroll
    for (int j = 0; j < 4; ++j) { const int col = 256 * j + 4 * lane;
        if (HAS_F) { const f32x4 g = *(const GAS f32x4*)(mb + gi * DM + col), gp = *(const GAS f32x4*)(gpost + col); Cg[j] = g * gp * resw; }
        if (HAS_H) { const f32x4 s = *(const GAS f32x4*)(mb + sci * DM + col), gp = *(const GAS f32x4*)(gpre + col); A[j] = gp * (s + 1.0f); Sh[j] = *(const GAS f32x4*)(mb + shi * DM + col); } }
    const float* xin = (const float*)xin_; const bf16* xinb = (const bf16*)xin_; float* xout = (float*)xout_; bf16* xoutb = (bf16*)xout_;
#define RP_LDX(dst, r, j) do { if (XIN_B) { const u32x2 w_ = __builtin_nontemporal_load((const GAS u32x2*)(xinb + (size_t)(r) * DM + 256 * (j) + 4 * lane)); \
        dst = (f32x4){__uint_as_float(w_.x << 16), __uint_as_float(w_.x & 0xffff0000u), __uint_as_float(w_.y << 16), __uint_as_float(w_.y & 0xffff0000u)}; } \
      else dst = __builtin_nontemporal_load((const GAS f32x4*)(xin + (size_t)(r) * DM + 256 * (j) + 4 * lane)); } while (0)
    f32x4 xn[4]; u32x2 fn[4];
#pragma unroll
    for (int j = 0; j < 4; ++j) { RP_LDX(xn[j], row_lo, j); if (HAS_F) fn[j] = __builtin_nontemporal_load((const GAS u32x2*)(Fb + (size_t)row_lo * DM + 256 * j + 4 * lane)); }
    for (int row = row_lo; row < row_lo + RPW; ++row) {
        f32x4 x[4]; u32x2 fwv[4];
#pragma unroll
        for (int j = 0; j < 4; ++j) { x[j] = xn[j]; if (HAS_F) fwv[j] = fn[j]; }
        { const int rn = (row + 1 < row_lo + RPW) ? row + 1 : row;
#pragma unroll
          for (int j = 0; j < 4; ++j) { RP_LDX(xn[j], rn, j); if (HAS_F) fn[j] = __builtin_nontemporal_load((const GAS u32x2*)(Fb + (size_t)rn * DM + 256 * j + 4 * lane)); } }
        if (HAS_F) {
            f32x4 f[4]; float ss = 0.f;
#pragma unroll
            for (int j = 0; j < 4; ++j) { const u32x2 fw = fwv[j];
                f[j] = (f32x4){__uint_as_float(fw.x << 16), __uint_as_float(fw.x & 0xffff0000u), __uint_as_float(fw.y << 16), __uint_as_float(fw.y & 0xffff0000u)}; ss += (f[j].x * f[j].x + f[j].y * f[j].y) + (f[j].z * f[j].z + f[j].w * f[j].w); }
            const float rstd = 1.0f / sqrtf(wave_sum(ss) * (1.0f / DM) + RMS_EPS);
#pragma unroll
            for (int j = 0; j < 4; ++j) { x[j] = x[j] + f[j] * rstd * Cg[j];
                if (XOUT_B) { u32x2 w; w.x = pk_bf16(x[j].x, x[j].y); w.y = pk_bf16(x[j].z, x[j].w); *(GAS u32x2*)(xoutb + (size_t)row * DM + 256 * j + 4 * lane) = w;
                    x[j] = (f32x4){__uint_as_float(w.x << 16), __uint_as_float(w.x & 0xffff0000u), __uint_as_float(w.y << 16), __uint_as_float(w.y & 0xffff0000u)}; }
                else __builtin_nontemporal_store(x[j], (GAS f32x4*)(xout + (size_t)row * DM + 256 * j + 4 * lane)); }
        }
        if (HAS_H) {
            float ss = 0.f;
#pragma unroll
            for (int j = 0; j < 4; ++j) ss += (x[j].x * x[j].x + x[j].y * x[j].y) + (x[j].z * x[j].z + x[j].w * x[j].w);
            const float rstd = 1.0f / sqrtf(wave_sum(ss) * (1.0f / DM) + RMS_EPS);
#pragma unroll
            for (int j = 0; j < 4; ++j) { const f32x4 h = x[j] * rstd * A[j] + Sh[j]; u32x2 w; w.x = pk_bf16(h.x, h.y); w.y = pk_bf16(h.z, h.w);
                *(GAS u32x2*)(H + (size_t)row * DM + 256 * j + 4 * lane) = w; }
        }
    }
}
#undef RP_LDX

__device__ __forceinline__ void rowpass_attn(const float* __restrict__ Od, const bf16* __restrict__ Os, bf16* __restrict__ H, const float* __restrict__ subln,
                                             const float* __restrict__ sbeta, float lam, int gw, int lane) {
    constexpr int RPW = M / 2048;
    const int hd = lane >> 4, e0 = 8 * (lane & 15);
    const f32x4 sl0 = *(const GAS f32x4*)(subln + e0), sl1 = *(const GAS f32x4*)(subln + e0 + 4);
    const f32x4 be0 = *(const GAS f32x4*)(sbeta + 8 * lane), be1 = *(const GAS f32x4*)(sbeta + 8 * lane + 4);
#define RA_UNPK(W_, V_) do { V_[0] = __uint_as_float(W_.x << 16); V_[1] = __uint_as_float(W_.x & 0xffff0000u); V_[2] = __uint_as_float(W_.y << 16); V_[3] = __uint_as_float(W_.y & 0xffff0000u); \
        V_[4] = __uint_as_float(W_.z << 16); V_[5] = __uint_as_float(W_.z & 0xffff0000u); V_[6] = __uint_as_float(W_.w << 16); V_[7] = __uint_as_float(W_.w & 0xffff0000u); } while (0)
    const int row_lo = gw * RPW;
    u32x4 n0 = __builtin_nontemporal_load((const GAS u32x4*)((const bf16*)Od + (size_t)row_lo * 1024 + hd * 256 + e0)), n1 = __builtin_nontemporal_load((const GAS u32x4*)((const bf16*)Od + (size_t)row_lo * 1024 + hd * 256 + 128 + e0));
    u32x4 ns = __builtin_nontemporal_load((const GAS u32x4*)(Os + (size_t)row_lo * 512 + 8 * lane));
    for (int row = row_lo; row < row_lo + RPW; ++row) {
        const u32x4 w0 = n0, w1 = n1, ws = ns;
        { const int rn = (row + 1 < row_lo + RPW) ? row + 1 : row;
          n0 = __builtin_nontemporal_load((const GAS u32x4*)((const bf16*)Od + (size_t)rn * 1024 + hd * 256 + e0)); n1 = __builtin_nontemporal_load((const GAS u32x4*)((const bf16*)Od + (size_t)rn * 1024 + hd * 256 + 128 + e0));
          ns = __builtin_nontemporal_load((const GAS u32x4*)(Os + (size_t)rn * 512 + 8 * lane)); }
        float a0[8], a1[8], v[8], sv[8];
        RA_UNPK(w0, a0); RA_UNPK(w1, a1); RA_UNPK(ws, sv);
        float ss = 0.f, s2 = 0.f;
#pragma unroll
        for (int i = 0; i < 8; ++i) { v[i] = a0[i] - a1[i] * lam; ss += v[i] * v[i]; s2 += sv[i] * sv[i]; }
        ss = row16_sum(ss);
        const float rstd = 0.8f / sqrtf(ss * (1.0f / 128.0f) + RMS_EPS);
        u32x4 od; od.x = pk_bf16(v[0] * rstd * sl0.x, v[1] * rstd * sl0.y); od.y = pk_bf16(v[2] * rstd * sl0.z, v[3] * rstd * sl0.w);
        od.z = pk_bf16(v[4] * rstd * sl1.x, v[5] * rstd * sl1.y); od.w = pk_bf16(v[6] * rstd * sl1.z, v[7] * rstd * sl1.w);
        *(GAS u32x4*)(H + (size_t)row * 1024 + hd * 128 + e0) = od;
        const float rstd2 = 1.0f / sqrtf(wave_sum(s2) * (1.0f / 512.0f) + RMS_EPS);
        u32x4 o; o.x = pk_bf16(sv[0] * rstd2 * be0.x, sv[1] * rstd2 * be0.y); o.y = pk_bf16(sv[2] * rstd2 * be0.z, sv[3] * rstd2 * be0.w);
        o.z = pk_bf16(sv[4] * rstd2 * be1.x, sv[5] * rstd2 * be1.y); o.w = pk_bf16(sv[6] * rstd2 * be1.z, sv[7] * rstd2 * be1.w);
        *(GAS u32x4*)(H + (size_t)row * 1024 + 512 + 8 * lane) = o;
    }
#undef RA_UNPK
}

#define KAS __attribute__((address_space(4)))
__device__ __forceinline__ const float* karg(int i) { const KAS char* ka = (const KAS char*)__builtin_amdgcn_kernarg_segment_ptr(); return (const float*)(*(const volatile KAS unsigned long long*)(ka + 8 * i)); }
#define AIN(i) karg(i)
__device__ __forceinline__ int fresh_tid() { int t = threadIdx.x; asm volatile("" : "+v"(t)); return t; }
__global__ void __launch_bounds__(512) fwd_megakernel(Args args) {
    extern __shared__ __attribute__((aligned(16))) unsigned char lds_raw[];
    cg::grid_group grid = cg::this_grid();
    LAS unsigned char* lds = (LAS unsigned char*)lds_raw;
    const int wave = __builtin_amdgcn_readfirstlane((int)threadIdx.x >> 6);
#define tid (fresh_tid())
#define lane (fresh_tid() & 63)
    const int G = gridDim.x, bx = blockIdx.x;
    const int vcu = (G % 8 == 0) ? (bx % 8) * (G / 8) + bx / 8 : bx;
    const int gw = vcu * 8 + wave, NGW = G * 8;
    unsigned* ctlw = (unsigned*)((unsigned char*)karg(25) + WS_CTLW);
    volatile LAS unsigned* MISC = (volatile LAS unsigned*)(lds + GEMM_LDS);
    if (tid < 64) MISC[tid] = 0u;
    __syncthreads();
    XcdBarrier bar = xcd_barrier_post(ctlw, MISC + 8);
#define WSP(off) ((unsigned char*)karg(25) + (off))
#define ctl ((float*)WSP(WS_CTL))
#define modp (((float*)WSP(WS_CTL)) + 1024)
#define out ((float*)karg(24))
#define Wgu1 ((bf16*)WSP(WS_WGU1))
#define Wd1 ((bf16*)WSP(WS_WD1))
#define Win ((bf16*)WSP(WS_WIN))
#define Wout ((bf16*)WSP(WS_WOUT))
#define Wgu2 ((bf16*)WSP(WS_WGU2))
#define Wd2 ((bf16*)WSP(WS_WD2))
#define H ((bf16*)WSP(WS_H))
#define F ((float*)WSP(WS_F))
#define ACT ((bf16*)WSP(WS_ACT))
#define QK ((bf16*)WSP(WS_ACT))
#define VtD ((bf16*)WSP(WS_VTD))
#define VtS ((bf16*)WSP(WS_VTS))
#define Osb ((bf16*)WSP(WS_OSB))
#define XB ((bf16*)WSP(WS_XB))
    if (PH(0)) REP(0) {
        if (bx < 144) {
            LAS float* sc = (LAS float*)lds;
            LAS float* red = sc + 4096;
            const float* c = AIN(1);
            for (int i = tid; i < 4096; i += 512) { const float v = c[i]; sc[i] = v / (1.0f + __expf(-v)); }
            __syncthreads();
            const int col = bx * 64 + (tid & 63), kg = tid >> 6;
            const float* wp = AIN(2) + (size_t)(kg * 128) * (NMOD * DM) + col;
            float a0 = 0.f, a1 = 0.f, a2 = 0.f, a3 = 0.f;
#pragma unroll 8
            for (int k = 0; k < 128; ++k) { const float w = __builtin_nontemporal_load((const GAS float*)wp + (size_t)k * (NMOD * DM)); const int kk = kg * 128 + k;
                a0 += sc[kk] * w; a1 += sc[1024 + kk] * w; a2 += sc[2048 + kk] * w; a3 += sc[3072 + kk] * w; }
            red[(kg * 4 + 0) * 64 + (tid & 63)] = a0; red[(kg * 4 + 1) * 64 + (tid & 63)] = a1; red[(kg * 4 + 2) * 64 + (tid & 63)] = a2; red[(kg * 4 + 3) * 64 + (tid & 63)] = a3;
            __syncthreads();
            if (tid < 256) { const int b = tid >> 6, cc = tid & 63; float s = 0.f;
#pragma unroll
                for (int g = 0; g < 8; ++g) s += red[(g * 4 + b) * 64 + cc];
                modp[(size_t)b * (NMOD * DM) + bx * 64 + cc] = s + AIN(3)[bx * 64 + cc]; }
            __syncthreads();
        }
        if (bx == G - 1 && wave == 0) {
            const float s1 = wave_sum(AIN(13)[lane] * AIN(14)[lane]), s2 = wave_sum(AIN(15)[lane] * AIN(16)[lane]);
            if (lane == 0) ctl[0] = __expf(s1) - __expf(s2) + 0.2f;
        }
        LAS float* scr = (LAS float*)(lds + wave * 16384);
        constexpr int I_G = (DM / 64) * (DFF / 32), I_D = (DFF / 64) * (DM / 32), I_IN = (DM / 64) * (3 * DM / 32), I_OUT = (DM / 64) * (DM / 32);
        static_assert(I_G == I_D, "item counts");
        constexpr int NEARLY = 3 * I_G + I_IN;
        for (int itx = gw; itx < NEARLY; itx += NGW) {
            int r = itx;
            if (r < I_G) { transpose_item(AIN(6), DM, DFF, Wgu1, 1, scr, r, lane); continue; } r -= I_G;
            if (r < I_G) { transpose_item(AIN(7), DM, DFF, Wgu1, 2, scr, r, lane); continue; } r -= I_G;
            if (r < I_D) { transpose_item(AIN(8), DFF, DM, Wd1, 0, scr, r, lane); continue; } r -= I_D;
            transpose_item(AIN(11), DM, 3 * DM, Win, 0, scr, r, lane);
        }
    }
    if (G == 0x7ffffff0) grid.sync();
    xcd_barrier(bar);
#ifdef EXTRA_SYNCS
    for (int es = 0; es < EXTRA_SYNCS; ++es) xcd_barrier(bar);
#endif
    if (PH(1)) REP(1) rowpass<false, true>(AIN(0), nullptr, nullptr, H, nullptr, modp, 0, 0.f, AIN(4), 1, 0, gw, lane);
    xcd_barrier(bar);
    if (PH(2)) REP(2) { pg8::Gemm g{H, Wgu1, M, 2 * DFF, DM}; pg8::StaticOrder S; S.init(M, 2 * DFF, G, bx, WGM_GU); pg8::EpiSwiglu E{ACT, DFF};
      pg8::gemm_phase<pg8::EpiSwiglu, pg8::StaticOrder, true, true>(lds, g, S, E); }
    xcd_barrier(bar);
    if (PH(3)) REP(3) { pg8::Gemm g{ACT, Wd1, M, DM, DFF}; pg8::StaticOrder S; S.init(M, DM, G, bx, WGM_N1K, 1); pg8::EpiBf16Out E{(bf16*)F, DM};
      pg8::gemm_phase<pg8::EpiBf16Out, pg8::StaticOrder, true, true>(lds, g, S, E); }
    xcd_barrier(bar);
    if (PH(4)) REP(4) rowpass<true, true, false, true>(AIN(0), (const bf16*)F, XB, H, AIN(5), modp, 2, 0.5f, AIN(9), 4, 3, gw, lane);
    xcd_barrier(bar);
    if (PH(5)) REP(5) { pg8::Gemm g{H, Win, M, 3 * DM, DM}; pg8::StaticOrder S; S.init(M, 3 * DM, G, bx, WGM_IN); pg8::EpiProj E{QK, VtD, VtS, C2, SEQ, ctlw + CW_KINF};
      pg8::gemm_phase<pg8::EpiProj, pg8::StaticOrder, true, true>(lds, g, S, E); }
    xcd_barrier(bar);
    if (PH(6)) {
        const unsigned* kinfw = ctlw + CW_KINF;
        LAS unsigned* uslot = (LAS unsigned*)(lds + att::FLAG_OFF + 128);
        const unsigned myx = xb_xcc_id() & 7u;
        for (int qi = 0; qi < 8; ++qi) {
            const unsigned xq = (myx + (unsigned)qi) & 7u;
            unsigned* qctr = ctlw + CW_QUEUE + 64 * xq;
            for (;;) {
                if (tid == 0) *uslot = atomicAdd(qctr, 1u);
                __syncthreads();
                const unsigned u = *uslot;
                __syncthreads();
                if (u >= 128u) break;
                const int h = 3 - (int)(u >> 5), qb = 31 - (int)(u & 31), b = (int)(xq >> 1), vh = 2 * h + (int)(xq & 1);
                const float slope2 = 1.4426950408889634f * exp2f(-2.0f * (float)(h + 1));
                const float kinfa = __uint_as_float(kinfw[(b * 8 + vh) * 2]), kinfb = __uint_as_float(kinfw[(b * 8 + vh) * 2 + 1]);
                att::attn_unit<0, 128>(lds, QK, vh * 64, 512 + vh * 64, VtD + ((size_t)(b * 512 + h * 128)) * SEQ, (size_t)b * SEQ, qb, slope2, kinfa, kinfb, F, nullptr, vh * 128);
            }
        }
        {
            unsigned* qctr = ctlw + CW_QUEUE + 64 * 8;
            for (;;) {
                if (tid == 0) *uslot = atomicAdd(qctr, 1u);
                __syncthreads();
                const unsigned u = *uslot;
                __syncthreads();
                if (u >= 1024u) break;
                const int v = (int)u, qb = 31 - (v >> 5), b = (v & 31) >> 3, h = v & 7;
                att::attn_unit<1, 64>(lds, QK, 1024 + h * 64, 1536 + h * 64, VtS + ((size_t)(b * 512 + h * 64)) * SEQ, (size_t)b * SEQ, qb, 0.f, 0.f, 0.f, nullptr, Osb, h * 64);
            }
        }
        {
            constexpr int I_G2 = (DM / 64) * (DFF / 32), I_OUT2 = (DM / 64) * (DM / 32), NLATE = 3 * I_G2 + I_OUT2;
            unsigned* tq = ctlw + CW_QUEUE + 64 * 9;
            volatile LAS unsigned* tslot = MISC + 32;
            LAS float* scr = (LAS float*)(lds + wave * 16384);
            for (;;) {
                if (tid == 0) tslot[0] = atomicAdd(tq, 1u);
                __syncthreads();
                const unsigned ch = tslot[0];
                __syncthreads();
                if (ch * 8u >= (unsigned)NLATE) break;
                int r = (int)ch * 8 + wave;
                if (r < NLATE) {
                    if (r < I_OUT2) transpose_item(AIN(12), DM, DM, Wout, 0, scr, r, lane);
                    else { r -= I_OUT2;
                        if (r < I_G2) transpose_item(AIN(21), DM, DFF, Wgu2, 1, scr, r, lane);
                        else if (r < 2 * I_G2) transpose_item(AIN(22), DM, DFF, Wgu2, 2, scr, r - I_G2, lane);
                        else transpose_item(AIN(23), DFF, DM, Wd2, 0, scr, r - 2 * I_G2, lane); }
                }
            }
        }
    }
    xcd_barrier(bar);
    if (PH(7)) REP(7) rowpass_attn(F, Osb, H, AIN(17), AIN(18), ctl[0], gw, lane);
    xcd_barrier(bar);
    if (PH(8)) REP(8) { pg8::Gemm g{H, Wout, M, DM, DM}; pg8::StaticOrder S; S.init(M, DM, G, bx, WGM_N1K); pg8::EpiBf16Out E{(bf16*)F, DM};
      pg8::gemm_phase<pg8::EpiBf16Out, pg8::StaticOrder, true, true>(lds, g, S, E); }
    xcd_barrier(bar);
    if (PH(9)) REP(9) rowpass<true, true, true, true>(XB, (const bf16*)F, XB, H, AIN(10), modp, 5, 1.0f, AIN(19), 7, 6, gw, lane);
    xcd_barrier(bar);
    if (PH(10)) REP(10) { pg8::Gemm g{H, Wgu2, M, 2 * DFF, DM}; pg8::StaticOrder S; S.init(M, 2 * DFF, G, bx, WGM_GU); pg8::EpiSwiglu E{ACT, DFF};
      pg8::gemm_phase<pg8::EpiSwiglu, pg8::StaticOrder, true, true>(lds, g, S, E); }
    xcd_barrier(bar);
    if (PH(11)) REP(11) { pg8::Gemm g{ACT, Wd2, M, DM, DFF}; pg8::StaticOrder S; S.init(M, DM, G, bx, WGM_N1K, 1); pg8::EpiBf16Out E{(bf16*)F, DM};
      pg8::gemm_phase<pg8::EpiBf16Out, pg8::StaticOrder, true, true>(lds, g, S, E); }
    xcd_barrier(bar);
    if (PH(12)) REP(12) rowpass<true, false, true, false>(XB, (const bf16*)F, out, nullptr, AIN(20), modp, 8, 0.5f, nullptr, 0, 0, gw, lane);
}
#undef ctl
#undef modp
#undef out
#undef Wgu1
#undef Wd1
#undef Win
#undef Wout
#undef Wgu2
#undef Wd2
#undef H
#undef F
#undef ACT
#undef QK
#undef VtD
#undef VtS
#undef Osb
#undef XB

#undef tid
#undef lane
extern "C" void kernel_launch(void* const* d_in, const int* in_sizes, int n_in, void* d_out, int out_size, void* d_ws, size_t ws_size, hipStream_t stream) {
    static int grid = 0;
    if (grid == 0) {
        if (n_in != 24 || out_size != M * DM || ws_size < WS_END) { fprintf(stderr, "kernel_launch: unexpected shapes (n_in %d out %d ws %zu)\n", n_in, out_size, ws_size); grid = -1; return; }
        int dev = 0, cus = 0, per_cu = 0;
        hipGetDevice(&dev); hipDeviceGetAttribute(&cus, hipDeviceAttributeMultiprocessorCount, dev);
        if (hipFuncSetAttribute((const void*)fwd_megakernel, hipFuncAttributeMaxDynamicSharedMemorySize, LDS_BYTES) != hipSuccess) { fprintf(stderr, "kernel_launch: hipFuncSetAttribute failed\n"); grid = -1; return; }
        if (hipOccupancyMaxActiveBlocksPerMultiprocessor(&per_cu, (const void*)fwd_megakernel, 512, LDS_BYTES) != hipSuccess || per_cu < 1) { fprintf(stderr, "kernel_launch: occupancy query says %d blocks per CU\n", per_cu); per_cu = 1; }
        (void)hipGetLastError();
        if (cus < 256) { fprintf(stderr, "kernel_launch: built for a 256-CU device (got %d CUs)\n", cus); grid = -1; return; }
        grid = 256;
    }
    if (grid < 0) return;
    if (hipMemsetAsync((char*)d_ws + WS_CTLW, 0, CTLW_BYTES, stream) != hipSuccess) { fprintf(stderr, "kernel_launch: memset of the control words failed\n"); return; }
    Args a{};
    for (int i = 0; i < 24; ++i) a.in[i] = (const float*)d_in[i];
    a.out = (float*)d_out; a.ws = (unsigned char*)d_ws;
    void* kargs[] = {&a};
    hipError_t e = hipLaunchCooperativeKernel((const void*)fwd_megakernel, dim3(grid), dim3(512), kargs, LDS_BYTES, stream);
    if (e != hipSuccess) fprintf(stderr, "cooperative launch failed: %s (grid %d)\n", hipGetErrorString(e), grid);
}
```

```cpp
#include <hip/hip_runtime.h>
#include <hip/hip_cooperative_groups.h>
#include <cstdio>
#include <cstdint>
#include <cmath>
namespace cg = cooperative_groups;
namespace pg8 {
#define PG8_LAS __attribute__((address_space(3)))
typedef unsigned short bf16_t;
typedef short bf16x8 __attribute__((ext_vector_type(8)));
typedef float f32x4 __attribute__((ext_vector_type(4)));
typedef unsigned u32x4 __attribute__((ext_vector_type(4)));
constexpr int BM = 256, BK = 64, HALF = 128, HTB = HALF * BK * 2  , STAGE_BYTES = 8 * HTB, NXCD = 8, WGM = 8;

__host__ __device__ __forceinline__ int lds_byte(int r, int c) { const int st = (r >> 4) * 2 + (c >> 5), rr = r & 15, cc = c & 31, ob = rr * 64 + cc * 2; return st * 1024 + (ob ^ (((ob >> 9) & 1) << 5)); }
__host__ __device__ __forceinline__ void stage_rc(int b, int& R, int& C) { const int st = b / 1024, sb = b % 1024, swz = sb ^ (((sb >> 9) & 1) << 5); R = (st >> 1) * 16 + swz / 64; C = (st & 1) * 32 + (swz % 64) / 2; }
__host__ __device__ __forceinline__ int perm32(int rho) { const int n = rho >> 4, i = rho & 15; return 8 * (i >> 2) + 4 * n + (i & 3); }

struct Unit { int pm, pn; };
struct Gemm { const bf16_t* A; const bf16_t* Bt; int M, N, K; };

struct StaticOrder {
    int nM, nN, nwg, G, c, wgm, rev;
    __host__ __device__ void init(int M, int N, int G_, int c_, int wgm_ = WGM, int rev_ = 0) { nM = M / BM; nN = N / BM; nwg = nM * nN; G = G_; c = c_; wgm = wgm_; rev = rev_; }
    __host__ __device__ bool next(int i, Unit& u) const {
        const long L = (long)i * G + c; if (L >= nwg) return false;
        int wgid = (int)L; { const int q = nwg / NXCD, r = nwg % NXCD, xcd = wgid % NXCD, off = wgid / NXCD; wgid = (xcd < r ? xcd * (q + 1) : r * (q + 1) + (xcd - r) * q) + off; }
        if (rev) wgid = nwg - 1 - wgid;
        const int nig = wgm * nN, gid = wgid / nig, fm = gid * wgm, gsz = (nM - fm) < wgm ? (nM - fm) : wgm;
        u.pm = fm + ((wgid % nig) % gsz); u.pn = (wgid % nig) / gsz; return true;
    }
    __device__ __forceinline__ void a_ready(const Unit&) const {}
    __device__ __forceinline__ void done(const Unit&) const {}
};

__device__ __forceinline__ unsigned cvt_pk_bf16(float lo, float hi) { unsigned r; asm volatile("v_cvt_pk_bf16_f32 %0, %1, %2" : "=v"(r) : "v"(lo), "v"(hi)); return r; }
#define PG8_GAS __attribute__((address_space(1)))
__device__ __forceinline__ float silu_mul(float g, float u) { const float e = __builtin_amdgcn_exp2f(g * -1.4426950408889634f); return g * __builtin_amdgcn_rcpf(1.0f + e) * u; }
struct EpiSwiglu {
    static constexpr bool PERM = true, AFTER_DRAIN = false;
    bf16_t* O; int ldc;
    __device__ __forceinline__ void operator()(const f32x4 (&acc)[2][2][4][2], const Unit& u, int wr, int wc, int fr, int fq) const {
        const int row0 = u.pm * BM + wr * 64 + fr; const int col0 = u.pn * HALF + wc * 32 + 8 * fq;
#pragma unroll
        for (int ai = 0; ai < 2; ++ai)
#pragma unroll
            for (int m = 0; m < 4; ++m) { bf16_t* rowp = O + (size_t)(row0 + ai * HALF + m * 16) * ldc + col0;
                const f32x4 g0 = acc[ai][0][m][0], g1 = acc[ai][0][m][1], u0 = acc[ai][1][m][0], u1 = acc[ai][1][m][1];
                u32x4 w; w.x = cvt_pk_bf16(silu_mul(g0[0], u0[0]), silu_mul(g0[1], u0[1])); w.y = cvt_pk_bf16(silu_mul(g0[2], u0[2]), silu_mul(g0[3], u0[3]));
                w.z = cvt_pk_bf16(silu_mul(g1[0], u1[0]), silu_mul(g1[1], u1[1])); w.w = cvt_pk_bf16(silu_mul(g1[2], u1[2]), silu_mul(g1[3], u1[3]));
                *(PG8_GAS u32x4*)rowp = w; }
    }
};
struct EpiBf16Out {
    static constexpr bool PERM = true, AFTER_DRAIN = false;
    bf16_t* O; int ldc;
    __device__ __forceinline__ void operator()(const f32x4 (&acc)[2][2][4][2], const Unit& u, int wr, int wc, int fr, int fq) const {
        const int row0 = u.pm * BM + wr * 64 + fr; const int col0 = u.pn * BM + wc * 32 + 8 * fq;
#pragma unroll
        for (int ai = 0; ai < 2; ++ai)
#pragma unroll
            for (int m = 0; m < 4; ++m) { bf16_t* rowp = O + (size_t)(row0 + ai * HALF + m * 16) * ldc + col0;
#pragma unroll
                for (int bj = 0; bj < 2; ++bj) { const f32x4 v0 = acc[ai][bj][m][0], v1 = acc[ai][bj][m][1];
                    u32x4 w; w.x = cvt_pk_bf16(v0[0], v0[1]); w.y = cvt_pk_bf16(v0[2], v0[3]); w.z = cvt_pk_bf16(v1[0], v1[1]); w.w = cvt_pk_bf16(v1[2], v1[3]);
                    *(PG8_GAS u32x4*)(rowp + bj * HALF) = w; } }
    }
};
struct EpiProj {
    static constexpr bool PERM = true, AFTER_DRAIN = false;
    bf16_t* QK; bf16_t* VtD; bf16_t* VtS; float qscale; int S; unsigned* kinf;
    __device__ __forceinline__ void operator()(const f32x4 (&acc)[2][2][4][2], const Unit& u, int wr, int wc, int fr, int fq) const {
        const int seg = u.pn >> 1, half = u.pn & 1;
        if (seg == 2 || seg == 5) {
            bf16_t* Vt = (seg == 2) ? VtD : VtS;
            const int row_t = u.pm * BM; const int b = row_t / S, t0 = row_t - b * S;
#pragma unroll
            for (int ai = 0; ai < 2; ++ai)
#pragma unroll
                for (int m = 0; m < 4; ++m) { const int t = t0 + ai * HALF + wr * 64 + m * 16 + fr; const int pos = (t & ~12) | ((t & 4) << 1) | ((t & 8) >> 1);
#pragma unroll
                    for (int bj = 0; bj < 2; ++bj)
#pragma unroll
                        for (int n = 0; n < 2; ++n) { const int ch = 256 * half + 128 * bj + 32 * wc + 8 * fq + 4 * n;
                            const f32x4 v = acc[ai][bj][m][n]; const unsigned w0 = cvt_pk_bf16(v[0], v[1]), w1 = cvt_pk_bf16(v[2], v[3]);
                            const unsigned snd = (fr & 1) ? w0 : w1;
                            const unsigned rcv = (unsigned)__builtin_amdgcn_update_dpp(0, (int)snd, 0xB1, 0xF, 0xF, true);
                            const unsigned lo = (fr & 1) ? rcv : w0, hi2 = (fr & 1) ? w1 : rcv;
                            const unsigned s0 = (lo & 0xffffu) | (hi2 << 16), s1 = (lo >> 16) | (hi2 & 0xffff0000u);
                            PG8_GAS bf16_t* p = (PG8_GAS bf16_t*)(Vt + ((size_t)(b * 512 + ch + 2 * (fr & 1))) * S + (pos & ~1));
                            *(PG8_GAS unsigned*)p = s0; *(PG8_GAS unsigned*)(p + (size_t)S) = s1; } }
        } else {
            const int cbase = ((seg == 0) ? 0 : (seg == 1) ? 512 : (seg == 3) ? 1024 : 1536) + 256 * half + wc * 32 + 8 * fq;
            const float sc = (seg == 0 || seg == 3) ? qscale : 1.0f;
            const int row0 = u.pm * BM + wr * 64 + fr;
#pragma unroll
            for (int ai = 0; ai < 2; ++ai)
#pragma unroll
                for (int m = 0; m < 4; ++m) { bf16_t* rowp = QK + (size_t)(row0 + ai * HALF + m * 16) * 2048 + cbase;
#pragma unroll
                    for (int bj = 0; bj < 2; ++bj) { const f32x4 v0 = acc[ai][bj][m][0] * sc, v1 = acc[ai][bj][m][1] * sc;
                        u32x4 w; w.x = cvt_pk_bf16(v0[0], v0[1]); w.y = cvt_pk_bf16(v0[2], v0[3]); w.z = cvt_pk_bf16(v1[0], v1[1]); w.w = cvt_pk_bf16(v1[2], v1[3]);
                        *(PG8_GAS u32x4*)(rowp + bj * HALF) = w; } }
            if (seg == 1) {
                const int b = (u.pm * BM) / S;
#pragma unroll
                for (int bj = 0; bj < 2; ++bj) { float v = 0.f;
#pragma unroll
                    for (int ai = 0; ai < 2; ++ai)
#pragma unroll
                        for (int m = 0; m < 4; ++m) { const f32x4 x = acc[ai][bj][m][0], y = acc[ai][bj][m][1];
                            float s2 = (x[0] * x[0] + x[1] * x[1]) + (x[2] * x[2] + x[3] * x[3]) + (y[0] * y[0] + y[1] * y[1]) + (y[2] * y[2] + y[3] * y[3]);
                            s2 += __shfl_xor(s2, 16); s2 += __shfl_xor(s2, 32);
                            v = fmaxf(v, s2); }
#pragma unroll
                    for (int o = 1; o < 16; o <<= 1) v = fmaxf(v, __shfl_xor(v, o));
                    if (fr == 0 && fq == 0) atomicMax(kinf + (b * 8 + 4 * half + 2 * bj + (wc >> 1)) * 2 + (wc & 1), __float_as_uint(v)); }
            }
        }
    }
};

template <class Epi, class Sched, bool ALIGN_EPI = false, bool SP2 = false>
__device__ __forceinline__ void gemm_phase(PG8_LAS unsigned char* lds, const Gemm g, const Sched& S, const Epi& E) {
    int tid_l = threadIdx.x; asm volatile("" : "+v"(tid_l));
    const int tid = tid_l, wid = __builtin_amdgcn_readfirstlane(tid >> 6), lane = tid & 63, wr = wid >> 2, wc = wid & 3, fr = lane & 15, fq = lane >> 4;
    const int K = g.K, nt = K / BK;
    unsigned voffA[2], voffB[2];
#pragma unroll
    for (int i = 0; i < 2; ++i) { int R, C; stage_rc(tid * 16 + i * 8192, R, C); const int Rb = Epi::PERM ? ((R & ~31) + perm32(R & 31)) : R;
        voffA[i] = (unsigned)(R * K + C) * 2u; voffB[i] = (unsigned)(Rb * K + C) * 2u; }
    const size_t kstep = (size_t)(BK * 2);
    const size_t hstep = (size_t)HALF * K * 2;
    const size_t tstep = 2 * hstep;
    const unsigned ldsw = (unsigned)wid * 1024u;
    const int aoff = lds_byte(wr * 64 + fr, fq * 8), boff = lds_byte(wc * 32 + fr, fq * 8);
#define PG8_SA(b, h) (((b) * 2 + (h)) * HTB)
#define PG8_SB(b, h) ((4 + (b) * 2 + (h)) * HTB)
#define PG8_STAGE(bufoff, gbase, voff) do { _Pragma("unroll") for (int _i = 0; _i < 2; ++_i) \
        __builtin_amdgcn_global_load_lds((const unsigned*)((const char*)(gbase) + (voff)[_i]), (PG8_LAS unsigned*)(lds + (bufoff) + ldsw + _i * 8192), 16, 0, 0); } while (0)
#define PG8_LDA(dst, b, h) do { _Pragma("unroll") for (int m = 0; m < 4; ++m) _Pragma("unroll") for (int k = 0; k < 2; ++k) dst[m][k] = *(const PG8_LAS bf16x8*)(lds + PG8_SA(b, h) + aoff + m * 2048 + k * 1024); } while (0)
#define PG8_LDB(dst, b, h) do { _Pragma("unroll") for (int n = 0; n < 2; ++n) _Pragma("unroll") for (int k = 0; k < 2; ++k) dst[n][k] = *(const PG8_LAS bf16x8*)(lds + PG8_SB(b, h) + boff + n * 2048 + k * 1024); } while (0)
#define PG8_MMA(ai, bj, At, Bt) do { __builtin_amdgcn_s_setprio(1); _Pragma("unroll") for (int m = 0; m < 4; ++m) _Pragma("unroll") for (int n = 0; n < 2; ++n) _Pragma("unroll") for (int k = 0; k < 2; ++k) \
        acc[ai][bj][m][n] = __builtin_amdgcn_mfma_f32_16x16x32_bf16(Bt[n][k], At[m][k], acc[ai][bj][m][n], 0, 0, 0); __builtin_amdgcn_s_setprio(0); } while (0)
#define PG8_WAIT_V(n) asm volatile("s_waitcnt vmcnt(" #n ")" ::: "memory")
#define PG8_WAIT_L(n) asm volatile("s_waitcnt lgkmcnt(" #n ")" ::: "memory")
#define PG8_BAR __builtin_amdgcn_s_barrier()
#define PG8_SCHED __builtin_amdgcn_sched_barrier(0)
    Unit cur, nxt; int ui = 0;
    if (!S.next(0, cur)) return;
    f32x4 acc[2][2][4][2];
#pragma unroll
    for (int a = 0; a < 2; ++a)
#pragma unroll
        for (int b = 0; b < 2; ++b)
#pragma unroll
            for (int m = 0; m < 4; ++m)
#pragma unroll
                for (int n = 0; n < 2; ++n) acc[a][b][m][n] = (f32x4){0.f, 0.f, 0.f, 0.f};
    bf16x8 At[4][2], B0[2][2], B1[2][2];
    const char* cA = (const char*)g.A + (size_t)cur.pm * tstep; const char* cB = (const char*)g.Bt + (size_t)cur.pn * tstep;
    S.a_ready(cur);
    if constexpr (SP2) {
        PG8_STAGE(PG8_SB(0, 0), cB, voffB); PG8_STAGE(PG8_SB(0, 1), cB + hstep, voffB); PG8_STAGE(PG8_SA(0, 0), cA, voffA); PG8_STAGE(PG8_SA(0, 1), cA + hstep, voffA);
        if (wr == 1) PG8_BAR;
        PG8_WAIT_V(2); PG8_BAR;
        PG8_STAGE(PG8_SB(1, 0), cB + kstep, voffB); PG8_STAGE(PG8_SA(1, 0), cA + kstep, voffA); PG8_STAGE(PG8_SB(1, 1), cB + hstep + kstep, voffB);
        PG8_WAIT_V(6); PG8_BAR;
    } else {
        PG8_STAGE(PG8_SB(0, 0), cB, voffB); PG8_STAGE(PG8_SA(0, 0), cA, voffA); PG8_STAGE(PG8_SB(0, 1), cB + hstep, voffB); PG8_STAGE(PG8_SA(0, 1), cA + hstep, voffA);
        if (wr == 1) PG8_BAR;
        PG8_WAIT_V(4); PG8_BAR;
        PG8_STAGE(PG8_SB(1, 0), cB + kstep, voffB); PG8_STAGE(PG8_SA(1, 0), cA + kstep, voffA); PG8_STAGE(PG8_SB(1, 1), cB + hstep + kstep, voffB);
        PG8_WAIT_V(6); PG8_BAR;
    }
    for (;;) {
        const bool has_next = S.next(ui + 1, nxt);
        const char* nA = has_next ? (const char*)g.A + (size_t)nxt.pm * tstep : cA; const char* nB = has_next ? (const char*)g.Bt + (size_t)nxt.pn * tstep : cB;
        for (int t = 0; t < nt; t += 2) {
            const bool last = (t == nt - 2);
            const char* a1 = cA + (size_t)(t + 1) * kstep;
            const char* a2 = last ? nA : cA + (size_t)(t + 2) * kstep; const char* b2 = last ? nB : cB + (size_t)(t + 2) * kstep;
            const char* a3 = a2 + kstep; const char* b3 = b2 + kstep;
            if (last && has_next) S.a_ready(nxt);
            if constexpr (SP2) {
            PG8_LDB(B0, 0, 0); PG8_LDB(B1, 0, 1); PG8_SCHED; PG8_LDA(At, 0, 0); PG8_STAGE(PG8_SA(1, 1), a1 + hstep, voffA);
            PG8_WAIT_V(8); PG8_WAIT_L(0); PG8_BAR; PG8_MMA(0, 0, At, B0); PG8_MMA(0, 1, At, B1); PG8_BAR; PG8_SCHED;
            PG8_LDA(At, 0, 1); PG8_STAGE(PG8_SB(0, 0), b2, voffB); PG8_STAGE(PG8_SB(0, 1), b2 + hstep, voffB); PG8_STAGE(PG8_SA(0, 0), a2, voffA);
            PG8_WAIT_V(8); PG8_WAIT_L(0); PG8_BAR; PG8_MMA(1, 0, At, B0); PG8_MMA(1, 1, At, B1); PG8_BAR; PG8_SCHED;
            PG8_LDB(B0, 1, 0); PG8_LDB(B1, 1, 1); PG8_SCHED; PG8_LDA(At, 1, 0); PG8_STAGE(PG8_SA(0, 1), a2 + hstep, voffA);
            PG8_WAIT_V(8); PG8_WAIT_L(0); PG8_BAR; PG8_MMA(0, 0, At, B0); PG8_MMA(0, 1, At, B1); PG8_BAR; PG8_SCHED;
            PG8_LDA(At, 1, 1); PG8_STAGE(PG8_SB(1, 0), b3, voffB); PG8_STAGE(PG8_SB(1, 1), b3 + hstep, voffB); PG8_STAGE(PG8_SA(1, 0), a3, voffA);
            PG8_WAIT_V(8); PG8_WAIT_L(0); PG8_BAR; PG8_MMA(1, 0, At, B0); PG8_MMA(1, 1, At, B1); PG8_BAR; PG8_SCHED;
            } else {
            PG8_LDB(B0, 0, 0); PG8_SCHED; PG8_LDA(At, 0, 0); PG8_STAGE(PG8_SA(1, 1), a1 + hstep, voffA);
            PG8_WAIT_L(8); PG8_BAR; PG8_WAIT_L(0); PG8_MMA(0, 0, At, B0); PG8_BAR; PG8_SCHED;
            PG8_LDB(B1, 0, 1); PG8_STAGE(PG8_SB(0, 0), b2, voffB);
            PG8_BAR; PG8_WAIT_L(0); PG8_MMA(0, 1, At, B1); PG8_BAR;
            PG8_LDA(At, 0, 1); PG8_STAGE(PG8_SA(0, 0), a2, voffA);
            PG8_BAR; PG8_WAIT_L(0); PG8_MMA(1, 0, At, B0); PG8_BAR; PG8_SCHED;
            PG8_STAGE(PG8_SB(0, 1), b2 + hstep, voffB);
            PG8_WAIT_V(6); PG8_BAR; PG8_MMA(1, 1, At, B1); PG8_BAR;
            PG8_LDB(B0, 1, 0); PG8_SCHED; PG8_LDA(At, 1, 0); PG8_STAGE(PG8_SA(0, 1), a2 + hstep, voffA);
            PG8_WAIT_L(8); PG8_BAR; PG8_WAIT_L(0); PG8_MMA(0, 0, At, B0); PG8_BAR; PG8_SCHED;
            PG8_LDB(B1, 1, 1); PG8_STAGE(PG8_SB(1, 0), b3, voffB);
            PG8_BAR; PG8_WAIT_L(0); PG8_MMA(0, 1, At, B1); PG8_BAR;
            PG8_LDA(At, 1, 1); PG8_STAGE(PG8_SA(1, 0), a3, voffA);
            PG8_BAR; PG8_WAIT_L(0); PG8_MMA(1, 0, At, B0); PG8_BAR; PG8_SCHED;
            PG8_STAGE(PG8_SB(1, 1), b3 + hstep, voffB);
            PG8_WAIT_V(6); PG8_BAR; PG8_MMA(1, 1, At, B1); PG8_BAR;
            }
        }
        if constexpr (ALIGN_EPI) { if (wr == 0) PG8_BAR; }
        if constexpr (!Epi::AFTER_DRAIN) { E(acc, cur, wr, wc, fr, fq); S.done(cur); }
        if (!has_next) break;
#pragma unroll
        for (int a = 0; a < 2; ++a)
#pragma unroll
            for (int b = 0; b < 2; ++b)
#pragma unroll
                for (int m = 0; m < 4; ++m)
#pragma unroll
                    for (int n = 0; n < 2; ++n) acc[a][b][m][n] = (f32x4){0.f, 0.f, 0.f, 0.f};
        cur = nxt; cA = nA; cB = nB; ++ui;
        if constexpr (ALIGN_EPI) { if (wr == 1) PG8_BAR; }
    }
    PG8_WAIT_V(0);
    if constexpr (!ALIGN_EPI) { if (wr == 0) PG8_BAR; }
    PG8_BAR;
    if constexpr (Epi::AFTER_DRAIN) { E.fused(acc, cur, wr, wc, fr, fq, lds, wid, lane); S.done(cur); }
#undef PG8_SA
#undef PG8_SB
#undef PG8_STAGE
#undef PG8_LDA
#undef PG8_LDB
#undef PG8_MMA
#undef PG8_WAIT_V
#undef PG8_WAIT_L
#undef PG8_BAR
#undef PG8_SCHED
}
}

#define LAS __attribute__((address_space(3)))
#define GAS __attribute__((address_space(1)))
typedef unsigned short bf16;
typedef float f32x4 __attribute__((ext_vector_type(4)));
typedef float f32x2 __attribute__((ext_vector_type(2)));
typedef float f32x16 __attribute__((ext_vector_type(16)));
typedef short bf16x8 __attribute__((ext_vector_type(8)));
typedef unsigned u32x4 __attribute__((ext_vector_type(4)));
typedef unsigned u32x2 __attribute__((ext_vector_type(2)));
constexpr int NB = 4, SEQ = 8192, DM = 1024, DFF = 2816, M = NB * SEQ, NMOD = 9;
constexpr float RMS_EPS = 1e-6f;
constexpr float C2 = 0.125f * 1.4426950408889634f;
constexpr size_t MiB = 1u << 20;
constexpr size_t WS_CTL = 0;
constexpr size_t WS_WGU1 = 1 * MiB, WS_WD1 = 12 * MiB, WS_WIN = 18 * MiB, WS_WOUT = 24 * MiB, WS_WGU2 = 26 * MiB, WS_WD2 = 37 * MiB;
constexpr size_t WS_H = 48 * MiB;
constexpr size_t WS_F = 112 * MiB;
constexpr size_t WS_XB = 176 * MiB;
constexpr size_t WS_ACT = 240 * MiB;
constexpr size_t WS_VTD = 416 * MiB, WS_VTS = 448 * MiB;
constexpr size_t WS_OSB = 480 * MiB;
constexpr size_t WS_END = 512 * MiB;
constexpr int GEMM_LDS = 131072, LDS_BYTES = GEMM_LDS + 1024;
constexpr size_t WS_CTLW = 512 * 1024, CTLW_BYTES = 32 * 1024;
constexpr int CW_KINF = 4096, CW_QUEUE = 4160;

template <int CTRL> __device__ __forceinline__ float dpp_f(float v) { return __builtin_bit_cast(float, __builtin_amdgcn_update_dpp(0, __builtin_bit_cast(int, v), CTRL, 0xF, 0xF, true)); }
__device__ __forceinline__ float row16_sum(float v) {
    v += dpp_f<0xB1>(v);
    v += dpp_f<0x4E>(v);
    v += dpp_f<0x141>(v);
    v += dpp_f<0x140>(v);
    return v;
}
__device__ __forceinline__ float xrow_sum(float v) {
    { auto rr = __builtin_amdgcn_permlane16_swap(__float_as_uint(v), __float_as_uint(v), false, false); v = __uint_as_float(rr[0]) + __uint_as_float(rr[1]); }
    { auto rr = __builtin_amdgcn_permlane32_swap(__float_as_uint(v), __float_as_uint(v), false, false); v = __uint_as_float(rr[0]) + __uint_as_float(rr[1]); }
    return v;
}
__device__ __forceinline__ float wave_sum(float v) { return xrow_sum(row16_sum(v)); }
__device__ __forceinline__ unsigned pk_bf16(float lo, float hi) { return pg8::cvt_pk_bf16(lo, hi); }
__device__ __forceinline__ float bf2f(unsigned short h) { return __uint_as_float(((unsigned)h) << 16); }

namespace att {
constexpr int KSTR = 144;
constexpr int KBUFB = 64 * KSTR, STAGEB = KBUFB + 128 * KSTR;
constexpr int FLAG_OFF = 2 * STAGEB;
constexpr float THR = -48.0f;
__device__ __forceinline__ int crow(int r, int hi) { return (r & 3) + 8 * (r >> 2) + 4 * hi; }
typedef __bf16 bf16x2_t __attribute__((ext_vector_type(2)));
__device__ __forceinline__ unsigned cvtpk_c(float lo, float hi) { const f32x2 v = {lo, hi}; const bf16x2_t b = __builtin_convertvector(v, bf16x2_t); return __builtin_bit_cast(unsigned, b); }
__device__ __forceinline__ bf16x8 pack8(const f32x16& p, int b) {
    u32x4 w; w.x = cvtpk_c(p[b], p[b + 1]); w.y = cvtpk_c(p[b + 2], p[b + 3]); w.z = cvtpk_c(p[b + 4], p[b + 5]); w.w = cvtpk_c(p[b + 6], p[b + 7]);
    return __builtin_bit_cast(bf16x8, w);
}
#define MFMA32(a, b, c) __builtin_amdgcn_mfma_f32_32x32x16_bf16((a), (b), (c), 0, 0, 0)
__device__ __forceinline__ float max3f(float a, float b, float c) { float r; asm("v_max3_f32 %0, %1, %2, %3" : "=v"(r) : "v"(a), "v"(b), "v"(c)); return r; }
__device__ __forceinline__ float xhalf_max(float m) { auto rr = __builtin_amdgcn_permlane32_swap(__float_as_uint(m), __float_as_uint(m), false, false); return fmaxf(__uint_as_float(rr[0]), __uint_as_float(rr[1])); }
__device__ __forceinline__ float xhalf_sum(float m) { auto rr = __builtin_amdgcn_permlane32_swap(__float_as_uint(m), __float_as_uint(m), false, false); return __uint_as_float(rr[0]) + __uint_as_float(rr[1]); }

template <int MODE, int DV>
__device__ __forceinline__ void attn_unit(LAS unsigned char* lds, const bf16* __restrict__ QK, int qcol, int kcol, const bf16* __restrict__ Vt,
                                          size_t rowbase, int qb, float slope2, float kinfa, float kinfb, float* __restrict__ Of, bf16* __restrict__ Ob, int ocol) {
    constexpr int NDB = DV / 32, NVC = DV / 64, NACC = NDB;
    int tid_l = threadIdx.x; asm volatile("" : "+v"(tid_l));
    const int tid = tid_l, lane = tid & 63, r32 = lane & 31, hi = lane >> 5;
    const int wid = __builtin_amdgcn_readfirstlane(tid >> 6);
    const int q0 = qb * 256, tw0 = q0 + 32 * wid, t = tw0 + r32;
    const int NT = 4 * qb + 4;
    bf16x8 qf[4];
    { const bf16* qp = QK + (rowbase + t) * 2048 + qcol + hi * 8;
#pragma unroll
      for (int ds = 0; ds < 4; ++ds) qf[ds] = *(const GAS bf16x8*)(qp + ds * 16); }
    float rowc = 0.f;
    if (MODE == 0) {
        float sa = 0.f, sb2 = 0.f;
#pragma unroll
        for (int ds = 0; ds < 4; ++ds) { const u32x4 w = __builtin_bit_cast(u32x4, qf[ds]);
            const float e0 = __uint_as_float(w.x << 16), e1 = __uint_as_float(w.x & 0xffff0000u), e2 = __uint_as_float(w.y << 16), e3 = __uint_as_float(w.y & 0xffff0000u);
            const float e4 = __uint_as_float(w.z << 16), e5 = __uint_as_float(w.z & 0xffff0000u), e6 = __uint_as_float(w.w << 16), e7 = __uint_as_float(w.w & 0xffff0000u);
            const float q2 = (e0 * e0 + e1 * e1) + (e2 * e2 + e3 * e3) + (e4 * e4 + e5 * e5) + (e6 * e6 + e7 * e7);
            if (ds < 2) sa += q2; else sb2 += q2; }
        sa = xhalf_sum(sa); sb2 = xhalf_sum(sb2);
        rowc = (sqrtf(sa * kinfa) + sqrtf(sb2 * kinfb)) * 1.02f;
    }
    const int krow = tid >> 3, kch = tid & 7;
    const bf16* ksrc = QK + (rowbase + krow) * 2048 + kcol + kch * 8;
    const unsigned kdst = krow * KSTR + kch * 16;
    const bf16* vsrc = Vt + (size_t)krow * SEQ + kch * 8;
    const unsigned vdst = KBUFB + krow * KSTR + kch * 16;
    const unsigned koff = r32 * KSTR + hi * 16;
    LAS unsigned* flags = (LAS unsigned*)(lds + FLAG_OFF);

    f32x16 o[NACC];
#pragma unroll
    for (int d = 0; d < NACC; ++d)
#pragma unroll
        for (int r = 0; r < 16; ++r) o[d][r] = 0.f;
    float mrun = 0.f, carry = 0.f, lrun = 0.f;
    bool wdone = false, first = true;
    bf16x8 ut0, ut1, uone;
    { const u32x4 c = {0x3F803F80u, 0x3F803F80u, 0x3F803F80u, 0x3F803F80u}; uone = __builtin_bit_cast(bf16x8, c); }
    if (MODE == 1) {
        u32x4 a, b;
        unsigned e0[8], e1[8];
#pragma unroll
        for (int j = 0; j < 8; ++j) { const int jj = 8 * (j >> 2) + 4 * hi + (j & 3); e0[j] = (jj > r32) ? 0x3F80u : 0u; e1[j] = (16 + jj > r32) ? 0x3F80u : 0u; }
        a.x = e0[0] | (e0[1] << 16); a.y = e0[2] | (e0[3] << 16); a.z = e0[4] | (e0[5] << 16); a.w = e0[6] | (e0[7] << 16);
        b.x = e1[0] | (e1[1] << 16); b.y = e1[2] | (e1[3] << 16); b.z = e1[4] | (e1[5] << 16); b.w = e1[6] | (e1[7] << 16);
        ut0 = __builtin_bit_cast(bf16x8, a); ut1 = __builtin_bit_cast(bf16x8, b);
    }
    u32x4 kreg[2], vreg[2][NVC];
#define ATT_LOAD(set_, kt_) do { kreg[set_] = *(const GAS u32x4*)(ksrc + (size_t)(kt_) * 64 * 2048); \
        _Pragma("unroll") for (int i_ = 0; i_ < NVC; ++i_) vreg[set_][i_] = *(const GAS u32x4*)(vsrc + (size_t)i_ * 64 * SEQ + (kt_) * 64); } while (0)
#define ATT_STORE(set_, stg_) do { *(LAS u32x4*)(lds + (stg_) * STAGEB + kdst) = kreg[set_]; \
        _Pragma("unroll") for (int i_ = 0; i_ < NVC; ++i_) *(LAS u32x4*)(lds + (stg_) * STAGEB + vdst + i_ * 64 * KSTR) = vreg[set_][i_]; } while (0)
    ATT_LOAD(0, NT - 1); ATT_LOAD(1, (NT - 2 > 0) ? NT - 2 : 0); ATT_STORE(0, 0);
    __syncthreads();
    int kt = NT - 1; bool fin = false;
    for (;;) {
#pragma unroll
      for (int hh = 0; hh < 2; ++hh) {
        const bool hasn = (kt > 0);
        ATT_LOAD(hh, (kt - 2 > 0) ? kt - 2 : 0);
        const int k0 = kt * 64;
        const LAS unsigned char* sb = lds + hh * STAGEB;
        const bool active = ((MODE == 0) ? (k0 <= tw0 + 31) : (k0 < tw0 + 31)) && !wdone;
        if (active) {
            f32x16 p0, p1;
            if (MODE == 0) {
                const float bb = slope2 * (float)(k0 + 4 * hi - t) - mrun;
#pragma unroll
                for (int r = 0; r < 16; ++r) { const float c = __builtin_fmaf(slope2, (float)((r & 3) + 8 * (r >> 2)), bb); p0[r] = c; p1[r] = __builtin_fmaf(slope2, 32.0f, c); }
            } else {
#pragma unroll
                for (int r = 0; r < 16; ++r) { p0[r] = 0.f; p1[r] = 0.f; }
            }
#pragma unroll
            for (int ds = 0; ds < 4; ++ds) {
                const bf16x8 k0f = *(const LAS bf16x8*)(sb + koff + ds * 32);
                const bf16x8 k1f = *(const LAS bf16x8*)(sb + koff + 32 * KSTR + ds * 32);
                p0 = MFMA32(k0f, qf[ds], p0); p1 = MFMA32(k1f, qf[ds], p1);
            }
            const bool diag = (MODE == 0) ? (k0 + 63 > tw0) : (k0 + 63 >= tw0);
            bf16x8 pf0, pf1, pf2, pf3;
            if (MODE == 0) {
                if (diag) {
#pragma unroll
                    for (int r = 0; r < 16; ++r) { const int key = k0 + crow(r, hi); if (key > t) p0[r] = -INFINITY; if (key + 32 > t) p1[r] = -INFINITY; }
                }
                float mx;
                { float a0 = max3f(p0[0], p0[1], p0[2]), a1 = max3f(p0[3], p0[4], p0[5]), a2 = max3f(p0[6], p0[7], p0[8]), a3 = max3f(p0[9], p0[10], p0[11]);
                  float a4 = max3f(p0[12], p0[13], p0[14]), a5 = max3f(p0[15], p1[0], p1[1]), a6 = max3f(p1[2], p1[3], p1[4]), a7 = max3f(p1[5], p1[6], p1[7]);
                  float a8 = max3f(p1[8], p1[9], p1[10]), a9 = max3f(p1[11], p1[12], p1[13]), a10 = max3f(p1[14], p1[15], a0);
                  a1 = max3f(a1, a2, a3); a4 = max3f(a4, a5, a6); a7 = max3f(a7, a8, a9);
                  mx = xhalf_max(max3f(max3f(a1, a4, a7), a10, a10)); }
                if (first || __any(mx > 6.0f)) {
                    const float dl = first ? mx : fmaxf(mx, 0.f);
#pragma unroll
                    for (int r = 0; r < 16; ++r) { p0[r] -= dl; p1[r] -= dl; }
                    mrun += dl;
                    if (!first) { const float alpha = __builtin_amdgcn_exp2f(-dl); lrun *= alpha;
#pragma unroll
                        for (int d = 0; d < NACC; ++d)
#pragma unroll
                            for (int r = 0; r < 16; ++r) o[d][r] *= alpha; }
                    first = false;
                }
#pragma unroll
                for (int r = 0; r < 16; ++r) { p0[r] = __builtin_amdgcn_exp2f(p0[r]); p1[r] = __builtin_amdgcn_exp2f(p1[r]); }
                { float s0 = p0[0] + p1[0], s1 = p0[1] + p1[1], s2 = p0[2] + p1[2], s3 = p0[3] + p1[3];
#pragma unroll
                  for (int r = 4; r < 16; r += 4) { s0 += p0[r] + p1[r]; s1 += p0[r + 1] + p1[r + 1]; s2 += p0[r + 2] + p1[r + 2]; s3 += p0[r + 3] + p1[r + 3]; }
                  lrun += (s0 + s1) + (s2 + s3); }
                pf0 = pack8(p0, 0); pf1 = pack8(p0, 8); pf2 = pack8(p1, 0); pf3 = pack8(p1, 8);
                wdone = __all(rowc - slope2 * (float)(t - k0 + 1) < mrun - 32.0f) != 0;
            } else {
                float ts = 0.f;
                f32x16 l0, l1;
#pragma unroll
                for (int r = 0; r < 16; ++r) {
                    { const float z = p0[r]; const float e = __builtin_amdgcn_exp2f(-fabsf(z)); const float sp = fmaxf(-z, 0.f) + __builtin_amdgcn_logf(1.0f + e);
                      const float lb = -sp; float lm = lb - z; if (diag && !(k0 + crow(r, hi) < t)) lm = 0.f; l0[r] = lm; ts += lm; p0[r] = lb + carry; }
                    { const float z = p1[r]; const float e = __builtin_amdgcn_exp2f(-fabsf(z)); const float sp = fmaxf(-z, 0.f) + __builtin_amdgcn_logf(1.0f + e);
                      const float lb = -sp; float lm = lb - z; if (diag && !(k0 + 32 + crow(r, hi) < t)) lm = 0.f; l1[r] = lm; ts += lm; p1[r] = lb + carry; }
                }
                const bf16x8 L0a = pack8(l0, 0), L0b = pack8(l0, 8), L1a = pack8(l1, 0), L1b = pack8(l1, 8);
                p0 = MFMA32(ut0, L0a, p0); p0 = MFMA32(ut1, L0b, p0); p0 = MFMA32(uone, L1a, p0); p0 = MFMA32(uone, L1b, p0);
                p1 = MFMA32(ut0, L1a, p1); p1 = MFMA32(ut1, L1b, p1);
#pragma unroll
                for (int r = 0; r < 16; ++r) {
                    float a0 = __builtin_amdgcn_exp2f(p0[r]), a1 = __builtin_amdgcn_exp2f(p1[r]);
                    if (diag) { if (!(k0 + crow(r, hi) < t)) a0 = 0.f; if (!(k0 + 32 + crow(r, hi) < t)) a1 = 0.f; }
                    p0[r] = a0; p1[r] = a1;
                }
                ts = xhalf_sum(ts);
                carry += ts;
                pf0 = pack8(p0, 0); pf1 = pack8(p0, 8); pf2 = pack8(p1, 0); pf3 = pack8(p1, 8);
                wdone = __all(carry < THR) != 0;
            }
#pragma unroll
            for (int d = 0; d < NDB; ++d) {
                const LAS unsigned char* vb = sb + KBUFB + d * 32 * KSTR + koff;
                const bf16x8 v0 = *(const LAS bf16x8*)(vb), v1 = *(const LAS bf16x8*)(vb + 32), v2 = *(const LAS bf16x8*)(vb + 64), v3 = *(const LAS bf16x8*)(vb + 96);
                o[d] = MFMA32(v0, pf0, o[d]); o[d] = MFMA32(v1, pf1, o[d]); o[d] = MFMA32(v2, pf2, o[d]); o[d] = MFMA32(v3, pf3, o[d]);
            }
        }
        if (hasn) ATT_STORE(hh ^ 1, hh ^ 1);
        if (lane == 0) flags[hh * 8 + wid] = wdone ? 1u : 0u;
        __syncthreads();
        if (!hasn) { fin = true; break; }
        { const unsigned f = flags[hh * 8 + (lane & 7)]; if (__all(f != 0u)) { fin = true; break; } }
        --kt;
      }
      if (fin) break;
    }
#undef ATT_LOAD
#undef ATT_STORE
    if (MODE == 0) {
        const float inv = 1.0f / xhalf_sum(lrun);
        bf16* op = (bf16*)Of + (rowbase + t) * 1024 + ocol + 4 * hi;
#pragma unroll
        for (int d = 0; d < NDB; ++d)
#pragma unroll
            for (int g = 0; g < 4; ++g) { u32x2 w; w.x = pk_bf16(o[d][4 * g] * inv, o[d][4 * g + 1] * inv); w.y = pk_bf16(o[d][4 * g + 2] * inv, o[d][4 * g + 3] * inv); *(GAS u32x2*)(op + 32 * d + 8 * g) = w; }
    } else {
        bf16* op = Ob + (rowbase + t) * 512 + ocol + 4 * hi;
#pragma unroll
        for (int d = 0; d < NDB; ++d)
#pragma unroll
            for (int g = 0; g < 4; ++g) { u32x2 w; w.x = pk_bf16(o[d][4 * g], o[d][4 * g + 1]); w.y = pk_bf16(o[d][4 * g + 2], o[d][4 * g + 3]); *(GAS u32x2*)(op + 32 * d + 8 * g) = w; }
    }
}
constexpr int SB2_KB = 64 * KSTR, SB2_STAGE = 4 * SB2_KB;
template <int MODE, int DV>
__device__ __forceinline__ void sb_unit2(LAS unsigned char* lds, const bf16* __restrict__ QK, int qcol, int kcol, const bf16* __restrict__ Vt, LAS unsigned* flags_,
                                          size_t rowbase, int qb, float slope2, float kinfa, float kinfb, float* __restrict__ Of, bf16* __restrict__ Ob, int ocol) {
    constexpr int NDB = DV / 32, NVC = DV / 64, NACC = NDB;
    int tid_l = threadIdx.x; asm volatile("" : "+v"(tid_l));
    const int tid = tid_l, lane = tid & 63, r32 = lane & 31, hi = lane >> 5;
    const int wid = __builtin_amdgcn_readfirstlane(tid >> 6);
    const int hsel = wid >> 2;
    qcol += 64 * hsel; ocol += 64 * hsel;
    const int q0 = qb * 128, tw0 = q0 + 32 * (wid & 3), t = tw0 + r32;
    const int NT = 2 * qb + 2;
    bf16x8 qf[4];
    { const bf16* qp = QK + (rowbase + t) * 2048 + qcol + hi * 8;
#pragma unroll
      for (int ds = 0; ds < 4; ++ds) qf[ds] = *(const GAS bf16x8*)(qp + ds * 16); }
    float rowc = 0.f;
    if (MODE == 0) {
        float sa = 0.f, sb2 = 0.f;
#pragma unroll
        for (int ds = 0; ds < 4; ++ds) { const u32x4 w = __builtin_bit_cast(u32x4, qf[ds]);
            const float e0 = __uint_as_float(w.x << 16), e1 = __uint_as_float(w.x & 0xffff0000u), e2 = __uint_as_float(w.y << 16), e3 = __uint_as_float(w.y & 0xffff0000u);
            const float e4 = __uint_as_float(w.z << 16), e5 = __uint_as_float(w.z & 0xffff0000u), e6 = __uint_as_float(w.w << 16), e7 = __uint_as_float(w.w & 0xffff0000u);
            const float q2 = (e0 * e0 + e1 * e1) + (e2 * e2 + e3 * e3) + (e4 * e4 + e5 * e5) + (e6 * e6 + e7 * e7);
            if (ds < 2) sa += q2; else sb2 += q2; }
        sa = xhalf_sum(sa); sb2 = xhalf_sum(sb2);
        rowc = (sqrtf(sa * kinfa) + sqrtf(sb2 * kinfb)) * 1.02f;
    }
    const int th = tid >> 8, idx = tid & 255, krow = idx >> 3, kch = idx & 7;
    const bf16* ksrc = QK + (rowbase + krow) * 2048 + kcol + 64 * th + kch * 8;
    const unsigned kdst = th * SB2_KB + krow * KSTR + kch * 16;
    const bf16* vsrc = Vt + (size_t)(64 * th + krow) * SEQ + kch * 8;
    const unsigned vdst = 2 * SB2_KB + th * SB2_KB + krow * KSTR + kch * 16;
    const unsigned koff = hsel * SB2_KB + r32 * KSTR + hi * 16;
    LAS unsigned* flags = flags_;

    f32x16 o[NACC];
#pragma unroll
    for (int d = 0; d < NACC; ++d)
#pragma unroll
        for (int r = 0; r < 16; ++r) o[d][r] = 0.f;
    float mrun = 0.f, carry = 0.f, lrun = 0.f;
    bool wdone = false, first = true;
    bf16x8 ut0, ut1, uone;
    { const u32x4 c = {0x3F803F80u, 0x3F803F80u, 0x3F803F80u, 0x3F803F80u}; uone = __builtin_bit_cast(bf16x8, c); }
    if (MODE == 1) {
        u32x4 a, b;
        unsigned e0[8], e1[8];
#pragma unroll
        for (int j = 0; j < 8; ++j) { const int jj = 8 * (j >> 2) + 4 * hi + (j & 3); e0[j] = (jj > r32) ? 0x3F80u : 0u; e1[j] = (16 + jj > r32) ? 0x3F80u : 0u; }
        a.x = e0[0] | (e0[1] << 16); a.y = e0[2] | (e0[3] << 16); a.z = e0[4] | (e0[5] << 16); a.w = e0[6] | (e0[7] << 16);
        b.x = e1[0] | (e1[1] << 16); b.y = e1[2] | (e1[3] << 16); b.z = e1[4] | (e1[5] << 16); b.w = e1[6] | (e1[7] << 16);
        ut0 = __builtin_bit_cast(bf16x8, a); ut1 = __builtin_bit_cast(bf16x8, b);
    }
    u32x4 kreg[2][2], vreg[2][2];
#define ATT_LOAD(set_, kt_) do { _Pragma("unroll") for (int i_ = 0; i_ < 2; ++i_) { kreg[set_][i_] = *(const GAS u32x4*)(ksrc + ((size_t)(kt_) * 64 + 32 * i_) * 2048); \
        vreg[set_][i_] = *(const GAS u32x4*)(vsrc + (size_t)i_ * 32 * SEQ + (kt_) * 64); } } while (0)
#define ATT_STORE(set_, stg_) do { _Pragma("unroll") for (int i_ = 0; i_ < 2; ++i_) { *(LAS u32x4*)(lds + (stg_) * SB2_STAGE + kdst + i_ * 32 * KSTR) = kreg[set_][i_]; \
        *(LAS u32x4*)(lds + (stg_) * SB2_STAGE + vdst + i_ * 32 * KSTR) = vreg[set_][i_]; } } while (0)
    ATT_LOAD(0, NT - 1); ATT_LOAD(1, (NT - 2 > 0) ? NT - 2 : 0); ATT_STORE(0, 0);
    __syncthreads();
    int kt = NT - 1; bool fin = false;
    for (;;) {
#pragma unroll
      for (int hh = 0; hh < 2; ++hh) {
        const bool hasn = (kt > 0);
        ATT_LOAD(hh, (kt - 2 > 0) ? kt - 2 : 0);
        const int k0 = kt * 64;
        const LAS unsigned char* sb = lds + hh * SB2_STAGE;
        const bool active = ((MODE == 0) ? (k0 <= tw0 + 31) : (k0 < tw0 + 31)) && !wdone;
        if (active) {
            f32x16 p0, p1;
            if (MODE == 0) {
                const float bb = slope2 * (float)(k0 + 4 * hi - t) - mrun;
#pragma unroll
                for (int r = 0; r < 16; ++r) { const float c = __builtin_fmaf(slope2, (float)((r & 3) + 8 * (r >> 2)), bb); p0[r] = c; p1[r] = __builtin_fmaf(slope2, 32.0f, c); }
            } else {
#pragma unroll
                for (int r = 0; r < 16; ++r) { p0[r] = 0.f; p1[r] = 0.f; }
            }
#pragma unroll
            for (int ds = 0; ds < 4; ++ds) {
                const bf16x8 k0f = *(const LAS bf16x8*)(sb + koff + ds * 32);
                const bf16x8 k1f = *(const LAS bf16x8*)(sb + koff + 32 * KSTR + ds * 32);
                p0 = MFMA32(k0f, qf[ds], p0); p1 = MFMA32(k1f, qf[ds], p1);
            }
            const bool diag = (MODE == 0) ? (k0 + 63 > tw0) : (k0 + 63 >= tw0);
            bf16x8 pf0, pf1, pf2, pf3;
            if (MODE == 0) {
                if (diag) {
#pragma unroll
                    for (int r = 0; r < 16; ++r) { const int key = k0 + crow(r, hi); if (key > t) p0[r] = -INFINITY; if (key + 32 > t) p1[r] = -INFINITY; }
                }
                float mx;
                { float a0 = max3f(p0[0], p0[1], p0[2]), a1 = max3f(p0[3], p0[4], p0[5]), a2 = max3f(p0[6], p0[7], p0[8]), a3 = max3f(p0[9], p0[10], p0[11]);
                  float a4 = max3f(p0[12], p0[13], p0[14]), a5 = max3f(p0[15], p1[0], p1[1]), a6 = max3f(p1[2], p1[3], p1[4]), a7 = max3f(p1[5], p1[6], p1[7]);
                  float a8 = max3f(p1[8], p1[9], p1[10]), a9 = max3f(p1[11], p1[12], p1[13]), a10 = max3f(p1[14], p1[15], a0);
                  a1 = max3f(a1, a2, a3); a4 = max3f(a4, a5, a6); a7 = max3f(a7, a8, a9);
                  mx = xhalf_max(max3f(max3f(a1, a4, a7), a10, a10)); }
                if (first || __any(mx > 6.0f)) {
                    const float dl = first ? mx : fmaxf(mx, 0.f);
#pragma unroll
                    for (int r = 0; r < 16; ++r) { p0[r] -= dl; p1[r] -= dl; }
                    mrun += dl;
                    if (!first) { const float alpha = __builtin_amdgcn_exp2f(-dl); lrun *= alpha;
#pragma unroll
                        for (int d = 0; d < NACC; ++d)
#pragma unroll
                            for (int r = 0; r < 16; ++r) o[d][r] *= alpha; }
                    first = false;
                }
#pragma unroll
                for (int r = 0; r < 16; ++r) { p0[r] = __builtin_amdgcn_exp2f(p0[r]); p1[r] = __builtin_amdgcn_exp2f(p1[r]); }
                { float s0 = p0[0] + p1[0], s1 = p0[1] + p1[1], s2 = p0[2] + p1[2], s3 = p0[3] + p1[3];
#pragma unroll
                  for (int r = 4; r < 16; r += 4) { s0 += p0[r] + p1[r]; s1 += p0[r + 1] + p1[r + 1]; s2 += p0[r + 2] + p1[r + 2]; s3 += p0[r + 3] + p1[r + 3]; }
                  lrun += (s0 + s1) + (s2 + s3); }
                pf0 = pack8(p0, 0); pf1 = pack8(p0, 8); pf2 = pack8(p1, 0); pf3 = pack8(p1, 8);
                wdone = __all(rowc - slope2 * (float)(t - k0 + 1) < mrun - 32.0f) != 0;
            } else {
                float ts = 0.f;
                f32x16 l0, l1;
#pragma unroll
                for (int r = 0; r < 16; ++r) {
                    { const float z = p0[r]; const float e = __builtin_amdgcn_exp2f(-fabsf(z)); const float sp = fmaxf(-z, 0.f) + __builtin_amdgcn_logf(1.0f + e);
                      const float lb = -sp; float lm = lb - z; if (diag && !(k0 + crow(r, hi) < t)) lm = 0.f; l0[r] = lm; ts += lm; p0[r] = lb + carry; }
                    { const float z = p1[r]; const float e = __builtin_amdgcn_exp2f(-fabsf(z)); const float sp = fmaxf(-z, 0.f) + __builtin_amdgcn_logf(1.0f + e);
                      const float lb = -sp; float lm = lb - z; if (diag && !(k0 + 32 + crow(r, hi) < t)) lm = 0.f; l1[r] = lm; ts += lm; p1[r] = lb + carry; }
                }
                const bf16x8 L0a = pack8(l0, 0), L0b = pack8(l0, 8), L1a = pack8(l1, 0), L1b = pack8(l1, 8);
                p0 = MFMA32(ut0, L0a, p0); p0 = MFMA32(ut1, L0b, p0); p0 = MFMA32(uone, L1a, p0); p0 = MFMA32(uone, L1b, p0);
                p1 = MFMA32(ut0, L1a, p1); p1 = MFMA32(ut1, L1b, p1);
#pragma unroll
                for (int r = 0; r < 16; ++r) {
                    float a0 = __builtin_amdgcn_exp2f(p0[r]), a1 = __builtin_amdgcn_exp2f(p1[r]);
                    if (diag) { if (!(k0 + crow(r, hi) < t)) a0 = 0.f; if (!(k0 + 32 + crow(r, hi) < t)) a1 = 0.f; }
                    p0[r] = a0; p1[r] = a1;
                }
                ts = xhalf_sum(ts);
                carry += ts;
                pf0 = pack8(p0, 0); pf1 = pack8(p0, 8); pf2 = pack8(p1, 0); pf3 = pack8(p1, 8);
                wdone = __all(carry < THR) != 0;
            }
#pragma unroll
            for (int d = 0; d < NDB; ++d) {
                const LAS unsigned char* vb = sb + 2 * SB2_KB + d * 32 * KSTR + koff;
                const bf16x8 v0 = *(const LAS bf16x8*)(vb), v1 = *(const LAS bf16x8*)(vb + 32), v2 = *(const LAS bf16x8*)(vb + 64), v3 = *(const LAS bf16x8*)(vb + 96);
                o[d] = MFMA32(v0, pf0, o[d]); o[d] = MFMA32(v1, pf1, o[d]); o[d] = MFMA32(v2, pf2, o[d]); o[d] = MFMA32(v3, pf3, o[d]);
            }
        }
        if (hasn) ATT_STORE(hh ^ 1, hh ^ 1);
        if (lane == 0) flags[hh * 8 + wid] = wdone ? 1u : 0u;
        __syncthreads();
        if (!hasn) { fin = true; break; }
        { const unsigned f = flags[hh * 8 + (lane & 7)]; if (__all(f != 0u)) { fin = true; break; } }
        --kt;
      }
      if (fin) break;
    }
#undef ATT_LOAD
#undef ATT_STORE
    if (MODE == 0) {
        const float inv = 1.0f / xhalf_sum(lrun);
        bf16* op = (bf16*)Of + (rowbase + t) * 1024 + ocol + 4 * hi;
#pragma unroll
        for (int d = 0; d < NDB; ++d)
#pragma unroll
            for (int g = 0; g < 4; ++g) { u32x2 w; w.x = pk_bf16(o[d][4 * g] * inv, o[d][4 * g + 1] * inv); w.y = pk_bf16(o[d][4 * g + 2] * inv, o[d][4 * g + 3] * inv); *(GAS u32x2*)(op + 32 * d + 8 * g) = w; }
    } else {
        bf16* op = Ob + (rowbase + t) * 512 + ocol + 4 * hi;
#pragma unroll
        for (int d = 0; d < NDB; ++d)
#pragma unroll
            for (int g = 0; g < 4; ++g) { u32x2 w; w.x = pk_bf16(o[d][4 * g], o[d][4 * g + 1]); w.y = pk_bf16(o[d][4 * g + 2], o[d][4 * g + 3]); *(GAS u32x2*)(op + 32 * d + 8 * g) = w; }
    }
}
#undef MFMA32
}

#define XB_TMO      128
#define XB_XCNT(j)  (256  + 64 * (j))
#define XB_XSUB(j)  (1280 + 64 * (j))
#define XB_XGEN(j)  (2304 + 64 * (j))
#define XB_TOP      3328
#define XB_TOPGEN   3392
#define XCD_BAR_WORDS 3456
#define XB_SPIN_CAP (1u << 18)

__device__ __forceinline__ unsigned xb_ld(unsigned* p)              { return __hip_atomic_load(p, __ATOMIC_RELAXED, __HIP_MEMORY_SCOPE_AGENT); }
__device__ __forceinline__ unsigned xb_add(unsigned* p, unsigned v) { return __hip_atomic_fetch_add(p, v, __ATOMIC_RELAXED, __HIP_MEMORY_SCOPE_AGENT); }
__device__ __forceinline__ unsigned xb_xcc_id() { return (unsigned)__builtin_amdgcn_s_getreg((3 << 11) | 20) & 0xFu; }
#define XB_SPIN(cond, bar) do { unsigned _sp = 0; while (cond) { __builtin_amdgcn_s_sleep(1); \
    if ((++_sp & 255u) == 0u) { if (xb_ld(&(bar)[XB_TMO])) break; if (_sp > XB_SPIN_CAP) { atomicAdd(&(bar)[XB_TMO], 1u); break; } } } } while (0)

struct XcdBarrier {
    unsigned* bar; unsigned x;
    volatile LAS unsigned* st;
};

__device__ __forceinline__ XcdBarrier xcd_barrier_post(unsigned* bar, volatile LAS unsigned* st) {
    XcdBarrier b; b.bar = bar; b.x = xb_xcc_id(); b.st = st;
    if (threadIdx.x == 0) (void)xb_add(&bar[XB_XCNT(b.x)], 1u);
    return b;
}
__device__ __forceinline__ void xcd_barrier_complete(unsigned* bar, unsigned x, unsigned& nloc, unsigned& nx) {
    const unsigned G = gridDim.x * gridDim.y * gridDim.z;
    unsigned sum, cnt, mine, sp = 0u;
    for (;;) {
        sum = 0u; cnt = 0u; mine = 0u;
#pragma unroll
        for (unsigned j = 0; j < 16; ++j) { const unsigned c = xb_ld(&bar[XB_XCNT(j)]); sum += c; cnt += (c > 0u) ? 1u : 0u; mine = (j == x) ? c : mine; }
        if (sum == G) break;
        __builtin_amdgcn_s_sleep(1);
        if ((++sp & 255u) == 0u) { if (xb_ld(&bar[XB_TMO])) break; if (sp > XB_SPIN_CAP) { atomicAdd(&bar[XB_TMO], 1u); break; } }
    }
    nloc = mine > 0u ? mine : 1u; nx = cnt > 0u ? cnt : 1u;
}

__device__ __forceinline__ void xcd_barrier(const XcdBarrier& b) {
    asm volatile("s_waitcnt vmcnt(0)" ::: "memory");
    __syncthreads();
    if (threadIdx.x == 0) {
        unsigned* bar = b.bar;
        __builtin_amdgcn_s_waitcnt(0);
        unsigned nloc = b.st[0], nx = b.st[1];
        if (nloc == 0u) { xcd_barrier_complete(bar, b.x, nloc, nx); b.st[0] = nloc; b.st[1] = nx; }
        const unsigned old = xb_add(&bar[XB_XSUB(b.x)], 1u);
        const unsigned gen = old / nloc;
        if (old + 1u == (gen + 1u) * nloc) {
            __builtin_amdgcn_fence(__ATOMIC_RELEASE, "agent");
            asm volatile("s_waitcnt vmcnt(0)" ::: "memory");
            const unsigned og = xb_add(&bar[XB_TOP], 1u);
            const unsigned tg = og / nx;
            if (og + 1u == (tg + 1u) * nx) xb_add(&bar[XB_TOPGEN], 1u);
            else XB_SPIN(xb_ld(&bar[XB_TOPGEN]) == tg, bar);
            __builtin_amdgcn_fence(__ATOMIC_ACQUIRE, "agent");
            xb_add(&bar[XB_XGEN(b.x)], 1u);
            asm volatile("s_waitcnt vmcnt(0)" ::: "memory");
        } else {
            XB_SPIN(xb_ld(&bar[XB_XGEN(b.x)]) == gen, bar);
            __builtin_amdgcn_fence(__ATOMIC_ACQUIRE, "agent");
            asm volatile("s_waitcnt vmcnt(0)" ::: "memory");
        }
    }
    __syncthreads();
}

#ifndef WGM_GU
#define WGM_GU 4
#endif
#ifndef WGM_N1K
#define WGM_N1K 4
#endif
#ifndef WGM_IN
#define WGM_IN 4
#endif
#ifndef PHASE_MASK
#define PHASE_MASK 0xFFFF
#endif
#define PH(n) (((PHASE_MASK) >> (n)) & 1)
#ifndef DUP_MASK
#define DUP_MASK 0
#endif
#ifndef ATT_DUP
#define ATT_DUP 0
#endif
#define REP(n) for (int rep_ = 0; rep_ < 1 + (((DUP_MASK) >> (n)) & 1); ++rep_)
#ifndef ATT_PASS_MASK
#define ATT_PASS_MASK 3
#endif
struct Args { const float* in[24]; float* out; unsigned char* ws; };

__device__ __forceinline__ void transpose_item(const float* __restrict__ W, int K, int N, bf16* __restrict__ WT, int mode, LAS float* scr, int item, int lane) {
    const int nblk = N / 32, kb = item / nblk, nb = item % nblk, k0 = 64 * kb, n0 = 32 * nb;
#pragma unroll
    for (int i = 0; i < 8; ++i) { const int kk = 8 * i + (lane >> 3), nq = 4 * (lane & 7);
        const f32x4 v = __builtin_nontemporal_load((const GAS f32x4*)(W + (size_t)(k0 + kk) * N + n0 + nq)); LAS float* d = scr + kk * 33 + nq; d[0] = v.x; d[1] = v.y; d[2] = v.z; d[3] = v.w; }
    asm volatile("s_waitcnt lgkmcnt(0)" ::: "memory");
    const int c = lane & 7;
#pragma unroll
    for (int j = 0; j < 4; ++j) { const int n = (lane >> 3) + 8 * j; const LAS float* s = scr + (8 * c) * 33 + n;
        u32x4 o; o.x = pk_bf16(s[0 * 33], s[1 * 33]); o.y = pk_bf16(s[2 * 33], s[3 * 33]); o.z = pk_bf16(s[4 * 33], s[5 * 33]); o.w = pk_bf16(s[6 * 33], s[7 * 33]);
        const int ng = n0 + n; const int nr = (mode == 0) ? ng : (256 * (ng >> 7) + (ng & 127) + (mode == 2 ? 128 : 0));
        *(GAS u32x4*)(WT + (size_t)nr * K + k0 + 8 * c) = o; }
    asm volatile("s_waitcnt lgkmcnt(0)" ::: "memory");
}

template <bool HAS_F, bool HAS_H, bool XIN_B = false, bool XOUT_B = false>
__device__ __forceinline__ void rowpass(const void* xin_, const bf16* __restrict__ Fb, void* xout_, bf16* __restrict__ H,
                                        const float* __restrict__ gpost, const float* __restrict__ modp, int gi  , float resw,
                                        const float* __restrict__ gpre, int sci, int shi, int gw, int lane) {
    constexpr int RPW = M / 2048;
    const int row_lo = gw * RPW; const int b = row_lo / SEQ;
    const float* mb = modp + (size_t)b * (NMOD * DM);
    f32x4 Cg[4], A[4], Sh[4];
#pragma unroll
    for (int j = 0; j < 4; ++j) { const int col = 256 * j + 4 * lane;
        if (HAS_F) { const f32x4 g = *(const GAS f32x4*)(mb + gi * DM + col), gp = *(const GAS f32x4*)(gpost + col); Cg[j] = g * gp * resw; }
        if (HAS_H) { const f32x4 s = *(const GAS f32x4*)(mb + sci * DM + col), gp = *(const GAS f32x4*)(gpre + col); A[j] = gp * (s + 1.0f); Sh[j] = *(const GAS f32x4*)(mb + shi * DM + col); } }
    const float* xin = (const float*)xin_; const bf16* xinb = (const bf16*)xin_; float* xout = (float*)xout_; bf16* xoutb = (bf16*)xout_;
#define RP_LDX(dst, r, j) do { if (XIN_B) { const u32x2 w_ = __builtin_nontemporal_load((const GAS u32x2*)(xinb + (size_t)(r) * DM + 256 * (j) + 4 * lane)); \
        dst = (f32x4){__uint_as_float(w_.x << 16), __uint_as_float(w_.x & 0xffff0000u), __uint_as_float(w_.y << 16), __uint_as_float(w_.y & 0xffff0000u)}; } \
      else dst = __builtin_nontemporal_load((const GAS f32x4*)(xin + (size_t)(r) * DM + 256 * (j) + 4 * lane)); } while (0)
    f32x4 xn[4]; u32x2 fn[4];
#pragma unroll
    for (int j = 0; j < 4; ++j) { RP_LDX(xn[j], row_lo, j); if (HAS_F) fn[j] = __builtin_nontemporal_load((const GAS u32x2*)(Fb + (size_t)row_lo * DM + 256 * j + 4 * lane)); }
    for (int row = row_lo; row < row_lo + RPW; ++row) {
        f32x4 x[4]; u32x2 fwv[4];
#pragma unroll
        for (int j = 0; j < 4; ++j) { x[j] = xn[j]; if (HAS_F) fwv[j] = fn[j]; }
        { const int rn = (row + 1 < row_lo + RPW) ? row + 1 : row;
#pragma unroll
          for (int j = 0; j < 4; ++j) { RP_LDX(xn[j], rn, j); if (HAS_F) fn[j] = __builtin_nontemporal_load((const GAS u32x2*)(Fb + (size_t)rn * DM + 256 * j + 4 * lane)); } }
        if (HAS_F) {
            f32x4 f[4]; float ss = 0.f;
#pragma unroll
            for (int j = 0; j < 4; ++j) { const u32x2 fw = fwv[j];
                f[j] = (f32x4){__uint_as_float(fw.x << 16), __uint_as_float(fw.x & 0xffff0000u), __uint_as_float(fw.y << 16), __uint_as_float(fw.y & 0xffff0000u)}; ss += (f[j].x * f[j].x + f[j].y * f[j].y) + (f[j].z * f[j].z + f[j].w * f[j].w); }
            const float rstd = 1.0f / sqrtf(wave_sum(ss) * (1.0f / DM) + RMS_EPS);
#pragma unroll
            for (int j = 0; j < 4; ++j) { x[j] = x[j] + f[j] * rstd * Cg[j];
                if (XOUT_B) { u32x2 w; w.x = pk_bf16(x[j].x, x[j].y); w.y = pk_bf16(x[j].z, x[j].w); *(GAS u32x2*)(xoutb + (size_t)row * DM + 256 * j + 4 * lane) = w;
                    x[j] = (f32x4){__uint_as_float(w.x << 16), __uint_as_float(w.x & 0xffff0000u), __uint_as_float(w.y << 16), __uint_as_float(w.y & 0xffff0000u)}; }
                else __builtin_nontemporal_store(x[j], (GAS f32x4*)(xout + (size_t)row * DM + 256 * j + 4 * lane)); }
        }
        if (HAS_H) {
            float ss = 0.f;
#pragma unroll
            for (int j = 0; j < 4; ++j) ss += (x[j].x * x[j].x + x[j].y * x[j].y) + (x[j].z * x[j].z + x[j].w * x[j].w);
            const float rstd = 1.0f / sqrtf(wave_sum(ss) * (1.0f / DM) + RMS_EPS);
#pragma unroll
            for (int j = 0; j < 4; ++j) { const f32x4 h = x[j] * rstd * A[j] + Sh[j]; u32x2 w; w.x = pk_bf16(h.x, h.y); w.y = pk_bf16(h.z, h.w);
                *(GAS u32x2*)(H + (size_t)row * DM + 256 * j + 4 * lane) = w; }
        }
    }
}
#undef RP_LDX

__device__ __forceinline__ void rowpass_attn(const float* __restrict__ Od, const bf16* __restrict__ Os, bf16* __restrict__ H, const float* __restrict__ subln,
                                             const float* __restrict__ sbeta, float lam, int gw, int lane) {
    constexpr int RPW = M / 2048;
    const int hd = lane >> 4, e0 = 8 * (lane & 15);
    const f32x4 sl0 = *(const GAS f32x4*)(subln + e0), sl1 = *(const GAS f32x4*)(subln + e0 + 4);
    const f32x4 be0 = *(const GAS f32x4*)(sbeta + 8 * lane), be1 = *(const GAS f32x4*)(sbeta + 8 * lane + 4);
#define RA_UNPK(W_, V_) do { V_[0] = __uint_as_float(W_.x << 16); V_[1] = __uint_as_float(W_.x & 0xffff0000u); V_[2] = __uint_as_float(W_.y << 16); V_[3] = __uint_as_float(W_.y & 0xffff0000u); \
        V_[4] = __uint_as_float(W_.z << 16); V_[5] = __uint_as_float(W_.z & 0xffff0000u); V_[6] = __uint_as_float(W_.w << 16); V_[7] = __uint_as_float(W_.w & 0xffff0000u); } while (0)
    const int row_lo = gw * RPW;
    u32x4 n0 = __builtin_nontemporal_load((const GAS u32x4*)((const bf16*)Od + (size_t)row_lo * 1024 + hd * 256 + e0)), n1 = __builtin_nontemporal_load((const GAS u32x4*)((const bf16*)Od + (size_t)row_lo * 1024 + hd * 256 + 128 + e0));
    u32x4 ns = __builtin_nontemporal_load((const GAS u32x4*)(Os + (size_t)row_lo * 512 + 8 * lane));
    for (int row = row_lo; row < row_lo + RPW; ++row) {
        const u32x4 w0 = n0, w1 = n1, ws = ns;
        { const int rn = (row + 1 < row_lo + RPW) ? row + 1 : row;
          n0 = __builtin_nontemporal_load((const GAS u32x4*)((const bf16*)Od + (size_t)rn * 1024 + hd * 256 + e0)); n1 = __builtin_nontemporal_load((const GAS u32x4*)((const bf16*)Od + (size_t)rn * 1024 + hd * 256 + 128 + e0));
          ns = __builtin_nontemporal_load((const GAS u32x4*)(Os + (size_t)rn * 512 + 8 * lane)); }
        float a0[8], a1[8], v[8], sv[8];
        RA_UNPK(w0, a0); RA_UNPK(w1, a1); RA_UNPK(ws, sv);
        float ss = 0.f, s2 = 0.f;
#pragma unroll
        for (int i = 0; i < 8; ++i) { v[i] = a0[i] - a1[i] * lam; ss += v[i] * v[i]; s2 += sv[i] * sv[i]; }
        ss = row16_sum(ss);
        const float rstd = 0.8f / sqrtf(ss * (1.0f / 128.0f) + RMS_EPS);
        u32x4 od; od.x = pk_bf16(v[0] * rstd * sl0.x, v[1] * rstd * sl0.y); od.y = pk_bf16(v[2] * rstd * sl0.z, v[3] * rstd * sl0.w);
        od.z = pk_bf16(v[4] * rstd * sl1.x, v[5] * rstd * sl1.y); od.w = pk_bf16(v[6] * rstd * sl1.z, v[7] * rstd * sl1.w);
        *(GAS u32x4*)(H + (size_t)row * 1024 + hd * 128 + e0) = od;
        const float rstd2 = 1.0f / sqrtf(wave_sum(s2) * (1.0f / 512.0f) + RMS_EPS);
        u32x4 o; o.x = pk_bf16(sv[0] * rstd2 * be0.x, sv[1] * rstd2 * be0.y); o.y = pk_bf16(sv[2] * rstd2 * be0.z, sv[3] * rstd2 * be0.w);
        o.z = pk_bf16(sv[4] * rstd2 * be1.x, sv[5] * rstd2 * be1.y); o.w = pk_bf16(sv[6] * rstd2 * be1.z, sv[7] * rstd2 * be1.w);
        *(GAS u32x4*)(H + (size_t)row * 1024 + 512 + 8 * lane) = o;
    }
#undef RA_UNPK
}

#define KAS __attribute__((address_space(4)))
__device__ __forceinline__ const float* karg(int i) { const KAS char* ka = (const KAS char*)__builtin_amdgcn_kernarg_segment_ptr(); return (const float*)(*(const volatile KAS unsigned long long*)(ka + 8 * i)); }
#define AIN(i) karg(i)
__device__ __forceinline__ int fresh_tid() { int t = threadIdx.x; asm volatile("" : "+v"(t)); return t; }
__global__ void __launch_bounds__(512) fwd_megakernel(Args args) {
    extern __shared__ __attribute__((aligned(16))) unsigned char lds_raw[];
    cg::grid_group grid = cg::this_grid();
    LAS unsigned char* lds = (LAS unsigned char*)lds_raw;
    const int wave = __builtin_amdgcn_readfirstlane((int)threadIdx.x >> 6);
#define tid (fresh_tid())
#define lane (fresh_tid() & 63)
    const int G = gridDim.x, bx = blockIdx.x;
    const int vcu = (G % 8 == 0) ? (bx % 8) * (G / 8) + bx / 8 : bx;
    const int gw = vcu * 8 + wave, NGW = G * 8;
    unsigned* ctlw = (unsigned*)((unsigned char*)karg(25) + WS_CTLW);
    volatile LAS unsigned* MISC = (volatile LAS unsigned*)(lds + GEMM_LDS);
    if (tid < 64) MISC[tid] = 0u;
    __syncthreads();
    XcdBarrier bar = xcd_barrier_post(ctlw, MISC + 8);
#define WSP(off) ((unsigned char*)karg(25) + (off))
#define ctl ((float*)WSP(WS_CTL))
#define modp (((float*)WSP(WS_CTL)) + 1024)
#define out ((float*)karg(24))
#define Wgu1 ((bf16*)WSP(WS_WGU1))
#define Wd1 ((bf16*)WSP(WS_WD1))
#define Win ((bf16*)WSP(WS_WIN))
#define Wout ((bf16*)WSP(WS_WOUT))
#define Wgu2 ((bf16*)WSP(WS_WGU2))
#define Wd2 ((bf16*)WSP(WS_WD2))
#define H ((bf16*)WSP(WS_H))
#define F ((float*)WSP(WS_F))
#define ACT ((bf16*)WSP(WS_ACT))
#define QK ((bf16*)WSP(WS_ACT))
#define VtD ((bf16*)WSP(WS_VTD))
#define VtS ((bf16*)WSP(WS_VTS))
#define Osb ((bf16*)WSP(WS_OSB))
#define XB ((bf16*)WSP(WS_XB))
    if (PH(0)) REP(0) {
        if (bx < 144) {
            LAS float* sc = (LAS float*)lds;
            LAS float* red = sc + 4096;
            const float* c = AIN(1);
            for (int i = tid; i < 4096; i += 512) { const float v = c[i]; sc[i] = v / (1.0f + __expf(-v)); }
            __syncthreads();
            const int col = bx * 64 + (tid & 63), kg = tid >> 6;
            const float* wp = AIN(2) + (size_t)(kg * 128) * (NMOD * DM) + col;
            float a0 = 0.f, a1 = 0.f, a2 = 0.f, a3 = 0.f;
#pragma unroll 8
            for (int k = 0; k < 128; ++k) { const float w = __builtin_nontemporal_load((const GAS float*)wp + (size_t)k * (NMOD * DM)); const int kk = kg * 128 + k;
                a0 += sc[kk] * w; a1 += sc[1024 + kk] * w; a2 += sc[2048 + kk] * w; a3 += sc[3072 + kk] * w; }
            red[(kg * 4 + 0) * 64 + (tid & 63)] = a0; red[(kg * 4 + 1) * 64 + (tid & 63)] = a1; red[(kg * 4 + 2) * 64 + (tid & 63)] = a2; red[(kg * 4 + 3) * 64 + (tid & 63)] = a3;
            __syncthreads();
            if (tid < 256) { const int b = tid >> 6, cc = tid & 63; float s = 0.f;
#pragma unroll
                for (int g = 0; g < 8; ++g) s += red[(g * 4 + b) * 64 + cc];
                modp[(size_t)b * (NMOD * DM) + bx * 64 + cc] = s + AIN(3)[bx * 64 + cc]; }
            __syncthreads();
        }
        if (bx == G - 1 && wave == 0) {
            const float s1 = wave_sum(AIN(13)[lane] * AIN(14)[lane]), s2 = wave_sum(AIN(15)[lane] * AIN(16)[lane]);
            if (lane == 0) ctl[0] = __expf(s1) - __expf(s2) + 0.2f;
        }
        LAS float* scr = (LAS float*)(lds + wave * 16384);
        constexpr int I_G = (DM / 64) * (DFF / 32), I_D = (DFF / 64) * (DM / 32), I_IN = (DM / 64) * (3 * DM / 32), I_OUT = (DM / 64) * (DM / 32);
        static_assert(I_G == I_D, "item counts");
        constexpr int NEARLY = 3 * I_G + I_IN;
        for (int itx = gw; itx < NEARLY; itx += NGW) {
            int r = itx;
            if (r < I_G) { transpose_item(AIN(6), DM, DFF, Wgu1, 1, scr, r, lane); continue; } r -= I_G;
            if (r < I_G) { transpose_item(AIN(7), DM, DFF, Wgu1, 2, scr, r, lane); continue; } r -= I_G;
            if (r < I_D) { transpose_item(AIN(8), DFF, DM, Wd1, 0, scr, r, lane); continue; } r -= I_D;
            transpose_item(AIN(11), DM, 3 * DM, Win, 0, scr, r, lane);
        }
    }
    if (G == 0x7ffffff0) grid.sync();
    xcd_barrier(bar);
#ifdef EXTRA_SYNCS
    for (int es = 0; es < EXTRA_SYNCS; ++es) xcd_barrier(bar);
#endif
    if (PH(1)) REP(1) rowpass<false, true>(AIN(0), nullptr, nullptr, H, nullptr, modp, 0, 0.f, AIN(4), 1, 0, gw, lane);
    xcd_barrier(bar);
    if (PH(2)) REP(2) { pg8::Gemm g{H, Wgu1, M, 2 * DFF, DM}; pg8::StaticOrder S; S.init(M, 2 * DFF, G, bx, WGM_GU); pg8::EpiSwiglu E{ACT, DFF};
      pg8::gemm_phase<pg8::EpiSwiglu, pg8::StaticOrder, true, true>(lds, g, S, E); }
    xcd_barrier(bar);
    if (PH(3)) REP(3) { pg8::Gemm g{ACT, Wd1, M, DM, DFF}; pg8::StaticOrder S; S.init(M, DM, G, bx, WGM_N1K, 1); pg8::EpiBf16Out E{(bf16*)F, DM};
      pg8::gemm_phase<pg8::EpiBf16Out, pg8::StaticOrder, true, true>(lds, g, S, E); }
    xcd_barrier(bar);
    if (PH(4)) REP(4) rowpass<true, true, false, true>(AIN(0), (const bf16*)F, XB, H, AIN(5), modp, 2, 0.5f, AIN(9), 4, 3, gw, lane);
    xcd_barrier(bar);
    if (PH(5)) REP(5) { pg8::Gemm g{H, Win, M, 3 * DM, DM}; pg8::StaticOrder S; S.init(M, 3 * DM, G, bx, WGM_IN); pg8::EpiProj E{QK, VtD, VtS, C2, SEQ, ctlw + CW_KINF};
      pg8::gemm_phase<pg8::EpiProj, pg8::StaticOrder, true, true>(lds, g, S, E); }
    xcd_barrier(bar);
    if (PH(6)) {
        const unsigned* kinfw = ctlw + CW_KINF;
        LAS unsigned* uslot = (LAS unsigned*)(lds + att::FLAG_OFF + 128);
        const unsigned myx = xb_xcc_id() & 7u;
        for (int qi = 0; qi < 8; ++qi) {
            const unsigned xq = (myx + (unsigned)qi) & 7u;
            unsigned* qctr = ctlw + CW_QUEUE + 64 * xq;
            for (;;) {
                if (tid == 0) *uslot = atomicAdd(qctr, 1u);
                __syncthreads();
                const unsigned u = *uslot;
                __syncthreads();
                if (u >= 128u) break;
                const int h = 3 - (int)(u >> 5), qb = 31 - (int)(u & 31), b = (int)(xq >> 1), vh = 2 * h + (int)(xq & 1);
                const float slope2 = 1.4426950408889634f * exp2f(-2.0f * (float)(h + 1));
                const float kinfa = __uint_as_float(kinfw[(b * 8 + vh) * 2]), kinfb = __uint_as_float(kinfw[(b * 8 + vh) * 2 + 1]);
                att::attn_unit<0, 128>(lds, QK, vh * 64, 512 + vh * 64, VtD + ((size_t)(b * 512 + h * 128)) * SEQ, (size_t)b * SEQ, qb, slope2, kinfa, kinfb, F, nullptr, vh * 128);
            }
        }
        {
            unsigned* qctr = ctlw + CW_QUEUE + 64 * 8;
            volatile LAS unsigned* sslot = MISC + 40; LAS unsigned* sflags = (LAS unsigned*)(lds + GEMM_LDS) + 44;
            for (;;) {
                if (tid == 0) sslot[0] = atomicAdd(qctr, 1u);
                __syncthreads();
                const unsigned u = sslot[0];
                __syncthreads();
                if (u >= 1024u) break;
                const int v = (int)u, qb = 63 - (v >> 4), b = (v & 15) >> 2, hp = v & 3;
                att::sb_unit2<1, 64>(lds, QK, 1024 + hp * 128, 1536 + hp * 128, VtS + ((size_t)(b * 512 + hp * 128)) * SEQ, sflags, (size_t)b * SEQ, qb, 0.f, 0.f, 0.f, nullptr, Osb, hp * 128);
            }
        }
        {
            constexpr int I_G2 = (DM / 64) * (DFF / 32), I_OUT2 = (DM / 64) * (DM / 32), NLATE = 3 * I_G2 + I_OUT2;
            unsigned* tq = ctlw + CW_QUEUE + 64 * 9;
            volatile LAS unsigned* tslot = MISC + 32;
            LAS float* scr = (LAS float*)(lds + wave * 16384);
            for (;;) {
                if (tid == 0) tslot[0] = atomicAdd(tq, 1u);
                __syncthreads();
                const unsigned ch = tslot[0];
                __syncthreads();
                if (ch * 8u >= (unsigned)NLATE) break;
                int r = (int)ch * 8 + wave;
                if (r < NLATE) {
                    if (r < I_OUT2) transpose_item(AIN(12), DM, DM, Wout, 0, scr, r, lane);
                    else { r -= I_OUT2;
                        if (r < I_G2) transpose_item(AIN(21), DM, DFF, Wgu2, 1, scr, r, lane);
                        else if (r < 2 * I_G2) transpose_item(AIN(22), DM, DFF, Wgu2, 2, scr, r - I_G2, lane);
                        else transpose_item(AIN(23), DFF, DM, Wd2, 0, scr, r - 2 * I_G2, lane); }
                }
            }
        }
    }
    xcd_barrier(bar);
    if (PH(7)) REP(7) rowpass_attn(F, Osb, H, AIN(17), AIN(18), ctl[0], gw, lane);
    xcd_barrier(bar);
    if (PH(8)) REP(8) { pg8::Gemm g{H, Wout, M, DM, DM}; pg8::StaticOrder S; S.init(M, DM, G, bx, WGM_N1K); pg8::EpiBf16Out E{(bf16*)F, DM};
      pg8::gemm_phase<pg8::EpiBf16Out, pg8::StaticOrder, true, true>(lds, g, S, E); }
    xcd_barrier(bar);
    if (PH(9)) REP(9) rowpass<true, true, true, true>(XB, (const bf16*)F, XB, H, AIN(10), modp, 5, 1.0f, AIN(19), 7, 6, gw, lane);
    xcd_barrier(bar);
    if (PH(10)) REP(10) { pg8::Gemm g{H, Wgu2, M, 2 * DFF, DM}; pg8::StaticOrder S; S.init(M, 2 * DFF, G, bx, WGM_GU); pg8::EpiSwiglu E{ACT, DFF};
      pg8::gemm_phase<pg8::EpiSwiglu, pg8::StaticOrder, true, true>(lds, g, S, E); }
    xcd_barrier(bar);
    if (PH(11)) REP(11) { pg8::Gemm g{ACT, Wd2, M, DM, DFF}; pg8::StaticOrder S; S.init(M, DM, G, bx, WGM_N1K, 1); pg8::EpiBf16Out E{(bf16*)F, DM};
      pg8::gemm_phase<pg8::EpiBf16Out, pg8::StaticOrder, true, true>(lds, g, S, E); }
    xcd_barrier(bar);
    if (PH(12)) REP(12) rowpass<true, false, true, false>(XB, (const bf16*)F, out, nullptr, AIN(20), modp, 8, 0.5f, nullptr, 0, 0, gw, lane);
}
#undef ctl
#undef modp
#undef out
#undef Wgu1
#undef Wd1
#undef Win
#undef Wout
#undef Wgu2
#undef Wd2
#undef H
#undef F
#undef ACT
#undef QK
#undef VtD
#undef VtS
#undef Osb
#undef XB

#undef tid
#undef lane
extern "C" void kernel_launch(void* const* d_in, const int* in_sizes, int n_in, void* d_out, int out_size, void* d_ws, size_t ws_size, hipStream_t stream) {
    static int grid = 0;
    if (grid == 0) {
        if (n_in != 24 || out_size != M * DM || ws_size < WS_END) { fprintf(stderr, "kernel_launch: unexpected shapes (n_in %d out %d ws %zu)\n", n_in, out_size, ws_size); grid = -1; return; }
        int dev = 0, cus = 0, per_cu = 0;
        hipGetDevice(&dev); hipDeviceGetAttribute(&cus, hipDeviceAttributeMultiprocessorCount, dev);
        if (hipFuncSetAttribute((const void*)fwd_megakernel, hipFuncAttributeMaxDynamicSharedMemorySize, LDS_BYTES) != hipSuccess) { fprintf(stderr, "kernel_launch: hipFuncSetAttribute failed\n"); grid = -1; return; }
        if (hipOccupancyMaxActiveBlocksPerMultiprocessor(&per_cu, (const void*)fwd_megakernel, 512, LDS_BYTES) != hipSuccess || per_cu < 1) { fprintf(stderr, "kernel_launch: occupancy query says %d blocks per CU\n", per_cu); per_cu = 1; }
        (void)hipGetLastError();
        if (cus < 256) { fprintf(stderr, "kernel_launch: built for a 256-CU device (got %d CUs)\n", cus); grid = -1; return; }
        grid = 256;
    }
    if (grid < 0) return;
    if (hipMemsetAsync((char*)d_ws + WS_CTLW, 0, CTLW_BYTES, stream) != hipSuccess) { fprintf(stderr, "kernel_launch: memset of the control words failed\n"); return; }
    Args a{};
    for (int i = 0; i < 24; ++i) a.in[i] = (const float*)d_in[i];
    a.out = (float*)d_out; a.ws = (unsigned char*)d_ws;
    void* kargs[] = {&a};
    hipError_t e = hipLaunchCooperativeKernel((const void*)fwd_megakernel, dim3(grid), dim3(512), kargs, LDS_BYTES, stream);
    if (e != hipSuccess) fprintf(stderr, "cooperative launch failed: %s (grid %d)\n", hipGetErrorString(e), grid);
}
```

```cpp
#include <hip/hip_runtime.h>
#include <hip/hip_cooperative_groups.h>
#include <cstdio>
#include <cstdint>
#include <cmath>
namespace cg = cooperative_groups;
namespace pg8 {
#define PG8_LAS __attribute__((address_space(3)))
typedef unsigned short bf16_t;
typedef short bf16x8 __attribute__((ext_vector_type(8)));
typedef float f32x4 __attribute__((ext_vector_type(4)));
typedef unsigned u32x4 __attribute__((ext_vector_type(4)));
constexpr int BM = 256, BK = 64, HALF = 128, HTB = HALF * BK * 2  , STAGE_BYTES = 8 * HTB, NXCD = 8, WGM = 8;

__host__ __device__ __forceinline__ int lds_byte(int r, int c) { const int st = (r >> 4) * 2 + (c >> 5), rr = r & 15, cc = c & 31, ob = rr * 64 + cc * 2; return st * 1024 + (ob ^ (((ob >> 9) & 1) << 5)); }
__host__ __device__ __forceinline__ void stage_rc(int b, int& R, int& C) { const int st = b / 1024, sb = b % 1024, swz = sb ^ (((sb >> 9) & 1) << 5); R = (st >> 1) * 16 + swz / 64; C = (st & 1) * 32 + (swz % 64) / 2; }
__host__ __device__ __forceinline__ int perm32(int rho) { const int n = rho >> 4, i = rho & 15; return 8 * (i >> 2) + 4 * n + (i & 3); }

struct Unit { int pm, pn; };
struct Gemm { const bf16_t* A; const bf16_t* Bt; int M, N, K; };

struct StaticOrder {
    int nM, nN, nwg, G, c, wgm, rev;
    __host__ __device__ void init(int M, int N, int G_, int c_, int wgm_ = WGM, int rev_ = 0) { nM = M / BM; nN = N / BM; nwg = nM * nN; G = G_; c = c_; wgm = wgm_; rev = rev_; }
    __host__ __device__ bool next(int i, Unit& u) const {
        const long L = (long)i * G + c; if (L >= nwg) return false;
        int wgid = (int)L; { const int q = nwg / NXCD, r = nwg % NXCD, xcd = wgid % NXCD, off = wgid / NXCD; wgid = (xcd < r ? xcd * (q + 1) : r * (q + 1) + (xcd - r) * q) + off; }
        if (rev) wgid = nwg - 1 - wgid;
        const int nig = wgm * nN, gid = wgid / nig, fm = gid * wgm, gsz = (nM - fm) < wgm ? (nM - fm) : wgm;
        u.pm = fm + ((wgid % nig) % gsz); u.pn = (wgid % nig) / gsz; return true;
    }
    __device__ __forceinline__ void a_ready(const Unit&) const {}
    __device__ __forceinline__ void done(const Unit&) const {}
};

__device__ __forceinline__ unsigned cvt_pk_bf16(float lo, float hi) { unsigned r; asm volatile("v_cvt_pk_bf16_f32 %0, %1, %2" : "=v"(r) : "v"(lo), "v"(hi)); return r; }
#define PG8_GAS __attribute__((address_space(1)))
__device__ __forceinline__ float silu_mul(float g, float u) { const float e = __builtin_amdgcn_exp2f(g * -1.4426950408889634f); return g * __builtin_amdgcn_rcpf(1.0f + e) * u; }
struct EpiSwiglu {
    static constexpr bool PERM = true, AFTER_DRAIN = false;
    bf16_t* O; int ldc;
    __device__ __forceinline__ void operator()(const f32x4 (&acc)[2][2][4][2], const Unit& u, int wr, int wc, int fr, int fq) const {
        const int row0 = u.pm * BM + wr * 64 + fr; const int col0 = u.pn * HALF + wc * 32 + 8 * fq;
#pragma unroll
        for (int ai = 0; ai < 2; ++ai)
#pragma unroll
            for (int m = 0; m < 4; ++m) { bf16_t* rowp = O + (size_t)(row0 + ai * HALF + m * 16) * ldc + col0;
                const f32x4 g0 = acc[ai][0][m][0], g1 = acc[ai][0][m][1], u0 = acc[ai][1][m][0], u1 = acc[ai][1][m][1];
                u32x4 w; w.x = cvt_pk_bf16(silu_mul(g0[0], u0[0]), silu_mul(g0[1], u0[1])); w.y = cvt_pk_bf16(silu_mul(g0[2], u0[2]), silu_mul(g0[3], u0[3]));
                w.z = cvt_pk_bf16(silu_mul(g1[0], u1[0]), silu_mul(g1[1], u1[1])); w.w = cvt_pk_bf16(silu_mul(g1[2], u1[2]), silu_mul(g1[3], u1[3]));
                *(PG8_GAS u32x4*)rowp = w; }
    }
};
struct EpiBf16Out {
    static constexpr bool PERM = true, AFTER_DRAIN = false;
    bf16_t* O; int ldc;
    __device__ __forceinline__ void operator()(const f32x4 (&acc)[2][2][4][2], const Unit& u, int wr, int wc, int fr, int fq) const {
        const int row0 = u.pm * BM + wr * 64 + fr; const int col0 = u.pn * BM + wc * 32 + 8 * fq;
#pragma unroll
        for (int ai = 0; ai < 2; ++ai)
#pragma unroll
            for (int m = 0; m < 4; ++m) { bf16_t* rowp = O + (size_t)(row0 + ai * HALF + m * 16) * ldc + col0;
#pragma unroll
                for (int bj = 0; bj < 2; ++bj) { const f32x4 v0 = acc[ai][bj][m][0], v1 = acc[ai][bj][m][1];
                    u32x4 w; w.x = cvt_pk_bf16(v0[0], v0[1]); w.y = cvt_pk_bf16(v0[2], v0[3]); w.z = cvt_pk_bf16(v1[0], v1[1]); w.w = cvt_pk_bf16(v1[2], v1[3]);
                    *(PG8_GAS u32x4*)(rowp + bj * HALF) = w; } }
    }
};
struct EpiProj {
    static constexpr bool PERM = true, AFTER_DRAIN = false;
    bf16_t* QK; bf16_t* VtD; bf16_t* VtS; float qscale; int S; unsigned* kinf;
    __device__ __forceinline__ void operator()(const f32x4 (&acc)[2][2][4][2], const Unit& u, int wr, int wc, int fr, int fq) const {
        const int seg = u.pn >> 1, half = u.pn & 1;
        if (seg == 2 || seg == 5) {
            bf16_t* Vt = (seg == 2) ? VtD : VtS;
            const int row_t = u.pm * BM; const int b = row_t / S, t0 = row_t - b * S;
#pragma unroll
            for (int ai = 0; ai < 2; ++ai)
#pragma unroll
                for (int m = 0; m < 4; ++m) { const int t = t0 + ai * HALF + wr * 64 + m * 16 + fr; const int pos = (t & ~12) | ((t & 4) << 1) | ((t & 8) >> 1);
#pragma unroll
                    for (int bj = 0; bj < 2; ++bj)
#pragma unroll
                        for (int n = 0; n < 2; ++n) { const int ch = 256 * half + 128 * bj + 32 * wc + 8 * fq + 4 * n;
                            const f32x4 v = acc[ai][bj][m][n]; const unsigned w0 = cvt_pk_bf16(v[0], v[1]), w1 = cvt_pk_bf16(v[2], v[3]);
                            const unsigned snd = (fr & 1) ? w0 : w1;
                            const unsigned rcv = (unsigned)__builtin_amdgcn_update_dpp(0, (int)snd, 0xB1, 0xF, 0xF, true);
                            const unsigned lo = (fr & 1) ? rcv : w0, hi2 = (fr & 1) ? w1 : rcv;
                            const unsigned s0 = (lo & 0xffffu) | (hi2 << 16), s1 = (lo >> 16) | (hi2 & 0xffff0000u);
                            PG8_GAS bf16_t* p = (PG8_GAS bf16_t*)(Vt + ((size_t)(b * 512 + ch + 2 * (fr & 1))) * S + (pos & ~1));
                            *(PG8_GAS unsigned*)p = s0; *(PG8_GAS unsigned*)(p + (size_t)S) = s1; } }
        } else {
            const int cbase = ((seg == 0) ? 0 : (seg == 1) ? 512 : (seg == 3) ? 1024 : 1536) + 256 * half + wc * 32 + 8 * fq;
            const float sc = (seg == 0 || seg == 3) ? qscale : 1.0f;
            const int row0 = u.pm * BM + wr * 64 + fr;
#pragma unroll
            for (int ai = 0; ai < 2; ++ai)
#pragma unroll
                for (int m = 0; m < 4; ++m) { bf16_t* rowp = QK + (size_t)(row0 + ai * HALF + m * 16) * 2048 + cbase;
#pragma unroll
                    for (int bj = 0; bj < 2; ++bj) { const f32x4 v0 = acc[ai][bj][m][0] * sc, v1 = acc[ai][bj][m][1] * sc;
                        u32x4 w; w.x = cvt_pk_bf16(v0[0], v0[1]); w.y = cvt_pk_bf16(v0[2], v0[3]); w.z = cvt_pk_bf16(v1[0], v1[1]); w.w = cvt_pk_bf16(v1[2], v1[3]);
                        *(PG8_GAS u32x4*)(rowp + bj * HALF) = w; } }
            if (seg == 1) {
                const int b = (u.pm * BM) / S;
#pragma unroll
                for (int bj = 0; bj < 2; ++bj) { float v = 0.f;
#pragma unroll
                    for (int ai = 0; ai < 2; ++ai)
#pragma unroll
                        for (int m = 0; m < 4; ++m) { const f32x4 x = acc[ai][bj][m][0], y = acc[ai][bj][m][1];
                            float s2 = (x[0] * x[0] + x[1] * x[1]) + (x[2] * x[2] + x[3] * x[3]) + (y[0] * y[0] + y[1] * y[1]) + (y[2] * y[2] + y[3] * y[3]);
                            s2 += __shfl_xor(s2, 16); s2 += __shfl_xor(s2, 32);
                            v = fmaxf(v, s2); }
#pragma unroll
                    for (int o = 1; o < 16; o <<= 1) v = fmaxf(v, __shfl_xor(v, o));
                    if (fr == 0 && fq == 0) atomicMax(kinf + (b * 8 + 4 * half + 2 * bj + (wc >> 1)) * 2 + (wc & 1), __float_as_uint(v)); }
            }
        }
    }
};

template <class Epi, class Sched, bool ALIGN_EPI = false, bool SP2 = false>
__device__ __forceinline__ void gemm_phase(PG8_LAS unsigned char* lds, const Gemm g, const Sched& S, const Epi& E) {
    int tid_l = threadIdx.x; asm volatile("" : "+v"(tid_l));
    const int tid = tid_l, wid = __builtin_amdgcn_readfirstlane(tid >> 6), lane = tid & 63, wr = wid >> 2, wc = wid & 3, fr = lane & 15, fq = lane >> 4;
    const int K = g.K, nt = K / BK;
    unsigned voffA[2], voffB[2];
#pragma unroll
    for (int i = 0; i < 2; ++i) { int R, C; stage_rc(tid * 16 + i * 8192, R, C); const int Rb = Epi::PERM ? ((R & ~31) + perm32(R & 31)) : R;
        voffA[i] = (unsigned)(R * K + C) * 2u; voffB[i] = (unsigned)(Rb * K + C) * 2u; }
    const size_t kstep = (size_t)(BK * 2);
    const size_t hstep = (size_t)HALF * K * 2;
    const size_t tstep = 2 * hstep;
    const unsigned ldsw = (unsigned)wid * 1024u;
    const int aoff = lds_byte(wr * 64 + fr, fq * 8), boff = lds_byte(wc * 32 + fr, fq * 8);
#define PG8_SA(b, h) (((b) * 2 + (h)) * HTB)
#define PG8_SB(b, h) ((4 + (b) * 2 + (h)) * HTB)
#define PG8_STAGE(bufoff, gbase, voff) do { _Pragma("unroll") for (int _i = 0; _i < 2; ++_i) \
        __builtin_amdgcn_global_load_lds((const unsigned*)((const char*)(gbase) + (voff)[_i]), (PG8_LAS unsigned*)(lds + (bufoff) + ldsw + _i * 8192), 16, 0, 0); } while (0)
#define PG8_LDA(dst, b, h) do { _Pragma("unroll") for (int m = 0; m < 4; ++m) _Pragma("unroll") for (int k = 0; k < 2; ++k) dst[m][k] = *(const PG8_LAS bf16x8*)(lds + PG8_SA(b, h) + aoff + m * 2048 + k * 1024); } while (0)
#define PG8_LDB(dst, b, h) do { _Pragma("unroll") for (int n = 0; n < 2; ++n) _Pragma("unroll") for (int k = 0; k < 2; ++k) dst[n][k] = *(const PG8_LAS bf16x8*)(lds + PG8_SB(b, h) + boff + n * 2048 + k * 1024); } while (0)
#define PG8_MMA(ai, bj, At, Bt) do { __builtin_amdgcn_s_setprio(1); _Pragma("unroll") for (int m = 0; m < 4; ++m) _Pragma("unroll") for (int n = 0; n < 2; ++n) _Pragma("unroll") for (int k = 0; k < 2; ++k) \
        acc[ai][bj][m][n] = __builtin_amdgcn_mfma_f32_16x16x32_bf16(Bt[n][k], At[m][k], acc[ai][bj][m][n], 0, 0, 0); __builtin_amdgcn_s_setprio(0); } while (0)
#define PG8_WAIT_V(n) asm volatile("s_waitcnt vmcnt(" #n ")" ::: "memory")
#define PG8_WAIT_L(n) asm volatile("s_waitcnt lgkmcnt(" #n ")" ::: "memory")
#define PG8_BAR __builtin_amdgcn_s_barrier()
#define PG8_SCHED __builtin_amdgcn_sched_barrier(0)
    Unit cur, nxt; int ui = 0;
    if (!S.next(0, cur)) return;
    f32x4 acc[2][2][4][2];
#pragma unroll
    for (int a = 0; a < 2; ++a)
#pragma unroll
        for (int b = 0; b < 2; ++b)
#pragma unroll
            for (int m = 0; m < 4; ++m)
#pragma unroll
                for (int n = 0; n < 2; ++n) acc[a][b][m][n] = (f32x4){0.f, 0.f, 0.f, 0.f};
    bf16x8 At[4][2], B0[2][2], B1[2][2];
    const char* cA = (const char*)g.A + (size_t)cur.pm * tstep; const char* cB = (const char*)g.Bt + (size_t)cur.pn * tstep;
    S.a_ready(cur);
    if constexpr (SP2) {
        PG8_STAGE(PG8_SB(0, 0), cB, voffB); PG8_STAGE(PG8_SB(0, 1), cB + hstep, voffB); PG8_STAGE(PG8_SA(0, 0), cA, voffA); PG8_STAGE(PG8_SA(0, 1), cA + hstep, voffA);
        if (wr == 1) PG8_BAR;
        PG8_WAIT_V(2); PG8_BAR;
        PG8_STAGE(PG8_SB(1, 0), cB + kstep, voffB); PG8_STAGE(PG8_SA(1, 0), cA + kstep, voffA); PG8_STAGE(PG8_SB(1, 1), cB + hstep + kstep, voffB);
        PG8_WAIT_V(6); PG8_BAR;
    } else {
        PG8_STAGE(PG8_SB(0, 0), cB, voffB); PG8_STAGE(PG8_SA(0, 0), cA, voffA); PG8_STAGE(PG8_SB(0, 1), cB + hstep, voffB); PG8_STAGE(PG8_SA(0, 1), cA + hstep, voffA);
        if (wr == 1) PG8_BAR;
        PG8_WAIT_V(4); PG8_BAR;
        PG8_STAGE(PG8_SB(1, 0), cB + kstep, voffB); PG8_STAGE(PG8_SA(1, 0), cA + kstep, voffA); PG8_STAGE(PG8_SB(1, 1), cB + hstep + kstep, voffB);
        PG8_WAIT_V(6); PG8_BAR;
    }
    for (;;) {
        const bool has_next = S.next(ui + 1, nxt);
        const char* nA = has_next ? (const char*)g.A + (size_t)nxt.pm * tstep : cA; const char* nB = has_next ? (const char*)g.Bt + (size_t)nxt.pn * tstep : cB;
        for (int t = 0; t < nt; t += 2) {
            const bool last = (t == nt - 2);
            const char* a1 = cA + (size_t)(t + 1) * kstep;
            const char* a2 = last ? nA : cA + (size_t)(t + 2) * kstep; const char* b2 = last ? nB : cB + (size_t)(t + 2) * kstep;
            const char* a3 = a2 + kstep; const char* b3 = b2 + kstep;
            if (last && has_next) S.a_ready(nxt);
            if constexpr (SP2) {
            PG8_LDB(B0, 0, 0); PG8_LDB(B1, 0, 1); PG8_SCHED; PG8_LDA(At, 0, 0); PG8_STAGE(PG8_SA(1, 1), a1 + hstep, voffA);
            PG8_WAIT_V(8); PG8_WAIT_L(0); PG8_BAR; PG8_MMA(0, 0, At, B0); PG8_MMA(0, 1, At, B1); PG8_BAR; PG8_SCHED;
            PG8_LDA(At, 0, 1); PG8_STAGE(PG8_SB(0, 0), b2, voffB); PG8_STAGE(PG8_SB(0, 1), b2 + hstep, voffB); PG8_STAGE(PG8_SA(0, 0), a2, voffA);
            PG8_WAIT_V(8); PG8_WAIT_L(0); PG8_BAR; PG8_MMA(1, 0, At, B0); PG8_MMA(1, 1, At, B1); PG8_BAR; PG8_SCHED;
            PG8_LDB(B0, 1, 0); PG8_LDB(B1, 1, 1); PG8_SCHED; PG8_LDA(At, 1, 0); PG8_STAGE(PG8_SA(0, 1), a2 + hstep, voffA);
            PG8_WAIT_V(8); PG8_WAIT_L(0); PG8_BAR; PG8_MMA(0, 0, At, B0); PG8_MMA(0, 1, At, B1); PG8_BAR; PG8_SCHED;
            PG8_LDA(At, 1, 1); PG8_STAGE(PG8_SB(1, 0), b3, voffB); PG8_STAGE(PG8_SB(1, 1), b3 + hstep, voffB); PG8_STAGE(PG8_SA(1, 0), a3, voffA);
            PG8_WAIT_V(8); PG8_WAIT_L(0); PG8_BAR; PG8_MMA(1, 0, At, B0); PG8_MMA(1, 1, At, B1); PG8_BAR; PG8_SCHED;
            } else {
            PG8_LDB(B0, 0, 0); PG8_SCHED; PG8_LDA(At, 0, 0); PG8_STAGE(PG8_SA(1, 1), a1 + hstep, voffA);
            PG8_WAIT_L(8); PG8_BAR; PG8_WAIT_L(0); PG8_MMA(0, 0, At, B0); PG8_BAR; PG8_SCHED;
            PG8_LDB(B1, 0, 1); PG8_STAGE(PG8_SB(0, 0), b2, voffB);
            PG8_BAR; PG8_WAIT_L(0); PG8_MMA(0, 1, At, B1); PG8_BAR;
            PG8_LDA(At, 0, 1); PG8_STAGE(PG8_SA(0, 0), a2, voffA);
            PG8_BAR; PG8_WAIT_L(0); PG8_MMA(1, 0, At, B0); PG8_BAR; PG8_SCHED;
            PG8_STAGE(PG8_SB(0, 1), b2 + hstep, voffB);
            PG8_WAIT_V(6); PG8_BAR; PG8_MMA(1, 1, At, B1); PG8_BAR;
            PG8_LDB(B0, 1, 0); PG8_SCHED; PG8_LDA(At, 1, 0); PG8_STAGE(PG8_SA(0, 1), a2 + hstep, voffA);
            PG8_WAIT_L(8); PG8_BAR; PG8_WAIT_L(0); PG8_MMA(0, 0, At, B0); PG8_BAR; PG8_SCHED;
            PG8_LDB(B1, 1, 1); PG8_STAGE(PG8_SB(1, 0), b3, voffB);
            PG8_BAR; PG8_WAIT_L(0); PG8_MMA(0, 1, At, B1); PG8_BAR;
            PG8_LDA(At, 1, 1); PG8_STAGE(PG8_SA(1, 0), a3, voffA);
            PG8_BAR; PG8_WAIT_L(0); PG8_MMA(1, 0, At, B0); PG8_BAR; PG8_SCHED;
            PG8_STAGE(PG8_SB(1, 1), b3 + hstep, voffB);
            PG8_WAIT_V(6); PG8_BAR; PG8_MMA(1, 1, At, B1); PG8_BAR;
            }
        }
        if constexpr (ALIGN_EPI) { if (wr == 0) PG8_BAR; }
        if constexpr (!Epi::AFTER_DRAIN) { E(acc, cur, wr, wc, fr, fq); S.done(cur); }
        if (!has_next) break;
#pragma unroll
        for (int a = 0; a < 2; ++a)
#pragma unroll
            for (int b = 0; b < 2; ++b)
#pragma unroll
                for (int m = 0; m < 4; ++m)
#pragma unroll
                    for (int n = 0; n < 2; ++n) acc[a][b][m][n] = (f32x4){0.f, 0.f, 0.f, 0.f};
        cur = nxt; cA = nA; cB = nB; ++ui;
        if constexpr (ALIGN_EPI) { if (wr == 1) PG8_BAR; }
    }
    PG8_WAIT_V(0);
    if constexpr (!ALIGN_EPI) { if (wr == 0) PG8_BAR; }
    PG8_BAR;
    if constexpr (Epi::AFTER_DRAIN) { E.fused(acc, cur, wr, wc, fr, fq, lds, wid, lane); S.done(cur); }
#undef PG8_SA
#undef PG8_SB
#undef PG8_STAGE
#undef PG8_LDA
#undef PG8_LDB
#undef PG8_MMA
#undef PG8_WAIT_V
#undef PG8_WAIT_L
#undef PG8_BAR
#undef PG8_SCHED
}
}

#define LAS __attribute__((address_space(3)))
#define GAS __attribute__((address_space(1)))
typedef unsigned short bf16;
typedef float f32x4 __attribute__((ext_vector_type(4)));
typedef float f32x2 __attribute__((ext_vector_type(2)));
typedef float f32x16 __attribute__((ext_vector_type(16)));
typedef short bf16x8 __attribute__((ext_vector_type(8)));
typedef unsigned u32x4 __attribute__((ext_vector_type(4)));
typedef unsigned u32x2 __attribute__((ext_vector_type(2)));
constexpr int NB = 4, SEQ = 8192, DM = 1024, DFF = 2816, M = NB * SEQ, NMOD = 9;
constexpr float RMS_EPS = 1e-6f;
constexpr float C2 = 0.125f * 1.4426950408889634f;
constexpr size_t MiB = 1u << 20;
constexpr size_t WS_CTL = 0;
constexpr size_t WS_WGU1 = 1 * MiB, WS_WD1 = 12 * MiB, WS_WIN = 18 * MiB, WS_WOUT = 24 * MiB, WS_WGU2 = 26 * MiB, WS_WD2 = 37 * MiB;
constexpr size_t WS_H = 48 * MiB;
constexpr size_t WS_F = 112 * MiB;
constexpr size_t WS_XB = 176 * MiB;
constexpr size_t WS_ACT = 240 * MiB;
constexpr size_t WS_VTD = 416 * MiB, WS_VTS = 448 * MiB;
constexpr size_t WS_OSB = 480 * MiB;
constexpr size_t WS_END = 512 * MiB;
constexpr int GEMM_LDS = 131072, LDS_BYTES = GEMM_LDS + 1024;
constexpr size_t WS_CTLW = 512 * 1024, CTLW_BYTES = 32 * 1024;
constexpr int CW_KINF = 4096, CW_QUEUE = 4160;

template <int CTRL> __device__ __forceinline__ float dpp_f(float v) { return __builtin_bit_cast(float, __builtin_amdgcn_update_dpp(0, __builtin_bit_cast(int, v), CTRL, 0xF, 0xF, true)); }
__device__ __forceinline__ float row16_sum(float v) {
    v += dpp_f<0xB1>(v);
    v += dpp_f<0x4E>(v);
    v += dpp_f<0x141>(v);
    v += dpp_f<0x140>(v);
    return v;
}
__device__ __forceinline__ float xrow_sum(float v) {
    { auto rr = __builtin_amdgcn_permlane16_swap(__float_as_uint(v), __float_as_uint(v), false, false); v = __uint_as_float(rr[0]) + __uint_as_float(rr[1]); }
    { auto rr = __builtin_amdgcn_permlane32_swap(__float_as_uint(v), __float_as_uint(v), false, false); v = __uint_as_float(rr[0]) + __uint_as_float(rr[1]); }
    return v;
}
__device__ __forceinline__ float wave_sum(float v) { return xrow_sum(row16_sum(v)); }
__device__ __forceinline__ unsigned pk_bf16(float lo, float hi) { return pg8::cvt_pk_bf16(lo, hi); }
__device__ __forceinline__ float bf2f(unsigned short h) { return __uint_as_float(((unsigned)h) << 16); }

namespace att {
constexpr int KSTR = 144;
constexpr int KBUFB = 64 * KSTR, STAGEB = KBUFB + 128 * KSTR;
constexpr int FLAG_OFF = 2 * STAGEB;
constexpr float THR = -48.0f;
__device__ __forceinline__ int crow(int r, int hi) { return (r & 3) + 8 * (r >> 2) + 4 * hi; }
typedef __bf16 bf16x2_t __attribute__((ext_vector_type(2)));
__device__ __forceinline__ unsigned cvtpk_c(float lo, float hi) { const f32x2 v = {lo, hi}; const bf16x2_t b = __builtin_convertvector(v, bf16x2_t); return __builtin_bit_cast(unsigned, b); }
__device__ __forceinline__ bf16x8 pack8(const f32x16& p, int b) {
    u32x4 w; w.x = cvtpk_c(p[b], p[b + 1]); w.y = cvtpk_c(p[b + 2], p[b + 3]); w.z = cvtpk_c(p[b + 4], p[b + 5]); w.w = cvtpk_c(p[b + 6], p[b + 7]);
    return __builtin_bit_cast(bf16x8, w);
}
#define MFMA32(a, b, c) __builtin_amdgcn_mfma_f32_32x32x16_bf16((a), (b), (c), 0, 0, 0)
__device__ __forceinline__ float max3f(float a, float b, float c) { float r; asm("v_max3_f32 %0, %1, %2, %3" : "=v"(r) : "v"(a), "v"(b), "v"(c)); return r; }
__device__ __forceinline__ float xhalf_max(float m) { auto rr = __builtin_amdgcn_permlane32_swap(__float_as_uint(m), __float_as_uint(m), false, false); return fmaxf(__uint_as_float(rr[0]), __uint_as_float(rr[1])); }
__device__ __forceinline__ float xhalf_sum(float m) { auto rr = __builtin_amdgcn_permlane32_swap(__float_as_uint(m), __float_as_uint(m), false, false); return __uint_as_float(rr[0]) + __uint_as_float(rr[1]); }

template <int MODE, int DV>
__device__ __forceinline__ void attn_unit(LAS unsigned char* lds, const bf16* __restrict__ QK, int qcol, int kcol, const bf16* __restrict__ Vt,
                                          size_t rowbase, int qb, float slope2, float kinfa, float kinfb, float* __restrict__ Of, bf16* __restrict__ Ob, int ocol) {
    constexpr int NDB = DV / 32, NVC = DV / 64, NACC = NDB;
    int tid_l = threadIdx.x; asm volatile("" : "+v"(tid_l));
    const int tid = tid_l, lane = tid & 63, r32 = lane & 31, hi = lane >> 5;
    const int wid = __builtin_amdgcn_readfirstlane(tid >> 6);
    const int q0 = qb * 256, tw0 = q0 + 32 * wid, t = tw0 + r32;
    const int NT = 4 * qb + 4;
    bf16x8 qf[4];
    { const bf16* qp = QK + (rowbase + t) * 2048 + qcol + hi * 8;
#pragma unroll
      for (int ds = 0; ds < 4; ++ds) qf[ds] = *(const GAS bf16x8*)(qp + ds * 16); }
    float rowc = 0.f;
    if (MODE == 0) {
        float sa = 0.f, sb2 = 0.f;
#pragma unroll
        for (int ds = 0; ds < 4; ++ds) { const u32x4 w = __builtin_bit_cast(u32x4, qf[ds]);
            const float e0 = __uint_as_float(w.x << 16), e1 = __uint_as_float(w.x & 0xffff0000u), e2 = __uint_as_float(w.y << 16), e3 = __uint_as_float(w.y & 0xffff0000u);
            const float e4 = __uint_as_float(w.z << 16), e5 = __uint_as_float(w.z & 0xffff0000u), e6 = __uint_as_float(w.w << 16), e7 = __uint_as_float(w.w & 0xffff0000u);
            const float q2 = (e0 * e0 + e1 * e1) + (e2 * e2 + e3 * e3) + (e4 * e4 + e5 * e5) + (e6 * e6 + e7 * e7);
            if (ds < 2) sa += q2; else sb2 += q2; }
        sa = xhalf_sum(sa); sb2 = xhalf_sum(sb2);
        rowc = (sqrtf(sa * kinfa) + sqrtf(sb2 * kinfb)) * 1.02f;
    }
    const int krow = tid >> 3, kch = tid & 7;
    const bf16* ksrc = QK + (rowbase + krow) * 2048 + kcol + kch * 8;
    const unsigned kdst = krow * KSTR + kch * 16;
    const bf16* vsrc = Vt + (size_t)krow * SEQ + kch * 8;
    const unsigned vdst = KBUFB + krow * KSTR + kch * 16;
    const unsigned koff = r32 * KSTR + hi * 16;
    LAS unsigned* flags = (LAS unsigned*)(lds + FLAG_OFF);

    f32x16 o[NACC];
#pragma unroll
    for (int d = 0; d < NACC; ++d)
#pragma unroll
        for (int r = 0; r < 16; ++r) o[d][r] = 0.f;
    float mrun = 0.f, carry = 0.f, lrun = 0.f;
    bool wdone = false, first = true;
    bf16x8 ut0, ut1, uone;
    { const u32x4 c = {0x3F803F80u, 0x3F803F80u, 0x3F803F80u, 0x3F803F80u}; uone = __builtin_bit_cast(bf16x8, c); }
    if (MODE == 1) {
        u32x4 a, b;
        unsigned e0[8], e1[8];
#pragma unroll
        for (int j = 0; j < 8; ++j) { const int jj = 8 * (j >> 2) + 4 * hi + (j & 3); e0[j] = (jj > r32) ? 0x3F80u : 0u; e1[j] = (16 + jj > r32) ? 0x3F80u : 0u; }
        a.x = e0[0] | (e0[1] << 16); a.y = e0[2] | (e0[3] << 16); a.z = e0[4] | (e0[5] << 16); a.w = e0[6] | (e0[7] << 16);
        b.x = e1[0] | (e1[1] << 16); b.y = e1[2] | (e1[3] << 16); b.z = e1[4] | (e1[5] << 16); b.w = e1[6] | (e1[7] << 16);
        ut0 = __builtin_bit_cast(bf16x8, a); ut1 = __builtin_bit_cast(bf16x8, b);
    }
    u32x4 kreg[2], vreg[2][NVC];
#define ATT_LOAD(set_, kt_) do { kreg[set_] = *(const GAS u32x4*)(ksrc + (size_t)(kt_) * 64 * 2048); \
        _Pragma("unroll") for (int i_ = 0; i_ < NVC; ++i_) vreg[set_][i_] = *(const GAS u32x4*)(vsrc + (size_t)i_ * 64 * SEQ + (kt_) * 64); } while (0)
#define ATT_STORE(set_, stg_) do { *(LAS u32x4*)(lds + (stg_) * STAGEB + kdst) = kreg[set_]; \
        _Pragma("unroll") for (int i_ = 0; i_ < NVC; ++i_) *(LAS u32x4*)(lds + (stg_) * STAGEB + vdst + i_ * 64 * KSTR) = vreg[set_][i_]; } while (0)
    ATT_LOAD(0, NT - 1); ATT_LOAD(1, (NT - 2 > 0) ? NT - 2 : 0); ATT_STORE(0, 0);
    __syncthreads();
    int kt = NT - 1; bool fin = false;
    for (;;) {
#pragma unroll
      for (int hh = 0; hh < 2; ++hh) {
        const bool hasn = (kt > 0);
        ATT_LOAD(hh, (kt - 2 > 0) ? kt - 2 : 0);
        const int k0 = kt * 64;
        const LAS unsigned char* sb = lds + hh * STAGEB;
        const bool active = ((MODE == 0) ? (k0 <= tw0 + 31) : (k0 < tw0 + 31)) && !wdone;
        if (active) {
            f32x16 p0, p1;
            if (MODE == 0) {
                const float bb = slope2 * (float)(k0 + 4 * hi - t) - mrun;
#pragma unroll
                for (int r = 0; r < 16; ++r) { const float c = __builtin_fmaf(slope2, (float)((r & 3) + 8 * (r >> 2)), bb); p0[r] = c; p1[r] = __builtin_fmaf(slope2, 32.0f, c); }
            } else {
#pragma unroll
                for (int r = 0; r < 16; ++r) { p0[r] = 0.f; p1[r] = 0.f; }
            }
#pragma unroll
            for (int ds = 0; ds < 4; ++ds) {
                const bf16x8 k0f = *(const LAS bf16x8*)(sb + koff + ds * 32);
                const bf16x8 k1f = *(const LAS bf16x8*)(sb + koff + 32 * KSTR + ds * 32);
                p0 = MFMA32(k0f, qf[ds], p0); p1 = MFMA32(k1f, qf[ds], p1);
            }
            const bool diag = (MODE == 0) ? (k0 + 63 > tw0) : (k0 + 63 >= tw0);
            bf16x8 pf0, pf1, pf2, pf3;
            if (MODE == 0) {
                if (diag) {
#pragma unroll
                    for (int r = 0; r < 16; ++r) { const int key = k0 + crow(r, hi); if (key > t) p0[r] = -INFINITY; if (key + 32 > t) p1[r] = -INFINITY; }
                }
                float mx;
                { float a0 = max3f(p0[0], p0[1], p0[2]), a1 = max3f(p0[3], p0[4], p0[5]), a2 = max3f(p0[6], p0[7], p0[8]), a3 = max3f(p0[9], p0[10], p0[11]);
                  float a4 = max3f(p0[12], p0[13], p0[14]), a5 = max3f(p0[15], p1[0], p1[1]), a6 = max3f(p1[2], p1[3], p1[4]), a7 = max3f(p1[5], p1[6], p1[7]);
                  float a8 = max3f(p1[8], p1[9], p1[10]), a9 = max3f(p1[11], p1[12], p1[13]), a10 = max3f(p1[14], p1[15], a0);
                  a1 = max3f(a1, a2, a3); a4 = max3f(a4, a5, a6); a7 = max3f(a7, a8, a9);
                  mx = xhalf_max(max3f(max3f(a1, a4, a7), a10, a10)); }
                if (first || __any(mx > 6.0f)) {
                    const float dl = first ? mx : fmaxf(mx, 0.f);
#pragma unroll
                    for (int r = 0; r < 16; ++r) { p0[r] -= dl; p1[r] -= dl; }
                    mrun += dl;
                    if (!first) { const float alpha = __builtin_amdgcn_exp2f(-dl); lrun *= alpha;
#pragma unroll
                        for (int d = 0; d < NACC; ++d)
#pragma unroll
                            for (int r = 0; r < 16; ++r) o[d][r] *= alpha; }
                    first = false;
                }
#pragma unroll
                for (int r = 0; r < 16; ++r) { p0[r] = __builtin_amdgcn_exp2f(p0[r]); p1[r] = __builtin_amdgcn_exp2f(p1[r]); }
                { float s0 = p0[0] + p1[0], s1 = p0[1] + p1[1], s2 = p0[2] + p1[2], s3 = p0[3] + p1[3];
#pragma unroll
                  for (int r = 4; r < 16; r += 4) { s0 += p0[r] + p1[r]; s1 += p0[r + 1] + p1[r + 1]; s2 += p0[r + 2] + p1[r + 2]; s3 += p0[r + 3] + p1[r + 3]; }
                  lrun += (s0 + s1) + (s2 + s3); }
                pf0 = pack8(p0, 0); pf1 = pack8(p0, 8); pf2 = pack8(p1, 0); pf3 = pack8(p1, 8);
                wdone = __all(rowc - slope2 * (float)(t - k0 + 1) < mrun - 32.0f) != 0;
            } else {
                float ts = 0.f;
                f32x16 l0, l1;
#pragma unroll
                for (int r = 0; r < 16; ++r) {
                    { const float z = p0[r]; const float e = __builtin_amdgcn_exp2f(-fabsf(z)); const float sp = fmaxf(-z, 0.f) + __builtin_amdgcn_logf(1.0f + e);
                      const float lb = -sp; float lm = lb - z; if (diag && !(k0 + crow(r, hi) < t)) lm = 0.f; l0[r] = lm; ts += lm; p0[r] = lb + carry; }
                    { const float z = p1[r]; const float e = __builtin_amdgcn_exp2f(-fabsf(z)); const float sp = fmaxf(-z, 0.f) + __builtin_amdgcn_logf(1.0f + e);
                      const float lb = -sp; float lm = lb - z; if (diag && !(k0 + 32 + crow(r, hi) < t)) lm = 0.f; l1[r] = lm; ts += lm; p1[r] = lb + carry; }
                }
                const bf16x8 L0a = pack8(l0, 0), L0b = pack8(l0, 8), L1a = pack8(l1, 0), L1b = pack8(l1, 8);
                p0 = MFMA32(ut0, L0a, p0); p0 = MFMA32(ut1, L0b, p0); p0 = MFMA32(uone, L1a, p0); p0 = MFMA32(uone, L1b, p0);
                p1 = MFMA32(ut0, L1a, p1); p1 = MFMA32(ut1, L1b, p1);
#pragma unroll
                for (int r = 0; r < 16; ++r) {
                    float a0 = __builtin_amdgcn_exp2f(p0[r]), a1 = __builtin_amdgcn_exp2f(p1[r]);
                    if (diag) { if (!(k0 + crow(r, hi) < t)) a0 = 0.f; if (!(k0 + 32 + crow(r, hi) < t)) a1 = 0.f; }
                    p0[r] = a0; p1[r] = a1;
                }
                ts = xhalf_sum(ts);
                carry += ts;
                pf0 = pack8(p0, 0); pf1 = pack8(p0, 8); pf2 = pack8(p1, 0); pf3 = pack8(p1, 8);
                wdone = __all(carry < THR) != 0;
            }
#pragma unroll
            for (int d = 0; d < NDB; ++d) {
                const LAS unsigned char* vb = sb + KBUFB + d * 32 * KSTR + koff;
                const bf16x8 v0 = *(const LAS bf16x8*)(vb), v1 = *(const LAS bf16x8*)(vb + 32), v2 = *(const LAS bf16x8*)(vb + 64), v3 = *(const LAS bf16x8*)(vb + 96);
                o[d] = MFMA32(v0, pf0, o[d]); o[d] = MFMA32(v1, pf1, o[d]); o[d] = MFMA32(v2, pf2, o[d]); o[d] = MFMA32(v3, pf3, o[d]);
            }
        }
        if (hasn) ATT_STORE(hh ^ 1, hh ^ 1);
        if (lane == 0) flags[hh * 8 + wid] = wdone ? 1u : 0u;
        __syncthreads();
        if (!hasn) { fin = true; break; }
        { const unsigned f = flags[hh * 8 + (lane & 7)]; if (__all(f != 0u)) { fin = true; break; } }
        --kt;
      }
      if (fin) break;
    }
#undef ATT_LOAD
#undef ATT_STORE
    if (MODE == 0) {
        const float inv = 1.0f / xhalf_sum(lrun);
        LAS unsigned char* ost = lds + wid * (32 * KSTR);
        bf16* og = (bf16*)Of + (rowbase + tw0) * 1024 + ocol;
#pragma unroll
        for (int ps = 0; ps < NDB / 2; ++ps) {
#pragma unroll
            for (int dd = 0; dd < 2; ++dd)
#pragma unroll
                for (int g = 0; g < 4; ++g) { const int d = 2 * ps + dd; u32x2 w; w.x = pk_bf16(o[d][4 * g] * inv, o[d][4 * g + 1] * inv); w.y = pk_bf16(o[d][4 * g + 2] * inv, o[d][4 * g + 3] * inv);
                    *(LAS u32x2*)(ost + r32 * KSTR + (32 * dd + 8 * g + 4 * hi) * 2) = w; }
#pragma unroll
            for (int i = 0; i < 4; ++i) { const int row = (lane >> 3) + 8 * i, ch = lane & 7;
                const u32x4 v = *(const LAS u32x4*)(ost + row * KSTR + ch * 16);
                *(GAS u32x4*)(og + (size_t)row * 1024 + 64 * ps + 8 * ch) = v; }
        }
    } else {
        bf16* op = Ob + (rowbase + t) * 512 + ocol + 4 * hi;
#pragma unroll
        for (int d = 0; d < NDB; ++d)
#pragma unroll
            for (int g = 0; g < 4; ++g) { u32x2 w; w.x = pk_bf16(o[d][4 * g], o[d][4 * g + 1]); w.y = pk_bf16(o[d][4 * g + 2], o[d][4 * g + 3]); *(GAS u32x2*)(op + 32 * d + 8 * g) = w; }
    }
}
constexpr int SB2_KB = 64 * KSTR, SB2_STAGE = 4 * SB2_KB;
template <int MODE, int DV>
__device__ __forceinline__ void sb_unit2(LAS unsigned char* lds, const bf16* __restrict__ QK, int qcol, int kcol, const bf16* __restrict__ Vt, LAS unsigned* flags_,
                                          size_t rowbase, int qb, float slope2, float kinfa, float kinfb, float* __restrict__ Of, bf16* __restrict__ Ob, int ocol) {
    constexpr int NDB = DV / 32, NVC = DV / 64, NACC = NDB;
    int tid_l = threadIdx.x; asm volatile("" : "+v"(tid_l));
    const int tid = tid_l, lane = tid & 63, r32 = lane & 31, hi = lane >> 5;
    const int wid = __builtin_amdgcn_readfirstlane(tid >> 6);
    const int hsel = wid >> 2;
    qcol += 64 * hsel; ocol += 64 * hsel;
    const int q0 = qb * 128, tw0 = q0 + 32 * (wid & 3), t = tw0 + r32;
    const int NT = 2 * qb + 2;
    bf16x8 qf[4];
    { const bf16* qp = QK + (rowbase + t) * 2048 + qcol + hi * 8;
#pragma unroll
      for (int ds = 0; ds < 4; ++ds) qf[ds] = *(const GAS bf16x8*)(qp + ds * 16); }
    float rowc = 0.f;
    if (MODE == 0) {
        float sa = 0.f, sb2 = 0.f;
#pragma unroll
        for (int ds = 0; ds < 4; ++ds) { const u32x4 w = __builtin_bit_cast(u32x4, qf[ds]);
            const float e0 = __uint_as_float(w.x << 16), e1 = __uint_as_float(w.x & 0xffff0000u), e2 = __uint_as_float(w.y << 16), e3 = __uint_as_float(w.y & 0xffff0000u);
            const float e4 = __uint_as_float(w.z << 16), e5 = __uint_as_float(w.z & 0xffff0000u), e6 = __uint_as_float(w.w << 16), e7 = __uint_as_float(w.w & 0xffff0000u);
            const float q2 = (e0 * e0 + e1 * e1) + (e2 * e2 + e3 * e3) + (e4 * e4 + e5 * e5) + (e6 * e6 + e7 * e7);
            if (ds < 2) sa += q2; else sb2 += q2; }
        sa = xhalf_sum(sa); sb2 = xhalf_sum(sb2);
        rowc = (sqrtf(sa * kinfa) + sqrtf(sb2 * kinfb)) * 1.02f;
    }
    const int th = tid >> 8, idx = tid & 255, krow = idx >> 3, kch = idx & 7;
    const bf16* ksrc = QK + (rowbase + krow) * 2048 + kcol + 64 * th + kch * 8;
    const unsigned kdst = th * SB2_KB + krow * KSTR + kch * 16;
    const bf16* vsrc = Vt + (size_t)(64 * th + krow) * SEQ + kch * 8;
    const unsigned vdst = 2 * SB2_KB + th * SB2_KB + krow * KSTR + kch * 16;
    const unsigned koff = hsel * SB2_KB + r32 * KSTR + hi * 16;
    LAS unsigned* flags = flags_;

    f32x16 o[NACC];
#pragma unroll
    for (int d = 0; d < NACC; ++d)
#pragma unroll
        for (int r = 0; r < 16; ++r) o[d][r] = 0.f;
    float mrun = 0.f, carry = 0.f, lrun = 0.f;
    bool wdone = false, first = true;
    bf16x8 ut0, ut1, uone;
    { const u32x4 c = {0x3F803F80u, 0x3F803F80u, 0x3F803F80u, 0x3F803F80u}; uone = __builtin_bit_cast(bf16x8, c); }
    if (MODE == 1) {
        u32x4 a, b;
        unsigned e0[8], e1[8];
#pragma unroll
        for (int j = 0; j < 8; ++j) { const int jj = 8 * (j >> 2) + 4 * hi + (j & 3); e0[j] = (jj > r32) ? 0x3F80u : 0u; e1[j] = (16 + jj > r32) ? 0x3F80u : 0u; }
        a.x = e0[0] | (e0[1] << 16); a.y = e0[2] | (e0[3] << 16); a.z = e0[4] | (e0[5] << 16); a.w = e0[6] | (e0[7] << 16);
        b.x = e1[0] | (e1[1] << 16); b.y = e1[2] | (e1[3] << 16); b.z = e1[4] | (e1[5] << 16); b.w = e1[6] | (e1[7] << 16);
        ut0 = __builtin_bit_cast(bf16x8, a); ut1 = __builtin_bit_cast(bf16x8, b);
    }
    u32x4 kreg[2][2], vreg[2][2];
#define ATT_LOAD(set_, kt_) do { _Pragma("unroll") for (int i_ = 0; i_ < 2; ++i_) { kreg[set_][i_] = *(const GAS u32x4*)(ksrc + ((size_t)(kt_) * 64 + 32 * i_) * 2048); \
        vreg[set_][i_] = *(const GAS u32x4*)(vsrc + (size_t)i_ * 32 * SEQ + (kt_) * 64); } } while (0)
#define ATT_STORE(set_, stg_) do { _Pragma("unroll") for (int i_ = 0; i_ < 2; ++i_) { *(LAS u32x4*)(lds + (stg_) * SB2_STAGE + kdst + i_ * 32 * KSTR) = kreg[set_][i_]; \
        *(LAS u32x4*)(lds + (stg_) * SB2_STAGE + vdst + i_ * 32 * KSTR) = vreg[set_][i_]; } } while (0)
    ATT_LOAD(0, NT - 1); ATT_LOAD(1, (NT - 2 > 0) ? NT - 2 : 0); ATT_STORE(0, 0);
    __syncthreads();
    int kt = NT - 1; bool fin = false;
    for (;;) {
#pragma unroll
      for (int hh = 0; hh < 2; ++hh) {
        const bool hasn = (kt > 0);
        ATT_LOAD(hh, (kt - 2 > 0) ? kt - 2 : 0);
        const int k0 = kt * 64;
        const LAS unsigned char* sb = lds + hh * SB2_STAGE;
        const bool active = ((MODE == 0) ? (k0 <= tw0 + 31) : (k0 < tw0 + 31)) && !wdone;
        if (active) {
            f32x16 p0, p1;
            if (MODE == 0) {
                const float bb = slope2 * (float)(k0 + 4 * hi - t) - mrun;
#pragma unroll
                for (int r = 0; r < 16; ++r) { const float c = __builtin_fmaf(slope2, (float)((r & 3) + 8 * (r >> 2)), bb); p0[r] = c; p1[r] = __builtin_fmaf(slope2, 32.0f, c); }
            } else {
#pragma unroll
                for (int r = 0; r < 16; ++r) { p0[r] = 0.f; p1[r] = 0.f; }
            }
#pragma unroll
            for (int ds = 0; ds < 4; ++ds) {
                const bf16x8 k0f = *(const LAS bf16x8*)(sb + koff + ds * 32);
                const bf16x8 k1f = *(const LAS bf16x8*)(sb + koff + 32 * KSTR + ds * 32);
                p0 = MFMA32(k0f, qf[ds], p0); p1 = MFMA32(k1f, qf[ds], p1);
            }
            const bool diag = (MODE == 0) ? (k0 + 63 > tw0) : (k0 + 63 >= tw0);
            bf16x8 pf0, pf1, pf2, pf3;
            if (MODE == 0) {
                if (diag) {
#pragma unroll
                    for (int r = 0; r < 16; ++r) { const int key = k0 + crow(r, hi); if (key > t) p0[r] = -INFINITY; if (key + 32 > t) p1[r] = -INFINITY; }
                }
                float mx;
                { float a0 = max3f(p0[0], p0[1], p0[2]), a1 = max3f(p0[3], p0[4], p0[5]), a2 = max3f(p0[6], p0[7], p0[8]), a3 = max3f(p0[9], p0[10], p0[11]);
                  float a4 = max3f(p0[12], p0[13], p0[14]), a5 = max3f(p0[15], p1[0], p1[1]), a6 = max3f(p1[2], p1[3], p1[4]), a7 = max3f(p1[5], p1[6], p1[7]);
                  float a8 = max3f(p1[8], p1[9], p1[10]), a9 = max3f(p1[11], p1[12], p1[13]), a10 = max3f(p1[14], p1[15], a0);
                  a1 = max3f(a1, a2, a3); a4 = max3f(a4, a5, a6); a7 = max3f(a7, a8, a9);
                  mx = xhalf_max(max3f(max3f(a1, a4, a7), a10, a10)); }
                if (first || __any(mx > 6.0f)) {
                    const float dl = first ? mx : fmaxf(mx, 0.f);
#pragma unroll
                    for (int r = 0; r < 16; ++r) { p0[r] -= dl; p1[r] -= dl; }
                    mrun += dl;
                    if (!first) { const float alpha = __builtin_amdgcn_exp2f(-dl); lrun *= alpha;
#pragma unroll
                        for (int d = 0; d < NACC; ++d)
#pragma unroll
                            for (int r = 0; r < 16; ++r) o[d][r] *= alpha; }
                    first = false;
                }
#pragma unroll
                for (int r = 0; r < 16; ++r) { p0[r] = __builtin_amdgcn_exp2f(p0[r]); p1[r] = __builtin_amdgcn_exp2f(p1[r]); }
                { float s0 = p0[0] + p1[0], s1 = p0[1] + p1[1], s2 = p0[2] + p1[2], s3 = p0[3] + p1[3];
#pragma unroll
                  for (int r = 4; r < 16; r += 4) { s0 += p0[r] + p1[r]; s1 += p0[r + 1] + p1[r + 1]; s2 += p0[r + 2] + p1[r + 2]; s3 += p0[r + 3] + p1[r + 3]; }
                  lrun += (s0 + s1) + (s2 + s3); }
                pf0 = pack8(p0, 0); pf1 = pack8(p0, 8); pf2 = pack8(p1, 0); pf3 = pack8(p1, 8);
                wdone = __all(rowc - slope2 * (float)(t - k0 + 1) < mrun - 32.0f) != 0;
            } else {
                float ts = 0.f;
                f32x16 l0, l1;
#pragma unroll
                for (int r = 0; r < 16; ++r) {
                    { const float z = p0[r]; const float e = __builtin_amdgcn_exp2f(-fabsf(z)); const float sp = fmaxf(-z, 0.f) + __builtin_amdgcn_logf(1.0f + e);
                      const float lb = -sp; float lm = lb - z; if (diag && !(k0 + crow(r, hi) < t)) lm = 0.f; l0[r] = lm; ts += lm; p0[r] = lb + carry; }
                    { const float z = p1[r]; const float e = __builtin_amdgcn_exp2f(-fabsf(z)); const float sp = fmaxf(-z, 0.f) + __builtin_amdgcn_logf(1.0f + e);
                      const float lb = -sp; float lm = lb - z; if (diag && !(k0 + 32 + crow(r, hi) < t)) lm = 0.f; l1[r] = lm; ts += lm; p1[r] = lb + carry; }
                }
                const bf16x8 L0a = pack8(l0, 0), L0b = pack8(l0, 8), L1a = pack8(l1, 0), L1b = pack8(l1, 8);
                p0 = MFMA32(ut0, L0a, p0); p0 = MFMA32(ut1, L0b, p0); p0 = MFMA32(uone, L1a, p0); p0 = MFMA32(uone, L1b, p0);
                p1 = MFMA32(ut0, L1a, p1); p1 = MFMA32(ut1, L1b, p1);
#pragma unroll
                for (int r = 0; r < 16; ++r) {
                    float a0 = __builtin_amdgcn_exp2f(p0[r]), a1 = __builtin_amdgcn_exp2f(p1[r]);
                    if (diag) { if (!(k0 + crow(r, hi) < t)) a0 = 0.f; if (!(k0 + 32 + crow(r, hi) < t)) a1 = 0.f; }
                    p0[r] = a0; p1[r] = a1;
                }
                ts = xhalf_sum(ts);
                carry += ts;
                pf0 = pack8(p0, 0); pf1 = pack8(p0, 8); pf2 = pack8(p1, 0); pf3 = pack8(p1, 8);
                wdone = __all(carry < THR) != 0;
            }
#pragma unroll
            for (int d = 0; d < NDB; ++d) {
                const LAS unsigned char* vb = sb + 2 * SB2_KB + d * 32 * KSTR + koff;
                const bf16x8 v0 = *(const LAS bf16x8*)(vb), v1 = *(const LAS bf16x8*)(vb + 32), v2 = *(const LAS bf16x8*)(vb + 64), v3 = *(const LAS bf16x8*)(vb + 96);
                o[d] = MFMA32(v0, pf0, o[d]); o[d] = MFMA32(v1, pf1, o[d]); o[d] = MFMA32(v2, pf2, o[d]); o[d] = MFMA32(v3, pf3, o[d]);
            }
        }
        if (hasn) ATT_STORE(hh ^ 1, hh ^ 1);
        if (lane == 0) flags[hh * 8 + wid] = wdone ? 1u : 0u;
        __syncthreads();
        if (!hasn) { fin = true; break; }
        { const unsigned f = flags[hh * 8 + (lane & 7)]; if (__all(f != 0u)) { fin = true; break; } }
        --kt;
      }
      if (fin) break;
    }
#undef ATT_LOAD
#undef ATT_STORE
    if (MODE == 0) {
        const float inv = 1.0f / xhalf_sum(lrun);
        bf16* op = (bf16*)Of + (rowbase + t) * 1024 + ocol + 4 * hi;
#pragma unroll
        for (int d = 0; d < NDB; ++d)
#pragma unroll
            for (int g = 0; g < 4; ++g) { u32x2 w; w.x = pk_bf16(o[d][4 * g] * inv, o[d][4 * g + 1] * inv); w.y = pk_bf16(o[d][4 * g + 2] * inv, o[d][4 * g + 3] * inv); *(GAS u32x2*)(op + 32 * d + 8 * g) = w; }
    } else {
        bf16* op = Ob + (rowbase + t) * 512 + ocol + 4 * hi;
#pragma unroll
        for (int d = 0; d < NDB; ++d)
#pragma unroll
            for (int g = 0; g < 4; ++g) { u32x2 w; w.x = pk_bf16(o[d][4 * g], o[d][4 * g + 1]); w.y = pk_bf16(o[d][4 * g + 2], o[d][4 * g + 3]); *(GAS u32x2*)(op + 32 * d + 8 * g) = w; }
    }
}
#undef MFMA32
}

#define XB_TMO      128
#define XB_XCNT(j)  (256  + 64 * (j))
#define XB_XSUB(j)  (1280 + 64 * (j))
#define XB_XGEN(j)  (2304 + 64 * (j))
#define XB_TOP      3328
#define XB_TOPGEN   3392
#define XCD_BAR_WORDS 3456
#define XB_SPIN_CAP (1u << 18)

__device__ __forceinline__ unsigned xb_ld(unsigned* p)              { return __hip_atomic_load(p, __ATOMIC_RELAXED, __HIP_MEMORY_SCOPE_AGENT); }
__device__ __forceinline__ unsigned xb_add(unsigned* p, unsigned v) { return __hip_atomic_fetch_add(p, v, __ATOMIC_RELAXED, __HIP_MEMORY_SCOPE_AGENT); }
__device__ __forceinline__ unsigned xb_xcc_id() { return (unsigned)__builtin_amdgcn_s_getreg((3 << 11) | 20) & 0xFu; }
#define XB_SPIN(cond, bar) do { unsigned _sp = 0; while (cond) { __builtin_amdgcn_s_sleep(1); \
    if ((++_sp & 255u) == 0u) { if (xb_ld(&(bar)[XB_TMO])) break; if (_sp > XB_SPIN_CAP) { atomicAdd(&(bar)[XB_TMO], 1u); break; } } } } while (0)

struct XcdBarrier {
    unsigned* bar; unsigned x;
    volatile LAS unsigned* st;
};

__device__ __forceinline__ XcdBarrier xcd_barrier_post(unsigned* bar, volatile LAS unsigned* st) {
    XcdBarrier b; b.bar = bar; b.x = xb_xcc_id(); b.st = st;
    if (threadIdx.x == 0) (void)xb_add(&bar[XB_XCNT(b.x)], 1u);
    return b;
}
__device__ __forceinline__ void xcd_barrier_complete(unsigned* bar, unsigned x, unsigned& nloc, unsigned& nx) {
    const unsigned G = gridDim.x * gridDim.y * gridDim.z;
    unsigned sum, cnt, mine, sp = 0u;
    for (;;) {
        sum = 0u; cnt = 0u; mine = 0u;
#pragma unroll
        for (unsigned j = 0; j < 16; ++j) { const unsigned c = xb_ld(&bar[XB_XCNT(j)]); sum += c; cnt += (c > 0u) ? 1u : 0u; mine = (j == x) ? c : mine; }
        if (sum == G) break;
        __builtin_amdgcn_s_sleep(1);
        if ((++sp & 255u) == 0u) { if (xb_ld(&bar[XB_TMO])) break; if (sp > XB_SPIN_CAP) { atomicAdd(&bar[XB_TMO], 1u); break; } }
    }
    nloc = mine > 0u ? mine : 1u; nx = cnt > 0u ? cnt : 1u;
}

__device__ __forceinline__ void xcd_barrier(const XcdBarrier& b) {
    asm volatile("s_waitcnt vmcnt(0)" ::: "memory");
    __syncthreads();
    if (threadIdx.x == 0) {
        unsigned* bar = b.bar;
        __builtin_amdgcn_s_waitcnt(0);
        unsigned nloc = b.st[0], nx = b.st[1];
        if (nloc == 0u) { xcd_barrier_complete(bar, b.x, nloc, nx); b.st[0] = nloc; b.st[1] = nx; }
        const unsigned old = xb_add(&bar[XB_XSUB(b.x)], 1u);
        const unsigned gen = old / nloc;
        if (old + 1u == (gen + 1u) * nloc) {
            __builtin_amdgcn_fence(__ATOMIC_RELEASE, "agent");
            asm volatile("s_waitcnt vmcnt(0)" ::: "memory");
            const unsigned og = xb_add(&bar[XB_TOP], 1u);
            const unsigned tg = og / nx;
            if (og + 1u == (tg + 1u) * nx) xb_add(&bar[XB_TOPGEN], 1u);
            else XB_SPIN(xb_ld(&bar[XB_TOPGEN]) == tg, bar);
            __builtin_amdgcn_fence(__ATOMIC_ACQUIRE, "agent");
            xb_add(&bar[XB_XGEN(b.x)], 1u);
            asm volatile("s_waitcnt vmcnt(0)" ::: "memory");
        } else {
            XB_SPIN(xb_ld(&bar[XB_XGEN(b.x)]) == gen, bar);
            __builtin_amdgcn_fence(__ATOMIC_ACQUIRE, "agent");
            asm volatile("s_waitcnt vmcnt(0)" ::: "memory");
        }
    }
    __syncthreads();
}

#ifndef WGM_GU
#define WGM_GU 4
#endif
#ifndef WGM_N1K
#define WGM_N1K 4
#endif
#ifndef WGM_IN
#define WGM_IN 4
#endif
#ifndef PHASE_MASK
#define PHASE_MASK 0xFFFF
#endif
#define PH(n) (((PHASE_MASK) >> (n)) & 1)
#ifndef DUP_MASK
#define DUP_MASK 0
#endif
#ifndef ATT_DUP
#define ATT_DUP 0
#endif
#define REP(n) for (int rep_ = 0; rep_ < 1 + (((DUP_MASK) >> (n)) & 1); ++rep_)
#ifndef ATT_PASS_MASK
#define ATT_PASS_MASK 3
#endif
struct Args { const float* in[24]; float* out; unsigned char* ws; };

__device__ __forceinline__ void transpose_item(const float* __restrict__ W, int K, int N, bf16* __restrict__ WT, int mode, LAS float* scr, int item, int lane) {
    const int nblk = N / 32, kb = item / nblk, nb = item % nblk, k0 = 64 * kb, n0 = 32 * nb;
#pragma unroll
    for (int i = 0; i < 8; ++i) { const int kk = 8 * i + (lane >> 3), nq = 4 * (lane & 7);
        const f32x4 v = __builtin_nontemporal_load((const GAS f32x4*)(W + (size_t)(k0 + kk) * N + n0 + nq)); LAS float* d = scr + kk * 33 + nq; d[0] = v.x; d[1] = v.y; d[2] = v.z; d[3] = v.w; }
    asm volatile("s_waitcnt lgkmcnt(0)" ::: "memory");
    const int c = lane & 7;
#pragma unroll
    for (int j = 0; j < 4; ++j) { const int n = (lane >> 3) + 8 * j; const LAS float* s = scr + (8 * c) * 33 + n;
        u32x4 o; o.x = pk_bf16(s[0 * 33], s[1 * 33]); o.y = pk_bf16(s[2 * 33], s[3 * 33]); o.z = pk_bf16(s[4 * 33], s[5 * 33]); o.w = pk_bf16(s[6 * 33], s[7 * 33]);
        const int ng = n0 + n; const int nr = (mode == 0) ? ng : (256 * (ng >> 7) + (ng & 127) + (mode == 2 ? 128 : 0));
        *(GAS u32x4*)(WT + (size_t)nr * K + k0 + 8 * c) = o; }
    asm volatile("s_waitcnt lgkmcnt(0)" ::: "memory");
}

template <bool HAS_F, bool HAS_H, bool XIN_B = false, bool XOUT_B = false>
__device__ __forceinline__ void rowpass(const void* xin_, const bf16* __restrict__ Fb, void* xout_, bf16* __restrict__ H,
                                        const float* __restrict__ gpost, const float* __restrict__ modp, int gi  , float resw,
                                        const float* __restrict__ gpre, int sci, int shi, int gw, int lane) {
    constexpr int RPW = M / 2048;
    const int row_lo = gw * RPW; const int b = row_lo / SEQ;
    const float* mb = modp + (size_t)b * (NMOD * DM);
    f32x4 Cg[4], A[4], Sh[4];
#pragma unroll
    for (int j = 0; j < 4; ++j) { const int col = 256 * j + 4 * lane;
        if (HAS_F) { const f32x4 g = *(const GAS f32x4*)(mb + gi * DM + col), gp = *(const GAS f32x4*)(gpost + col); Cg[j] = g * gp * resw; }
        if (HAS_H) { const f32x4 s = *(const GAS f32x4*)(mb + sci * DM + col), gp = *(const GAS f32x4*)(gpre + col); A[j] = gp * (s + 1.0f); Sh[j] = *(const GAS f32x4*)(mb + shi * DM + col); } }
    const float* xin = (const float*)xin_; const bf16* xinb = (const bf16*)xin_; float* xout = (float*)xout_; bf16* xoutb = (bf16*)xout_;
#define RP_LDX(dst, r, j) do { if (XIN_B) { const u32x2 w_ = __builtin_nontemporal_load((const GAS u32x2*)(xinb + (size_t)(r) * DM + 256 * (j) + 4 * lane)); \
        dst = (f32x4){__uint_as_float(w_.x << 16), __uint_as_float(w_.x & 0xffff0000u), __uint_as_float(w_.y << 16), __uint_as_float(w_.y & 0xffff0000u)}; } \
      else dst = __builtin_nontemporal_load((const GAS f32x4*)(xin + (size_t)(r) * DM + 256 * (j) + 4 * lane)); } while (0)
    f32x4 xn[4]; u32x2 fn[4];
#pragma unroll
    for (int j = 0; j < 4; ++j) { RP_LDX(xn[j], row_lo, j); if (HAS_F) fn[j] = __builtin_nontemporal_load((const GAS u32x2*)(Fb + (size_t)row_lo * DM + 256 * j + 4 * lane)); }
    for (int row = row_lo; row < row_lo + RPW; ++row) {
        f32x4 x[4]; u32x2 fwv[4];
#pragma unroll
        for (int j = 0; j < 4; ++j) { x[j] = xn[j]; if (HAS_F) fwv[j] = fn[j]; }
        { const int rn = (row + 1 < row_lo + RPW) ? row + 1 : row;
#pragma unroll
          for (int j = 0; j < 4; ++j) { RP_LDX(xn[j], rn, j); if (HAS_F) fn[j] = __builtin_nontemporal_load((const GAS u32x2*)(Fb + (size_t)rn * DM + 256 * j + 4 * lane)); } }
        if (HAS_F) {
            f32x4 f[4]; float ss = 0.f;
#pragma unroll
            for (int j = 0; j < 4; ++j) { const u32x2 fw = fwv[j];
                f[j] = (f32x4){__uint_as_float(fw.x << 16), __uint_as_float(fw.x & 0xffff0000u), __uint_as_float(fw.y << 16), __uint_as_float(fw.y & 0xffff0000u)}; ss += (f[j].x * f[j].x + f[j].y * f[j].y) + (f[j].z * f[j].z + f[j].w * f[j].w); }
            const float rstd = 1.0f / sqrtf(wave_sum(ss) * (1.0f / DM) + RMS_EPS);
#pragma unroll
            for (int j = 0; j < 4; ++j) { x[j] = x[j] + f[j] * rstd * Cg[j];
                if (XOUT_B) { u32x2 w; w.x = pk_bf16(x[j].x, x[j].y); w.y = pk_bf16(x[j].z, x[j].w); *(GAS u32x2*)(xoutb + (size_t)row * DM + 256 * j + 4 * lane) = w;
                    x[j] = (f32x4){__uint_as_float(w.x << 16), __uint_as_float(w.x & 0xffff0000u), __uint_as_float(w.y << 16), __uint_as_float(w.y & 0xffff0000u)}; }
                else __builtin_nontemporal_store(x[j], (GAS f32x4*)(xout + (size_t)row * DM + 256 * j + 4 * lane)); }
        }
        if (HAS_H) {
            float ss = 0.f;
#pragma unroll
            for (int j = 0; j < 4; ++j) ss += (x[j].x * x[j].x + x[j].y * x[j].y) + (x[j].z * x[j].z + x[j].w * x[j].w);
            const float rstd = 1.0f / sqrtf(wave_sum(ss) * (1.0f / DM) + RMS_EPS);
#pragma unroll
            for (int j = 0; j < 4; ++j) { const f32x4 h = x[j] * rstd * A[j] + Sh[j]; u32x2 w; w.x = pk_bf16(h.x, h.y); w.y = pk_bf16(h.z, h.w);
                *(GAS u32x2*)(H + (size_t)row * DM + 256 * j + 4 * lane) = w; }
        }
    }
}
#undef RP_LDX

__device__ __forceinline__ void rowpass_attn(const float* __restrict__ Od, const bf16* __restrict__ Os, bf16* __restrict__ H, const float* __restrict__ subln,
                                             const float* __restrict__ sbeta, float lam, int gw, int lane) {
    constexpr int RPW = M / 2048;
    const int hd = lane >> 4, e0 = 8 * (lane & 15);
    const f32x4 sl0 = *(const GAS f32x4*)(subln + e0), sl1 = *(const GAS f32x4*)(subln + e0 + 4);
    const f32x4 be0 = *(const GAS f32x4*)(sbeta + 8 * lane), be1 = *(const GAS f32x4*)(sbeta + 8 * lane + 4);
#define RA_UNPK(W_, V_) do { V_[0] = __uint_as_float(W_.x << 16); V_[1] = __uint_as_float(W_.x & 0xffff0000u); V_[2] = __uint_as_float(W_.y << 16); V_[3] = __uint_as_float(W_.y & 0xffff0000u); \
        V_[4] = __uint_as_float(W_.z << 16); V_[5] = __uint_as_float(W_.z & 0xffff0000u); V_[6] = __uint_as_float(W_.w << 16); V_[7] = __uint_as_float(W_.w & 0xffff0000u); } while (0)
    const int row_lo = gw * RPW;
    u32x4 n0 = __builtin_nontemporal_load((const GAS u32x4*)((const bf16*)Od + (size_t)row_lo * 1024 + hd * 256 + e0)), n1 = __builtin_nontemporal_load((const GAS u32x4*)((const bf16*)Od + (size_t)row_lo * 1024 + hd * 256 + 128 + e0));
    u32x4 ns = __builtin_nontemporal_load((const GAS u32x4*)(Os + (size_t)row_lo * 512 + 8 * lane));
    for (int row = row_lo; row < row_lo + RPW; ++row) {
        const u32x4 w0 = n0, w1 = n1, ws = ns;
        { const int rn = (row + 1 < row_lo + RPW) ? row + 1 : row;
          n0 = __builtin_nontemporal_load((const GAS u32x4*)((const bf16*)Od + (size_t)rn * 1024 + hd * 256 + e0)); n1 = __builtin_nontemporal_load((const GAS u32x4*)((const bf16*)Od + (size_t)rn * 1024 + hd * 256 + 128 + e0));
          ns = __builtin_nontemporal_load((const GAS u32x4*)(Os + (size_t)rn * 512 + 8 * lane)); }
        float a0[8], a1[8], v[8], sv[8];
        RA_UNPK(w0, a0); RA_UNPK(w1, a1); RA_UNPK(ws, sv);
        float ss = 0.f, s2 = 0.f;
#pragma unroll
        for (int i = 0; i < 8; ++i) { v[i] = a0[i] - a1[i] * lam; ss += v[i] * v[i]; s2 += sv[i] * sv[i]; }
        ss = row16_sum(ss);
        const float rstd = 0.8f / sqrtf(ss * (1.0f / 128.0f) + RMS_EPS);
        u32x4 od; od.x = pk_bf16(v[0] * rstd * sl0.x, v[1] * rstd * sl0.y); od.y = pk_bf16(v[2] * rstd * sl0.z, v[3] * rstd * sl0.w);
        od.z = pk_bf16(v[4] * rstd * sl1.x, v[5] * rstd * sl1.y); od.w = pk_bf16(v[6] * rstd * sl1.z, v[7] * rstd * sl1.w);
        *(GAS u32x4*)(H + (size_t)row * 1024 + hd * 128 + e0) = od;
        const float rstd2 = 1.0f / sqrtf(wave_sum(s2) * (1.0f / 512.0f) + RMS_EPS);
        u32x4 o; o.x = pk_bf16(sv[0] * rstd2 * be0.x, sv[1] * rstd2 * be0.y); o.y = pk_bf16(sv[2] * rstd2 * be0.z, sv[3] * rstd2 * be0.w);
        o.z = pk_bf16(sv[4] * rstd2 * be1.x, sv[5] * rstd2 * be1.y); o.w = pk_bf16(sv[6] * rstd2 * be1.z, sv[7] * rstd2 * be1.w);
        *(GAS u32x4*)(H + (size_t)row * 1024 + 512 + 8 * lane) = o;
    }
#undef RA_UNPK
}

#define KAS __attribute__((address_space(4)))
__device__ __forceinline__ const float* karg(int i) { const KAS char* ka = (const KAS char*)__builtin_amdgcn_kernarg_segment_ptr(); return (const float*)(*(const volatile KAS unsigned long long*)(ka + 8 * i)); }
#define AIN(i) karg(i)
__device__ __forceinline__ int fresh_tid() { int t = threadIdx.x; asm volatile("" : "+v"(t)); return t; }
__global__ void __launch_bounds__(512) fwd_megakernel(Args args) {
    extern __shared__ __attribute__((aligned(16))) unsigned char lds_raw[];
    cg::grid_group grid = cg::this_grid();
    LAS unsigned char* lds = (LAS unsigned char*)lds_raw;
    const int wave = __builtin_amdgcn_readfirstlane((int)threadIdx.x >> 6);
#define tid (fresh_tid())
#define lane (fresh_tid() & 63)
    const int G = gridDim.x, bx = blockIdx.x;
    const int vcu = (G % 8 == 0) ? (bx % 8) * (G / 8) + bx / 8 : bx;
    const int gw = vcu * 8 + wave, NGW = G * 8;
    unsigned* ctlw = (unsigned*)((unsigned char*)karg(25) + WS_CTLW);
    volatile LAS unsigned* MISC = (volatile LAS unsigned*)(lds + GEMM_LDS);
    if (tid < 64) MISC[tid] = 0u;
    __syncthreads();
    XcdBarrier bar = xcd_barrier_post(ctlw, MISC + 8);
#define WSP(off) ((unsigned char*)karg(25) + (off))
#define ctl ((float*)WSP(WS_CTL))
#define modp (((float*)WSP(WS_CTL)) + 1024)
#define out ((float*)karg(24))
#define Wgu1 ((bf16*)WSP(WS_WGU1))
#define Wd1 ((bf16*)WSP(WS_WD1))
#define Win ((bf16*)WSP(WS_WIN))
#define Wout ((bf16*)WSP(WS_WOUT))
#define Wgu2 ((bf16*)WSP(WS_WGU2))
#define Wd2 ((bf16*)WSP(WS_WD2))
#define H ((bf16*)WSP(WS_H))
#define F ((float*)WSP(WS_F))
#define ACT ((bf16*)WSP(WS_ACT))
#define QK ((bf16*)WSP(WS_ACT))
#define VtD ((bf16*)WSP(WS_VTD))
#define VtS ((bf16*)WSP(WS_VTS))
#define Osb ((bf16*)WSP(WS_OSB))
#define XB ((bf16*)WSP(WS_XB))
    if (PH(0)) REP(0) {
        if (bx < 144) {
            LAS float* sc = (LAS float*)lds;
            LAS float* red = sc + 4096;
            const float* c = AIN(1);
            for (int i = tid; i < 4096; i += 512) { const float v = c[i]; sc[i] = v / (1.0f + __expf(-v)); }
            __syncthreads();
            const int col = bx * 64 + (tid & 63), kg = tid >> 6;
            const float* wp = AIN(2) + (size_t)(kg * 128) * (NMOD * DM) + col;
            float a0 = 0.f, a1 = 0.f, a2 = 0.f, a3 = 0.f;
#pragma unroll 8
            for (int k = 0; k < 128; ++k) { const float w = __builtin_nontemporal_load((const GAS float*)wp + (size_t)k * (NMOD * DM)); const int kk = kg * 128 + k;
                a0 += sc[kk] * w; a1 += sc[1024 + kk] * w; a2 += sc[2048 + kk] * w; a3 += sc[3072 + kk] * w; }
            red[(kg * 4 + 0) * 64 + (tid & 63)] = a0; red[(kg * 4 + 1) * 64 + (tid & 63)] = a1; red[(kg * 4 + 2) * 64 + (tid & 63)] = a2; red[(kg * 4 + 3) * 64 + (tid & 63)] = a3;
            __syncthreads();
            if (tid < 256) { const int b = tid >> 6, cc = tid & 63; float s = 0.f;
#pragma unroll
                for (int g = 0; g < 8; ++g) s += red[(g * 4 + b) * 64 + cc];
                modp[(size_t)b * (NMOD * DM) + bx * 64 + cc] = s + AIN(3)[bx * 64 + cc]; }
            __syncthreads();
        }
        if (bx == G - 1 && wave == 0) {
            const float s1 = wave_sum(AIN(13)[lane] * AIN(14)[lane]), s2 = wave_sum(AIN(15)[lane] * AIN(16)[lane]);
            if (lane == 0) ctl[0] = __expf(s1) - __expf(s2) + 0.2f;
        }
        LAS float* scr = (LAS float*)(lds + wave * 16384);
        constexpr int I_G = (DM / 64) * (DFF / 32), I_D = (DFF / 64) * (DM / 32), I_IN = (DM / 64) * (3 * DM / 32), I_OUT = (DM / 64) * (DM / 32);
        static_assert(I_G == I_D, "item counts");
        constexpr int NEARLY = 3 * I_G + I_IN;
        for (int itx = gw; itx < NEARLY; itx += NGW) {
            int r = itx;
            if (r < I_G) { transpose_item(AIN(6), DM, DFF, Wgu1, 1, scr, r, lane); continue; } r -= I_G;
            if (r < I_G) { transpose_item(AIN(7), DM, DFF, Wgu1, 2, scr, r, lane); continue; } r -= I_G;
            if (r < I_D) { transpose_item(AIN(8), DFF, DM, Wd1, 0, scr, r, lane); continue; } r -= I_D;
            transpose_item(AIN(11), DM, 3 * DM, Win, 0, scr, r, lane);
        }
    }
    if (G == 0x7ffffff0) grid.sync();
    xcd_barrier(bar);
#ifdef EXTRA_SYNCS
    for (int es = 0; es < EXTRA_SYNCS; ++es) xcd_barrier(bar);
#endif
    if (PH(1)) REP(1) rowpass<false, true>(AIN(0), nullptr, nullptr, H, nullptr, modp, 0, 0.f, AIN(4), 1, 0, gw, lane);
    xcd_barrier(bar);
    if (PH(2)) REP(2) { pg8::Gemm g{H, Wgu1, M, 2 * DFF, DM}; pg8::StaticOrder S; S.init(M, 2 * DFF, G, bx, WGM_GU); pg8::EpiSwiglu E{ACT, DFF};
      pg8::gemm_phase<pg8::EpiSwiglu, pg8::StaticOrder, true, true>(lds, g, S, E); }
    xcd_barrier(bar);
    if (PH(3)) REP(3) { pg8::Gemm g{ACT, Wd1, M, DM, DFF}; pg8::StaticOrder S; S.init(M, DM, G, bx, WGM_N1K, 1); pg8::EpiBf16Out E{(bf16*)F, DM};
      pg8::gemm_phase<pg8::EpiBf16Out, pg8::StaticOrder, true, true>(lds, g, S, E); }
    xcd_barrier(bar);
    if (PH(4)) REP(4) rowpass<true, true, false, true>(AIN(0), (const bf16*)F, XB, H, AIN(5), modp, 2, 0.5f, AIN(9), 4, 3, gw, lane);
    xcd_barrier(bar);
    if (PH(5)) REP(5) { pg8::Gemm g{H, Win, M, 3 * DM, DM}; pg8::StaticOrder S; S.init(M, 3 * DM, G, bx, WGM_IN); pg8::EpiProj E{QK, VtD, VtS, C2, SEQ, ctlw + CW_KINF};
      pg8::gemm_phase<pg8::EpiProj, pg8::StaticOrder, true, true>(lds, g, S, E); }
    xcd_barrier(bar);
    if (PH(6)) {
        const unsigned* kinfw = ctlw + CW_KINF;
        LAS unsigned* uslot = (LAS unsigned*)(lds + att::FLAG_OFF + 128);
        const unsigned myx = xb_xcc_id() & 7u;
        for (int qi = 0; qi < 8; ++qi) {
            const unsigned xq = (myx + (unsigned)qi) & 7u;
            unsigned* qctr = ctlw + CW_QUEUE + 64 * xq;
            for (;;) {
                if (tid == 0) *uslot = atomicAdd(qctr, 1u);
                __syncthreads();
                const unsigned u = *uslot;
                __syncthreads();
                if (u >= 128u) break;
                const int h = 3 - (int)(u >> 5), qb = 31 - (int)(u & 31), b = (int)(xq >> 1), vh = 2 * h + (int)(xq & 1);
                const float slope2 = 1.4426950408889634f * exp2f(-2.0f * (float)(h + 1));
                const float kinfa = __uint_as_float(kinfw[(b * 8 + vh) * 2]), kinfb = __uint_as_float(kinfw[(b * 8 + vh) * 2 + 1]);
                att::attn_unit<0, 128>(lds, QK, vh * 64, 512 + vh * 64, VtD + ((size_t)(b * 512 + h * 128)) * SEQ, (size_t)b * SEQ, qb, slope2, kinfa, kinfb, F, nullptr, vh * 128);
            }
        }
        {
            unsigned* qctr = ctlw + CW_QUEUE + 64 * 8;
            volatile LAS unsigned* sslot = MISC + 40; LAS unsigned* sflags = (LAS unsigned*)(lds + GEMM_LDS) + 44;
            for (;;) {
                if (tid == 0) sslot[0] = atomicAdd(qctr, 1u);
                __syncthreads();
                const unsigned u = sslot[0];
                __syncthreads();
                if (u >= 1024u) break;
                const int v = (int)u, qb = 63 - (v >> 4), b = (v & 15) >> 2, hp = v & 3;
                att::sb_unit2<1, 64>(lds, QK, 1024 + hp * 128, 1536 + hp * 128, VtS + ((size_t)(b * 512 + hp * 128)) * SEQ, sflags, (size_t)b * SEQ, qb, 0.f, 0.f, 0.f, nullptr, Osb, hp * 128);
            }
        }
        {
            constexpr int I_G2 = (DM / 64) * (DFF / 32), I_OUT2 = (DM / 64) * (DM / 32), NLATE = 3 * I_G2 + I_OUT2;
            unsigned* tq = ctlw + CW_QUEUE + 64 * 9;
            volatile LAS unsigned* tslot = MISC + 32;
            LAS float* scr = (LAS float*)(lds + wave * 16384);
            for (;;) {
                if (tid == 0) tslot[0] = atomicAdd(tq, 1u);
                __syncthreads();
                const unsigned ch = tslot[0];
                __syncthreads();
                if (ch * 8u >= (unsigned)NLATE) break;
                int r = (int)ch * 8 + wave;
                if (r < NLATE) {
                    if (r < I_OUT2) transpose_item(AIN(12), DM, DM, Wout, 0, scr, r, lane);
                    else { r -= I_OUT2;
                        if (r < I_G2) transpose_item(AIN(21), DM, DFF, Wgu2, 1, scr, r, lane);
                        else if (r < 2 * I_G2) transpose_item(AIN(22), DM, DFF, Wgu2, 2, scr, r - I_G2, lane);
                        else transpose_item(AIN(23), DFF, DM, Wd2, 0, scr, r - 2 * I_G2, lane); }
                }
            }
        }
    }
    xcd_barrier(bar);
    if (PH(7)) REP(7) rowpass_attn(F, Osb, H, AIN(17), AIN(18), ctl[0], gw, lane);
    xcd_barrier(bar);
    if (PH(8)) REP(8) { pg8::Gemm g{H, Wout, M, DM, DM}; pg8::StaticOrder S; S.init(M, DM, G, bx, WGM_N1K); pg8::EpiBf16Out E{(bf16*)F, DM};
      pg8::gemm_phase<pg8::EpiBf16Out, pg8::StaticOrder, true, true>(lds, g, S, E); }
    xcd_barrier(bar);
    if (PH(9)) REP(9) rowpass<true, true, true, true>(XB, (const bf16*)F, XB, H, AIN(10), modp, 5, 1.0f, AIN(19), 7, 6, gw, lane);
    xcd_barrier(bar);
    if (PH(10)) REP(10) { pg8::Gemm g{H, Wgu2, M, 2 * DFF, DM}; pg8::StaticOrder S; S.init(M, 2 * DFF, G, bx, WGM_GU); pg8::EpiSwiglu E{ACT, DFF};
      pg8::gemm_phase<pg8::EpiSwiglu, pg8::StaticOrder, true, true>(lds, g, S, E); }
    xcd_barrier(bar);
    if (PH(11)) REP(11) { pg8::Gemm g{ACT, Wd2, M, DM, DFF}; pg8::StaticOrder S; S.init(M, DM, G, bx, WGM_N1K, 1); pg8::EpiBf16Out E{(bf16*)F, DM};
      pg8::gemm_phase<pg8::EpiBf16Out, pg8::StaticOrder, true, true>(lds, g, S, E); }
    xcd_barrier(bar);
    if (PH(12)) REP(12) rowpass<true, false, true, false>(XB, (const bf16*)F, out, nullptr, AIN(20), modp, 8, 0.5f, nullptr, 0, 0, gw, lane);
}
#undef ctl
#undef modp
#undef out
#undef Wgu1
#undef Wd1
#undef Win
#undef Wout
#undef Wgu2
#undef Wd2
#undef H
#undef F
#undef ACT
#undef QK
#undef VtD
#undef VtS
#undef Osb
#undef XB

#undef tid
#undef lane
extern "C" void kernel_launch(void* const* d_in, const int* in_sizes, int n_in, void* d_out, int out_size, void* d_ws, size_t ws_size, hipStream_t stream) {
    static int grid = 0;
    if (grid == 0) {
        if (n_in != 24 || out_size != M * DM || ws_size < WS_END) { fprintf(stderr, "kernel_launch: unexpected shapes (n_in %d out %d ws %zu)\n", n_in, out_size, ws_size); grid = -1; return; }
        int dev = 0, cus = 0, per_cu = 0;
        hipGetDevice(&dev); hipDeviceGetAttribute(&cus, hipDeviceAttributeMultiprocessorCount, dev);
        if (hipFuncSetAttribute((const void*)fwd_megakernel, hipFuncAttributeMaxDynamicSharedMemorySize, LDS_BYTES) != hipSuccess) { fprintf(stderr, "kernel_launch: hipFuncSetAttribute failed\n"); grid = -1; return; }
        if (hipOccupancyMaxActiveBlocksPerMultiprocessor(&per_cu, (const void*)fwd_megakernel, 512, LDS_BYTES) != hipSuccess || per_cu < 1) { fprintf(stderr, "kernel_launch: occupancy query says %d blocks per CU\n", per_cu); per_cu = 1; }
        (void)hipGetLastError();
        if (cus < 256) { fprintf(stderr, "kernel_launch: built for a 256-CU device (got %d CUs)\n", cus); grid = -1; return; }
        grid = 256;
    }
    if (grid < 0) return;
    if (hipMemsetAsync((char*)d_ws + WS_CTLW, 0, CTLW_BYTES, stream) != hipSuccess) { fprintf(stderr, "kernel_launch: memset of the control words failed\n"); return; }
    Args a{};
    for (int i = 0; i < 24; ++i) a.in[i] = (const float*)d_in[i];
    a.out = (float*)d_out; a.ws = (unsigned char*)d_ws;
    void* kargs[] = {&a};
    hipError_t e = hipLaunchCooperativeKernel((const void*)fwd_megakernel, dim3(grid), dim3(512), kargs, LDS_BYTES, stream);
    if (e != hipSuccess) fprintf(stderr, "cooperative launch failed: %s (grid %d)\n", hipGetErrorString(e), grid);
}
```

```cpp
#include <hip/hip_runtime.h>
#include <hip/hip_cooperative_groups.h>
#include <cstdio>
#include <cstdint>
#include <cmath>
namespace cg = cooperative_groups;
namespace pg8 {
#define PG8_LAS __attribute__((address_space(3)))
typedef unsigned short bf16_t;
typedef short bf16x8 __attribute__((ext_vector_type(8)));
typedef float f32x4 __attribute__((ext_vector_type(4)));
typedef unsigned u32x4 __attribute__((ext_vector_type(4)));
constexpr int BM = 256, BK = 64, HALF = 128, HTB = HALF * BK * 2  , STAGE_BYTES = 8 * HTB, NXCD = 8, WGM = 8;

__host__ __device__ __forceinline__ int lds_byte(int r, int c) { const int st = (r >> 4) * 2 + (c >> 5), rr = r & 15, cc = c & 31, ob = rr * 64 + cc * 2; return st * 1024 + (ob ^ (((ob >> 9) & 1) << 5)); }
__host__ __device__ __forceinline__ void stage_rc(int b, int& R, int& C) { const int st = b / 1024, sb = b % 1024, swz = sb ^ (((sb >> 9) & 1) << 5); R = (st >> 1) * 16 + swz / 64; C = (st & 1) * 32 + (swz % 64) / 2; }
__host__ __device__ __forceinline__ int perm32(int rho) { const int n = rho >> 4, i = rho & 15; return 8 * (i >> 2) + 4 * n + (i & 3); }

struct Unit { int pm, pn; };
struct Gemm { const bf16_t* A; const bf16_t* Bt; int M, N, K; };

struct StaticOrder {
    int nM, nN, nwg, G, c, wgm, rev;
    __host__ __device__ void init(int M, int N, int G_, int c_, int wgm_ = WGM, int rev_ = 0) { nM = M / BM; nN = N / BM; nwg = nM * nN; G = G_; c = c_; wgm = wgm_; rev = rev_; }
    __host__ __device__ bool next(int i, Unit& u) const {
        const long L = (long)i * G + c; if (L >= nwg) return false;
        int wgid = (int)L; { const int q = nwg / NXCD, r = nwg % NXCD, xcd = wgid % NXCD, off = wgid / NXCD; wgid = (xcd < r ? xcd * (q + 1) : r * (q + 1) + (xcd - r) * q) + off; }
        if (rev) wgid = nwg - 1 - wgid;
        const int nig = wgm * nN, gid = wgid / nig, fm = gid * wgm, gsz = (nM - fm) < wgm ? (nM - fm) : wgm;
        u.pm = fm + ((wgid % nig) % gsz); u.pn = (wgid % nig) / gsz; return true;
    }
    __device__ __forceinline__ void a_ready(const Unit&) const {}
    __device__ __forceinline__ void done(const Unit&) const {}
};

__device__ __forceinline__ unsigned cvt_pk_bf16(float lo, float hi) { unsigned r; asm volatile("v_cvt_pk_bf16_f32 %0, %1, %2" : "=v"(r) : "v"(lo), "v"(hi)); return r; }
#define PG8_GAS __attribute__((address_space(1)))
__device__ __forceinline__ float silu_mul(float g, float u) { const float e = __builtin_amdgcn_exp2f(g * -1.4426950408889634f); return g * __builtin_amdgcn_rcpf(1.0f + e) * u; }
struct EpiSwiglu {
    static constexpr bool PERM = true, AFTER_DRAIN = false;
    bf16_t* O; int ldc;
    __device__ __forceinline__ void operator()(const f32x4 (&acc)[2][2][4][2], const Unit& u, int wr, int wc, int fr, int fq) const {
        const int row0 = u.pm * BM + wr * 64 + fr; const int col0 = u.pn * HALF + wc * 32 + 8 * fq;
#pragma unroll
        for (int ai = 0; ai < 2; ++ai)
#pragma unroll
            for (int m = 0; m < 4; ++m) { bf16_t* rowp = O + (size_t)(row0 + ai * HALF + m * 16) * ldc + col0;
                const f32x4 g0 = acc[ai][0][m][0], g1 = acc[ai][0][m][1], u0 = acc[ai][1][m][0], u1 = acc[ai][1][m][1];
                u32x4 w; w.x = cvt_pk_bf16(silu_mul(g0[0], u0[0]), silu_mul(g0[1], u0[1])); w.y = cvt_pk_bf16(silu_mul(g0[2], u0[2]), silu_mul(g0[3], u0[3]));
                w.z = cvt_pk_bf16(silu_mul(g1[0], u1[0]), silu_mul(g1[1], u1[1])); w.w = cvt_pk_bf16(silu_mul(g1[2], u1[2]), silu_mul(g1[3], u1[3]));
                *(PG8_GAS u32x4*)rowp = w; }
    }
};
struct EpiBf16Out {
    static constexpr bool PERM = true, AFTER_DRAIN = false;
    bf16_t* O; int ldc;
    __device__ __forceinline__ void operator()(const f32x4 (&acc)[2][2][4][2], const Unit& u, int wr, int wc, int fr, int fq) const {
        const int row0 = u.pm * BM + wr * 64 + fr; const int col0 = u.pn * BM + wc * 32 + 8 * fq;
#pragma unroll
        for (int ai = 0; ai < 2; ++ai)
#pragma unroll
            for (int m = 0; m < 4; ++m) { bf16_t* rowp = O + (size_t)(row0 + ai * HALF + m * 16) * ldc + col0;
#pragma unroll
                for (int bj = 0; bj < 2; ++bj) { const f32x4 v0 = acc[ai][bj][m][0], v1 = acc[ai][bj][m][1];
                    u32x4 w; w.x = cvt_pk_bf16(v0[0], v0[1]); w.y = cvt_pk_bf16(v0[2], v0[3]); w.z = cvt_pk_bf16(v1[0], v1[1]); w.w = cvt_pk_bf16(v1[2], v1[3]);
                    *(PG8_GAS u32x4*)(rowp + bj * HALF) = w; } }
    }
};
struct EpiProj {
    static constexpr bool PERM = true, AFTER_DRAIN = false;
    bf16_t* QK; bf16_t* VtD; bf16_t* VtS; float qscale; int S; unsigned* kinf;
    __device__ __forceinline__ void operator()(const f32x4 (&acc)[2][2][4][2], const Unit& u, int wr, int wc, int fr, int fq) const {
        const int seg = u.pn >> 1, half = u.pn & 1;
        if (seg == 2 || seg == 5) {
            bf16_t* Vt = (seg == 2) ? VtD : VtS;
            const int row_t = u.pm * BM; const int b = row_t / S, t0 = row_t - b * S;
#pragma unroll
            for (int ai = 0; ai < 2; ++ai)
#pragma unroll
                for (int m = 0; m < 4; ++m) { const int t = t0 + ai * HALF + wr * 64 + m * 16 + fr; const int pos = (t & ~12) | ((t & 4) << 1) | ((t & 8) >> 1);
#pragma unroll
                    for (int bj = 0; bj < 2; ++bj)
#pragma unroll
                        for (int n = 0; n < 2; ++n) { const int ch = 256 * half + 128 * bj + 32 * wc + 8 * fq + 4 * n;
                            const f32x4 v = acc[ai][bj][m][n]; const unsigned w0 = cvt_pk_bf16(v[0], v[1]), w1 = cvt_pk_bf16(v[2], v[3]);
                            const unsigned snd = (fr & 1) ? w0 : w1;
                            const unsigned rcv = (unsigned)__builtin_amdgcn_update_dpp(0, (int)snd, 0xB1, 0xF, 0xF, true);
                            const unsigned lo = (fr & 1) ? rcv : w0, hi2 = (fr & 1) ? w1 : rcv;
                            const unsigned s0 = (lo & 0xffffu) | (hi2 << 16), s1 = (lo >> 16) | (hi2 & 0xffff0000u);
                            PG8_GAS bf16_t* p = (PG8_GAS bf16_t*)(Vt + ((size_t)(b * 512 + ch + 2 * (fr & 1))) * S + (pos & ~1));
                            *(PG8_GAS unsigned*)p = s0; *(PG8_GAS unsigned*)(p + (size_t)S) = s1; } }
        } else {
            const int cbase = ((seg == 0) ? 0 : (seg == 1) ? 512 : (seg == 3) ? 1024 : 1536) + 256 * half + wc * 32 + 8 * fq;
            const float sc = (seg == 0 || seg == 3) ? qscale : 1.0f;
            const int row0 = u.pm * BM + wr * 64 + fr;
#pragma unroll
            for (int ai = 0; ai < 2; ++ai)
#pragma unroll
                for (int m = 0; m < 4; ++m) { bf16_t* rowp = QK + (size_t)(row0 + ai * HALF + m * 16) * 2048 + cbase;
#pragma unroll
                    for (int bj = 0; bj < 2; ++bj) { const f32x4 v0 = acc[ai][bj][m][0] * sc, v1 = acc[ai][bj][m][1] * sc;
                        u32x4 w; w.x = cvt_pk_bf16(v0[0], v0[1]); w.y = cvt_pk_bf16(v0[2], v0[3]); w.z = cvt_pk_bf16(v1[0], v1[1]); w.w = cvt_pk_bf16(v1[2], v1[3]);
                        *(PG8_GAS u32x4*)(rowp + bj * HALF) = w; } }
            if (seg == 1) {
                const int b = (u.pm * BM) / S;
#pragma unroll
                for (int bj = 0; bj < 2; ++bj) { float v = 0.f;
#pragma unroll
                    for (int ai = 0; ai < 2; ++ai)
#pragma unroll
                        for (int m = 0; m < 4; ++m) { const f32x4 x = acc[ai][bj][m][0], y = acc[ai][bj][m][1];
                            float s2 = (x[0] * x[0] + x[1] * x[1]) + (x[2] * x[2] + x[3] * x[3]) + (y[0] * y[0] + y[1] * y[1]) + (y[2] * y[2] + y[3] * y[3]);
                            s2 += __shfl_xor(s2, 16); s2 += __shfl_xor(s2, 32);
                            v = fmaxf(v, s2); }
#pragma unroll
                    for (int o = 1; o < 16; o <<= 1) v = fmaxf(v, __shfl_xor(v, o));
                    if (fr == 0 && fq == 0) atomicMax(kinf + (b * 8 + 4 * half + 2 * bj + (wc >> 1)) * 2 + (wc & 1), __float_as_uint(v)); }
            }
        }
    }
};

template <class Epi, class Sched, bool ALIGN_EPI = false, bool SP2 = false>
__device__ __forceinline__ void gemm_phase(PG8_LAS unsigned char* lds, const Gemm g, const Sched& S, const Epi& E) {
    int tid_l = threadIdx.x; asm volatile("" : "+v"(tid_l));
    const int tid = tid_l, wid = __builtin_amdgcn_readfirstlane(tid >> 6), lane = tid & 63, wr = wid >> 2, wc = wid & 3, fr = lane & 15, fq = lane >> 4;
    const int K = g.K, nt = K / BK;
    unsigned voffA[2], voffB[2];
#pragma unroll
    for (int i = 0; i < 2; ++i) { int R, C; stage_rc(tid * 16 + i * 8192, R, C); const int Rb = Epi::PERM ? ((R & ~31) + perm32(R & 31)) : R;
        voffA[i] = (unsigned)(R * K + C) * 2u; voffB[i] = (unsigned)(Rb * K + C) * 2u; }
    const size_t kstep = (size_t)(BK * 2);
    const size_t hstep = (size_t)HALF * K * 2;
    const size_t tstep = 2 * hstep;
    const unsigned ldsw = (unsigned)wid * 1024u;
    const int aoff = lds_byte(wr * 64 + fr, fq * 8), boff = lds_byte(wc * 32 + fr, fq * 8);
#define PG8_SA(b, h) (((b) * 2 + (h)) * HTB)
#define PG8_SB(b, h) ((4 + (b) * 2 + (h)) * HTB)
#define PG8_STAGE(bufoff, gbase, voff) do { _Pragma("unroll") for (int _i = 0; _i < 2; ++_i) \
        __builtin_amdgcn_global_load_lds((const unsigned*)((const char*)(gbase) + (voff)[_i]), (PG8_LAS unsigned*)(lds + (bufoff) + ldsw + _i * 8192), 16, 0, 0); } while (0)
#define PG8_LDA(dst, b, h) do { _Pragma("unroll") for (int m = 0; m < 4; ++m) _Pragma("unroll") for (int k = 0; k < 2; ++k) dst[m][k] = *(const PG8_LAS bf16x8*)(lds + PG8_SA(b, h) + aoff + m * 2048 + k * 1024); } while (0)
#define PG8_LDB(dst, b, h) do { _Pragma("unroll") for (int n = 0; n < 2; ++n) _Pragma("unroll") for (int k = 0; k < 2; ++k) dst[n][k] = *(const PG8_LAS bf16x8*)(lds + PG8_SB(b, h) + boff + n * 2048 + k * 1024); } while (0)
#define PG8_MMA(ai, bj, At, Bt) do { __builtin_amdgcn_s_setprio(1); _Pragma("unroll") for (int m = 0; m < 4; ++m) _Pragma("unroll") for (int n = 0; n < 2; ++n) _Pragma("unroll") for (int k = 0; k < 2; ++k) \
        acc[ai][bj][m][n] = __builtin_amdgcn_mfma_f32_16x16x32_bf16(Bt[n][k], At[m][k], acc[ai][bj][m][n], 0, 0, 0); __builtin_amdgcn_s_setprio(0); } while (0)
#define PG8_WAIT_V(n) asm volatile("s_waitcnt vmcnt(" #n ")" ::: "memory")
#define PG8_WAIT_L(n) asm volatile("s_waitcnt lgkmcnt(" #n ")" ::: "memory")
#define PG8_BAR __builtin_amdgcn_s_barrier()
#define PG8_SCHED __builtin_amdgcn_sched_barrier(0)
    Unit cur, nxt; int ui = 0;
    if (!S.next(0, cur)) return;
    f32x4 acc[2][2][4][2];
#pragma unroll
    for (int a = 0; a < 2; ++a)
#pragma unroll
        for (int b = 0; b < 2; ++b)
#pragma unroll
            for (int m = 0; m < 4; ++m)
#pragma unroll
                for (int n = 0; n < 2; ++n) acc[a][b][m][n] = (f32x4){0.f, 0.f, 0.f, 0.f};
    bf16x8 At[4][2], B0[2][2], B1[2][2];
    const char* cA = (const char*)g.A + (size_t)cur.pm * tstep; const char* cB = (const char*)g.Bt + (size_t)cur.pn * tstep;
    S.a_ready(cur);
    if constexpr (SP2) {
        PG8_STAGE(PG8_SB(0, 0), cB, voffB); PG8_STAGE(PG8_SB(0, 1), cB + hstep, voffB); PG8_STAGE(PG8_SA(0, 0), cA, voffA); PG8_STAGE(PG8_SA(0, 1), cA + hstep, voffA);
        if (wr == 1) PG8_BAR;
        PG8_WAIT_V(2); PG8_BAR;
        PG8_STAGE(PG8_SB(1, 0), cB + kstep, voffB); PG8_STAGE(PG8_SA(1, 0), cA + kstep, voffA); PG8_STAGE(PG8_SB(1, 1), cB + hstep + kstep, voffB);
        PG8_WAIT_V(6); PG8_BAR;
    } else {
        PG8_STAGE(PG8_SB(0, 0), cB, voffB); PG8_STAGE(PG8_SA(0, 0), cA, voffA); PG8_STAGE(PG8_SB(0, 1), cB + hstep, voffB); PG8_STAGE(PG8_SA(0, 1), cA + hstep, voffA);
        if (wr == 1) PG8_BAR;
        PG8_WAIT_V(4); PG8_BAR;
        PG8_STAGE(PG8_SB(1, 0), cB + kstep, voffB); PG8_STAGE(PG8_SA(1, 0), cA + kstep, voffA); PG8_STAGE(PG8_SB(1, 1), cB + hstep + kstep, voffB);
        PG8_WAIT_V(6); PG8_BAR;
    }
    for (;;) {
        const bool has_next = S.next(ui + 1, nxt);
        const char* nA = has_next ? (const char*)g.A + (size_t)nxt.pm * tstep : cA; const char* nB = has_next ? (const char*)g.Bt + (size_t)nxt.pn * tstep : cB;
        for (int t = 0; t < nt; t += 2) {
            const bool last = (t == nt - 2);
            const char* a1 = cA + (size_t)(t + 1) * kstep;
            const char* a2 = last ? nA : cA + (size_t)(t + 2) * kstep; const char* b2 = last ? nB : cB + (size_t)(t + 2) * kstep;
            const char* a3 = a2 + kstep; const char* b3 = b2 + kstep;
            if (last && has_next) S.a_ready(nxt);
            if constexpr (SP2) {
            PG8_LDB(B0, 0, 0); PG8_LDB(B1, 0, 1); PG8_SCHED; PG8_LDA(At, 0, 0); PG8_STAGE(PG8_SA(1, 1), a1 + hstep, voffA);
            PG8_WAIT_V(8); PG8_WAIT_L(0); PG8_BAR; PG8_MMA(0, 0, At, B0); PG8_MMA(0, 1, At, B1); PG8_BAR; PG8_SCHED;
            PG8_LDA(At, 0, 1); PG8_STAGE(PG8_SB(0, 0), b2, voffB); PG8_STAGE(PG8_SB(0, 1), b2 + hstep, voffB); PG8_STAGE(PG8_SA(0, 0), a2, voffA);
            PG8_WAIT_V(8); PG8_WAIT_L(0); PG8_BAR; PG8_MMA(1, 0, At, B0); PG8_MMA(1, 1, At, B1); PG8_BAR; PG8_SCHED;
            PG8_LDB(B0, 1, 0); PG8_LDB(B1, 1, 1); PG8_SCHED; PG8_LDA(At, 1, 0); PG8_STAGE(PG8_SA(0, 1), a2 + hstep, voffA);
            PG8_WAIT_V(8); PG8_WAIT_L(0); PG8_BAR; PG8_MMA(0, 0, At, B0); PG8_MMA(0, 1, At, B1); PG8_BAR; PG8_SCHED;
            PG8_LDA(At, 1, 1); PG8_STAGE(PG8_SB(1, 0), b3, voffB); PG8_STAGE(PG8_SB(1, 1), b3 + hstep, voffB); PG8_STAGE(PG8_SA(1, 0), a3, voffA);
            PG8_WAIT_V(8); PG8_WAIT_L(0); PG8_BAR; PG8_MMA(1, 0, At, B0); PG8_MMA(1, 1, At, B1); PG8_BAR; PG8_SCHED;
            } else {
            PG8_LDB(B0, 0, 0); PG8_SCHED; PG8_LDA(At, 0, 0); PG8_STAGE(PG8_SA(1, 1), a1 + hstep, voffA);
            PG8_WAIT_L(8); PG8_BAR; PG8_WAIT_L(0); PG8_MMA(0, 0, At, B0); PG8_BAR; PG8_SCHED;
            PG8_LDB(B1, 0, 1); PG8_STAGE(PG8_SB(0, 0), b2, voffB);
            PG8_BAR; PG8_WAIT_L(0); PG8_MMA(0, 1, At, B1); PG8_BAR;
            PG8_LDA(At, 0, 1); PG8_STAGE(PG8_SA(0, 0), a2, voffA);
            PG8_BAR; PG8_WAIT_L(0); PG8_MMA(1, 0, At, B0); PG8_BAR; PG8_SCHED;
            PG8_STAGE(PG8_SB(0, 1), b2 + hstep, voffB);
            PG8_WAIT_V(6); PG8_BAR; PG8_MMA(1, 1, At, B1); PG8_BAR;
            PG8_LDB(B0, 1, 0); PG8_SCHED; PG8_LDA(At, 1, 0); PG8_STAGE(PG8_SA(0, 1), a2 + hstep, voffA);
            PG8_WAIT_L(8); PG8_BAR; PG8_WAIT_L(0); PG8_MMA(0, 0, At, B0); PG8_BAR; PG8_SCHED;
            PG8_LDB(B1, 1, 1); PG8_STAGE(PG8_SB(1, 0), b3, voffB);
            PG8_BAR; PG8_WAIT_L(0); PG8_MMA(0, 1, At, B1); PG8_BAR;
            PG8_LDA(At, 1, 1); PG8_STAGE(PG8_SA(1, 0), a3, voffA);
            PG8_BAR; PG8_WAIT_L(0); PG8_MMA(1, 0, At, B0); PG8_BAR; PG8_SCHED;
            PG8_STAGE(PG8_SB(1, 1), b3 + hstep, voffB);
            PG8_WAIT_V(6); PG8_BAR; PG8_MMA(1, 1, At, B1); PG8_BAR;
            }
        }
        if constexpr (ALIGN_EPI) { if (wr == 0) PG8_BAR; }
        if constexpr (!Epi::AFTER_DRAIN) { E(acc, cur, wr, wc, fr, fq); S.done(cur); }
        if (!has_next) break;
#pragma unroll
        for (int a = 0; a < 2; ++a)
#pragma unroll
            for (int b = 0; b < 2; ++b)
#pragma unroll
                for (int m = 0; m < 4; ++m)
#pragma unroll
                    for (int n = 0; n < 2; ++n) acc[a][b][m][n] = (f32x4){0.f, 0.f, 0.f, 0.f};
        cur = nxt; cA = nA; cB = nB; ++ui;
        if constexpr (ALIGN_EPI) { if (wr == 1) PG8_BAR; }
    }
    PG8_WAIT_V(0);
    if constexpr (!ALIGN_EPI) { if (wr == 0) PG8_BAR; }
    PG8_BAR;
    if constexpr (Epi::AFTER_DRAIN) { E.fused(acc, cur, wr, wc, fr, fq, lds, wid, lane); S.done(cur); }
#undef PG8_SA
#undef PG8_SB
#undef PG8_STAGE
#undef PG8_LDA
#undef PG8_LDB
#undef PG8_MMA
#undef PG8_WAIT_V
#undef PG8_WAIT_L
#undef PG8_BAR
#undef PG8_SCHED
}
}

#define LAS __attribute__((address_space(3)))
#define GAS __attribute__((address_space(1)))
typedef unsigned short bf16;
typedef float f32x4 __attribute__((ext_vector_type(4)));
typedef float f32x2 __attribute__((ext_vector_type(2)));
typedef float f32x16 __attribute__((ext_vector_type(16)));
typedef short bf16x8 __attribute__((ext_vector_type(8)));
typedef unsigned u32x4 __attribute__((ext_vector_type(4)));
typedef unsigned u32x2 __attribute__((ext_vector_type(2)));
constexpr int NB = 4, SEQ = 8192, DM = 1024, DFF = 2816, M = NB * SEQ, NMOD = 9;
constexpr float RMS_EPS = 1e-6f;
constexpr float C2 = 0.125f * 1.4426950408889634f;
constexpr size_t MiB = 1u << 20;
constexpr size_t WS_CTL = 0;
constexpr size_t WS_WGU1 = 1 * MiB, WS_WD1 = 12 * MiB, WS_WIN = 18 * MiB, WS_WOUT = 24 * MiB, WS_WGU2 = 26 * MiB, WS_WD2 = 37 * MiB;
constexpr size_t WS_H = 48 * MiB;
constexpr size_t WS_F = 112 * MiB;
constexpr size_t WS_XB = 176 * MiB;
constexpr size_t WS_ACT = 240 * MiB;
constexpr size_t WS_VTD = 416 * MiB, WS_VTS = 448 * MiB;
constexpr size_t WS_OSB = 480 * MiB;
constexpr size_t WS_END = 512 * MiB;
constexpr int GEMM_LDS = 131072, LDS_BYTES = GEMM_LDS + 1024;
constexpr size_t WS_CTLW = 512 * 1024, CTLW_BYTES = 32 * 1024;
constexpr int CW_KINF = 4096, CW_QUEUE = 4160;

template <int CTRL> __device__ __forceinline__ float dpp_f(float v) { return __builtin_bit_cast(float, __builtin_amdgcn_update_dpp(0, __builtin_bit_cast(int, v), CTRL, 0xF, 0xF, true)); }
__device__ __forceinline__ float row16_sum(float v) {
    v += dpp_f<0xB1>(v);
    v += dpp_f<0x4E>(v);
    v += dpp_f<0x141>(v);
    v += dpp_f<0x140>(v);
    return v;
}
__device__ __forceinline__ float xrow_sum(float v) {
    { auto rr = __builtin_amdgcn_permlane16_swap(__float_as_uint(v), __float_as_uint(v), false, false); v = __uint_as_float(rr[0]) + __uint_as_float(rr[1]); }
    { auto rr = __builtin_amdgcn_permlane32_swap(__float_as_uint(v), __float_as_uint(v), false, false); v = __uint_as_float(rr[0]) + __uint_as_float(rr[1]); }
    return v;
}
__device__ __forceinline__ float wave_sum(float v) { return xrow_sum(row16_sum(v)); }
__device__ __forceinline__ unsigned pk_bf16(float lo, float hi) { return pg8::cvt_pk_bf16(lo, hi); }
__device__ __forceinline__ float bf2f(unsigned short h) { return __uint_as_float(((unsigned)h) << 16); }

namespace att {
constexpr int KSTR = 144;
constexpr int KBUFB = 64 * KSTR, STAGEB = KBUFB + 128 * KSTR;
constexpr int FLAG_OFF = 2 * STAGEB;
constexpr float THR = -48.0f;
__device__ __forceinline__ int crow(int r, int hi) { return (r & 3) + 8 * (r >> 2) + 4 * hi; }
typedef __bf16 bf16x2_t __attribute__((ext_vector_type(2)));
__device__ __forceinline__ unsigned cvtpk_c(float lo, float hi) { const f32x2 v = {lo, hi}; const bf16x2_t b = __builtin_convertvector(v, bf16x2_t); return __builtin_bit_cast(unsigned, b); }
__device__ __forceinline__ bf16x8 pack8(const f32x16& p, int b) {
    u32x4 w; w.x = cvtpk_c(p[b], p[b + 1]); w.y = cvtpk_c(p[b + 2], p[b + 3]); w.z = cvtpk_c(p[b + 4], p[b + 5]); w.w = cvtpk_c(p[b + 6], p[b + 7]);
    return __builtin_bit_cast(bf16x8, w);
}
#define MFMA32(a, b, c) __builtin_amdgcn_mfma_f32_32x32x16_bf16((a), (b), (c), 0, 0, 0)
__device__ __forceinline__ float max3f(float a, float b, float c) { float r; asm("v_max3_f32 %0, %1, %2, %3" : "=v"(r) : "v"(a), "v"(b), "v"(c)); return r; }
__device__ __forceinline__ float xhalf_max(float m) { auto rr = __builtin_amdgcn_permlane32_swap(__float_as_uint(m), __float_as_uint(m), false, false); return fmaxf(__uint_as_float(rr[0]), __uint_as_float(rr[1])); }
__device__ __forceinline__ float xhalf_sum(float m) { auto rr = __builtin_amdgcn_permlane32_swap(__float_as_uint(m), __float_as_uint(m), false, false); return __uint_as_float(rr[0]) + __uint_as_float(rr[1]); }

template <int MODE, int DV>
__device__ __forceinline__ void attn_unit(LAS unsigned char* lds, const bf16* __restrict__ QK, int qcol, int kcol, const bf16* __restrict__ Vt,
                                          size_t rowbase, int qb, float slope2, float kinfa, float kinfb, float* __restrict__ Of, bf16* __restrict__ Ob, int ocol) {
    constexpr int NDB = DV / 32, NVC = DV / 64, NACC = NDB;
    int tid_l = threadIdx.x; asm volatile("" : "+v"(tid_l));
    const int tid = tid_l, lane = tid & 63, r32 = lane & 31, hi = lane >> 5;
    const int wid = __builtin_amdgcn_readfirstlane(tid >> 6);
    const int q0 = qb * 256, tw0 = q0 + 32 * wid, t = tw0 + r32;
    const int NT = 4 * qb + 4;
    bf16x8 qf[4];
    { const bf16* qp = QK + (rowbase + t) * 2048 + qcol + hi * 8;
#pragma unroll
      for (int ds = 0; ds < 4; ++ds) qf[ds] = *(const GAS bf16x8*)(qp + ds * 16); }
    float rowc = 0.f;
    if (MODE == 0) {
        float sa = 0.f, sb2 = 0.f;
#pragma unroll
        for (int ds = 0; ds < 4; ++ds) { const u32x4 w = __builtin_bit_cast(u32x4, qf[ds]);
            const float e0 = __uint_as_float(w.x << 16), e1 = __uint_as_float(w.x & 0xffff0000u), e2 = __uint_as_float(w.y << 16), e3 = __uint_as_float(w.y & 0xffff0000u);
            const float e4 = __uint_as_float(w.z << 16), e5 = __uint_as_float(w.z & 0xffff0000u), e6 = __uint_as_float(w.w << 16), e7 = __uint_as_float(w.w & 0xffff0000u);
            const float q2 = (e0 * e0 + e1 * e1) + (e2 * e2 + e3 * e3) + (e4 * e4 + e5 * e5) + (e6 * e6 + e7 * e7);
            if (ds < 2) sa += q2; else sb2 += q2; }
        sa = xhalf_sum(sa); sb2 = xhalf_sum(sb2);
        rowc = (sqrtf(sa * kinfa) + sqrtf(sb2 * kinfb)) * 1.02f;
    }
    const int krow = tid >> 3, kch = tid & 7;
    const bf16* ksrc = QK + (rowbase + krow) * 2048 + kcol + kch * 8;
    const unsigned kdst = krow * KSTR + kch * 16;
    const bf16* vsrc = Vt + (size_t)krow * SEQ + kch * 8;
    const unsigned vdst = KBUFB + krow * KSTR + kch * 16;
    const unsigned koff = r32 * KSTR + hi * 16;
    LAS unsigned* flags = (LAS unsigned*)(lds + FLAG_OFF);

    f32x16 o[NACC];
#pragma unroll
    for (int d = 0; d < NACC; ++d)
#pragma unroll
        for (int r = 0; r < 16; ++r) o[d][r] = 0.f;
    float mrun = 0.f, carry = 0.f, lrun = 0.f;
    bool wdone = false, first = true;
    bf16x8 ut0, ut1, uone;
    { const u32x4 c = {0x3F803F80u, 0x3F803F80u, 0x3F803F80u, 0x3F803F80u}; uone = __builtin_bit_cast(bf16x8, c); }
    if (MODE == 1) {
        u32x4 a, b;
        unsigned e0[8], e1[8];
#pragma unroll
        for (int j = 0; j < 8; ++j) { const int jj = 8 * (j >> 2) + 4 * hi + (j & 3); e0[j] = (jj > r32) ? 0x3F80u : 0u; e1[j] = (16 + jj > r32) ? 0x3F80u : 0u; }
        a.x = e0[0] | (e0[1] << 16); a.y = e0[2] | (e0[3] << 16); a.z = e0[4] | (e0[5] << 16); a.w = e0[6] | (e0[7] << 16);
        b.x = e1[0] | (e1[1] << 16); b.y = e1[2] | (e1[3] << 16); b.z = e1[4] | (e1[5] << 16); b.w = e1[6] | (e1[7] << 16);
        ut0 = __builtin_bit_cast(bf16x8, a); ut1 = __builtin_bit_cast(bf16x8, b);
    }
    u32x4 kreg[2], vreg[2][NVC];
#define ATT_LOAD(set_, kt_) do { kreg[set_] = *(const GAS u32x4*)(ksrc + (size_t)(kt_) * 64 * 2048); \
        _Pragma("unroll") for (int i_ = 0; i_ < NVC; ++i_) vreg[set_][i_] = *(const GAS u32x4*)(vsrc + (size_t)i_ * 64 * SEQ + (kt_) * 64); } while (0)
#define ATT_STORE(set_, stg_) do { *(LAS u32x4*)(lds + (stg_) * STAGEB + kdst) = kreg[set_]; \
        _Pragma("unroll") for (int i_ = 0; i_ < NVC; ++i_) *(LAS u32x4*)(lds + (stg_) * STAGEB + vdst + i_ * 64 * KSTR) = vreg[set_][i_]; } while (0)
    ATT_LOAD(0, NT - 1); ATT_LOAD(1, (NT - 2 > 0) ? NT - 2 : 0); ATT_STORE(0, 0);
    __syncthreads();
    int kt = NT - 1; bool fin = false;
    for (;;) {
#pragma unroll
      for (int hh = 0; hh < 2; ++hh) {
        const bool hasn = (kt > 0);
        ATT_LOAD(hh, (kt - 2 > 0) ? kt - 2 : 0);
        const int k0 = kt * 64;
        const LAS unsigned char* sb = lds + hh * STAGEB;
        const bool active = ((MODE == 0) ? (k0 <= tw0 + 31) : (k0 < tw0 + 31)) && !wdone;
        if (active) {
            f32x16 p0, p1;
            if (MODE == 0) {
                const float bb = slope2 * (float)(k0 + 4 * hi - t) - mrun;
#pragma unroll
                for (int r = 0; r < 16; ++r) { const float c = __builtin_fmaf(slope2, (float)((r & 3) + 8 * (r >> 2)), bb); p0[r] = c; p1[r] = __builtin_fmaf(slope2, 32.0f, c); }
            } else {
#pragma unroll
                for (int r = 0; r < 16; ++r) { p0[r] = 0.f; p1[r] = 0.f; }
            }
#pragma unroll
            for (int ds = 0; ds < 4; ++ds) {
                const bf16x8 k0f = *(const LAS bf16x8*)(sb + koff + ds * 32);
                const bf16x8 k1f = *(const LAS bf16x8*)(sb + koff + 32 * KSTR + ds * 32);
                p0 = MFMA32(k0f, qf[ds], p0); p1 = MFMA32(k1f, qf[ds], p1);
            }
            const bool diag = (MODE == 0) ? (k0 + 63 > tw0) : (k0 + 63 >= tw0);
            bf16x8 pf0, pf1, pf2, pf3;
            if (MODE == 0) {
                if (diag) {
#pragma unroll
                    for (int r = 0; r < 16; ++r) { const int key = k0 + crow(r, hi); if (key > t) p0[r] = -INFINITY; if (key + 32 > t) p1[r] = -INFINITY; }
                }
                float mx;
                { float a0 = max3f(p0[0], p0[1], p0[2]), a1 = max3f(p0[3], p0[4], p0[5]), a2 = max3f(p0[6], p0[7], p0[8]), a3 = max3f(p0[9], p0[10], p0[11]);
                  float a4 = max3f(p0[12], p0[13], p0[14]), a5 = max3f(p0[15], p1[0], p1[1]), a6 = max3f(p1[2], p1[3], p1[4]), a7 = max3f(p1[5], p1[6], p1[7]);
                  float a8 = max3f(p1[8], p1[9], p1[10]), a9 = max3f(p1[11], p1[12], p1[13]), a10 = max3f(p1[14], p1[15], a0);
                  a1 = max3f(a1, a2, a3); a4 = max3f(a4, a5, a6); a7 = max3f(a7, a8, a9);
                  mx = xhalf_max(max3f(max3f(a1, a4, a7), a10, a10)); }
                if (first || __any(mx > 6.0f)) {
                    const float dl = first ? mx : fmaxf(mx, 0.f);
#pragma unroll
                    for (int r = 0; r < 16; ++r) { p0[r] -= dl; p1[r] -= dl; }
                    mrun += dl;
                    if (!first) { const float alpha = __builtin_amdgcn_exp2f(-dl); lrun *= alpha;
#pragma unroll
                        for (int d = 0; d < NACC; ++d)
#pragma unroll
                            for (int r = 0; r < 16; ++r) o[d][r] *= alpha; }
                    first = false;
                }
#pragma unroll
                for (int r = 0; r < 16; ++r) { p0[r] = __builtin_amdgcn_exp2f(p0[r]); p1[r] = __builtin_amdgcn_exp2f(p1[r]); }
                { float s0 = p0[0] + p1[0], s1 = p0[1] + p1[1], s2 = p0[2] + p1[2], s3 = p0[3] + p1[3];
#pragma unroll
                  for (int r = 4; r < 16; r += 4) { s0 += p0[r] + p1[r]; s1 += p0[r + 1] + p1[r + 1]; s2 += p0[r + 2] + p1[r + 2]; s3 += p0[r + 3] + p1[r + 3]; }
                  lrun += (s0 + s1) + (s2 + s3); }
                pf0 = pack8(p0, 0); pf1 = pack8(p0, 8); pf2 = pack8(p1, 0); pf3 = pack8(p1, 8);
                wdone = __all(rowc - slope2 * (float)(t - k0 + 1) < mrun - 32.0f) != 0;
            } else {
                float ts = 0.f;
                f32x16 l0, l1;
#pragma unroll
                for (int r = 0; r < 16; ++r) {
                    { const float z = p0[r]; const float e = __builtin_amdgcn_exp2f(-fabsf(z)); const float sp = fmaxf(-z, 0.f) + __builtin_amdgcn_logf(1.0f + e);
                      const float lb = -sp; float lm = lb - z; if (diag && !(k0 + crow(r, hi) < t)) lm = 0.f; l0[r] = lm; ts += lm; p0[r] = lb + carry; }
                    { const float z = p1[r]; const float e = __builtin_amdgcn_exp2f(-fabsf(z)); const float sp = fmaxf(-z, 0.f) + __builtin_amdgcn_logf(1.0f + e);
                      const float lb = -sp; float lm = lb - z; if (diag && !(k0 + 32 + crow(r, hi) < t)) lm = 0.f; l1[r] = lm; ts += lm; p1[r] = lb + carry; }
                }
                const bf16x8 L0a = pack8(l0, 0), L0b = pack8(l0, 8), L1a = pack8(l1, 0), L1b = pack8(l1, 8);
                p0 = MFMA32(ut0, L0a, p0); p0 = MFMA32(ut1, L0b, p0); p0 = MFMA32(uone, L1a, p0); p0 = MFMA32(uone, L1b, p0);
                p1 = MFMA32(ut0, L1a, p1); p1 = MFMA32(ut1, L1b, p1);
#pragma unroll
                for (int r = 0; r < 16; ++r) {
                    float a0 = __builtin_amdgcn_exp2f(p0[r]), a1 = __builtin_amdgcn_exp2f(p1[r]);
                    if (diag) { if (!(k0 + crow(r, hi) < t)) a0 = 0.f; if (!(k0 + 32 + crow(r, hi) < t)) a1 = 0.f; }
                    p0[r] = a0; p1[r] = a1;
                }
                ts = xhalf_sum(ts);
                carry += ts;
                pf0 = pack8(p0, 0); pf1 = pack8(p0, 8); pf2 = pack8(p1, 0); pf3 = pack8(p1, 8);
                wdone = __all(carry < THR) != 0;
            }
#pragma unroll
            for (int d = 0; d < NDB; ++d) {
                const LAS unsigned char* vb = sb + KBUFB + d * 32 * KSTR + koff;
                const bf16x8 v0 = *(const LAS bf16x8*)(vb), v1 = *(const LAS bf16x8*)(vb + 32), v2 = *(const LAS bf16x8*)(vb + 64), v3 = *(const LAS bf16x8*)(vb + 96);
                o[d] = MFMA32(v0, pf0, o[d]); o[d] = MFMA32(v1, pf1, o[d]); o[d] = MFMA32(v2, pf2, o[d]); o[d] = MFMA32(v3, pf3, o[d]);
            }
        }
        if (hasn) ATT_STORE(hh ^ 1, hh ^ 1);
        if (lane == 0) flags[hh * 8 + wid] = wdone ? 1u : 0u;
        __syncthreads();
        if (!hasn) { fin = true; break; }
        { const unsigned f = flags[hh * 8 + (lane & 7)]; if (__all(f != 0u)) { fin = true; break; } }
        --kt;
      }
      if (fin) break;
    }
#undef ATT_LOAD
#undef ATT_STORE
    if (MODE == 0) {
        const float inv = 1.0f / xhalf_sum(lrun);
        LAS unsigned char* ost = lds + wid * (32 * KSTR);
        bf16* og = (bf16*)Of + (rowbase + tw0) * 1024 + ocol;
#pragma unroll
        for (int ps = 0; ps < NDB / 2; ++ps) {
#pragma unroll
            for (int dd = 0; dd < 2; ++dd)
#pragma unroll
                for (int g = 0; g < 4; ++g) { const int d = 2 * ps + dd; u32x2 w; w.x = pk_bf16(o[d][4 * g] * inv, o[d][4 * g + 1] * inv); w.y = pk_bf16(o[d][4 * g + 2] * inv, o[d][4 * g + 3] * inv);
                    *(LAS u32x2*)(ost + r32 * KSTR + (32 * dd + 8 * g + 4 * hi) * 2) = w; }
#pragma unroll
            for (int i = 0; i < 4; ++i) { const int row = (lane >> 3) + 8 * i, ch = lane & 7;
                const u32x4 v = *(const LAS u32x4*)(ost + row * KSTR + ch * 16);
                *(GAS u32x4*)(og + (size_t)row * 1024 + 64 * ps + 8 * ch) = v; }
        }
    } else {
        bf16* op = Ob + (rowbase + t) * 512 + ocol + 4 * hi;
#pragma unroll
        for (int d = 0; d < NDB; ++d)
#pragma unroll
            for (int g = 0; g < 4; ++g) { u32x2 w; w.x = pk_bf16(o[d][4 * g], o[d][4 * g + 1]); w.y = pk_bf16(o[d][4 * g + 2], o[d][4 * g + 3]); *(GAS u32x2*)(op + 32 * d + 8 * g) = w; }
    }
}
constexpr int SB2_KB = 64 * KSTR, SB2_STAGE = 4 * SB2_KB;
template <int MODE, int DV>
__device__ __forceinline__ void sb_unit2(LAS unsigned char* lds, const bf16* __restrict__ QK, int qcol, int kcol, const bf16* __restrict__ Vt, LAS unsigned* flags_,
                                          size_t rowbase, int qb, float slope2, float kinfa, float kinfb, float* __restrict__ Of, bf16* __restrict__ Ob, int ocol) {
    constexpr int NDB = DV / 32, NVC = DV / 64, NACC = NDB;
    int tid_l = threadIdx.x; asm volatile("" : "+v"(tid_l));
    const int tid = tid_l, lane = tid & 63, r32 = lane & 31, hi = lane >> 5;
    const int wid = __builtin_amdgcn_readfirstlane(tid >> 6);
    const int hsel = wid >> 2;
    qcol += 64 * hsel; ocol += 64 * hsel;
    const int q0 = qb * 128, tw0 = q0 + 32 * (wid & 3), t = tw0 + r32;
    const int NT = 2 * qb + 2;
    bf16x8 qf[4];
    { const bf16* qp = QK + (rowbase + t) * 2048 + qcol + hi * 8;
#pragma unroll
      for (int ds = 0; ds < 4; ++ds) qf[ds] = *(const GAS bf16x8*)(qp + ds * 16); }
    float rowc = 0.f;
    if (MODE == 0) {
        float sa = 0.f, sb2 = 0.f;
#pragma unroll
        for (int ds = 0; ds < 4; ++ds) { const u32x4 w = __builtin_bit_cast(u32x4, qf[ds]);
            const float e0 = __uint_as_float(w.x << 16), e1 = __uint_as_float(w.x & 0xffff0000u), e2 = __uint_as_float(w.y << 16), e3 = __uint_as_float(w.y & 0xffff0000u);
            const float e4 = __uint_as_float(w.z << 16), e5 = __uint_as_float(w.z & 0xffff0000u), e6 = __uint_as_float(w.w << 16), e7 = __uint_as_float(w.w & 0xffff0000u);
            const float q2 = (e0 * e0 + e1 * e1) + (e2 * e2 + e3 * e3) + (e4 * e4 + e5 * e5) + (e6 * e6 + e7 * e7);
            if (ds < 2) sa += q2; else sb2 += q2; }
        sa = xhalf_sum(sa); sb2 = xhalf_sum(sb2);
        rowc = (sqrtf(sa * kinfa) + sqrtf(sb2 * kinfb)) * 1.02f;
    }
    const int th = tid >> 8, idx = tid & 255, krow = idx >> 3, kch = idx & 7;
    const bf16* ksrc = QK + (rowbase + krow) * 2048 + kcol + 64 * th + kch * 8;
    const unsigned kdst = th * SB2_KB + krow * KSTR + kch * 16;
    const bf16* vsrc = Vt + (size_t)(64 * th + krow) * SEQ + kch * 8;
    const unsigned vdst = 2 * SB2_KB + th * SB2_KB + krow * KSTR + kch * 16;
    const unsigned koff = hsel * SB2_KB + r32 * KSTR + hi * 16;
    LAS unsigned* flags = flags_;

    f32x16 o[NACC];
#pragma unroll
    for (int d = 0; d < NACC; ++d)
#pragma unroll
        for (int r = 0; r < 16; ++r) o[d][r] = 0.f;
    float mrun = 0.f, carry = 0.f, lrun = 0.f;
    bool wdone = false, first = true;
    bf16x8 ut0, ut1, uone;
    { const u32x4 c = {0x3F803F80u, 0x3F803F80u, 0x3F803F80u, 0x3F803F80u}; uone = __builtin_bit_cast(bf16x8, c); }
    if (MODE == 1) {
        u32x4 a, b;
        unsigned e0[8], e1[8];
#pragma unroll
        for (int j = 0; j < 8; ++j) { const int jj = 8 * (j >> 2) + 4 * hi + (j & 3); e0[j] = (jj > r32) ? 0x3F80u : 0u; e1[j] = (16 + jj > r32) ? 0x3F80u : 0u; }
        a.x = e0[0] | (e0[1] << 16); a.y = e0[2] | (e0[3] << 16); a.z = e0[4] | (e0[5] << 16); a.w = e0[6] | (e0[7] << 16);
        b.x = e1[0] | (e1[1] << 16); b.y = e1[2] | (e1[3] << 16); b.z = e1[4] | (e1[5] << 16); b.w = e1[6] | (e1[7] << 16);
        ut0 = __builtin_bit_cast(bf16x8, a); ut1 = __builtin_bit_cast(bf16x8, b);
    }
    u32x4 kreg[2][2], vreg[2][2];
#define ATT_LOAD(set_, kt_) do { _Pragma("unroll") for (int i_ = 0; i_ < 2; ++i_) { kreg[set_][i_] = *(const GAS u32x4*)(ksrc + ((size_t)(kt_) * 64 + 32 * i_) * 2048); \
        vreg[set_][i_] = *(const GAS u32x4*)(vsrc + (size_t)i_ * 32 * SEQ + (kt_) * 64); } } while (0)
#define ATT_STORE(set_, stg_) do { _Pragma("unroll") for (int i_ = 0; i_ < 2; ++i_) { *(LAS u32x4*)(lds + (stg_) * SB2_STAGE + kdst + i_ * 32 * KSTR) = kreg[set_][i_]; \
        *(LAS u32x4*)(lds + (stg_) * SB2_STAGE + vdst + i_ * 32 * KSTR) = vreg[set_][i_]; } } while (0)
    ATT_LOAD(0, NT - 1); ATT_LOAD(1, (NT - 2 > 0) ? NT - 2 : 0); ATT_STORE(0, 0);
    __syncthreads();
    int kt = NT - 1; bool fin = false;
    for (;;) {
#pragma unroll
      for (int hh = 0; hh < 2; ++hh) {
        const bool hasn = (kt > 0);
        ATT_LOAD(hh, (kt - 2 > 0) ? kt - 2 : 0);
        const int k0 = kt * 64;
        const LAS unsigned char* sb = lds + hh * SB2_STAGE;
        const bool active = ((MODE == 0) ? (k0 <= tw0 + 31) : (k0 < tw0 + 31)) && !wdone;
        if (active) {
            f32x16 p0, p1;
            if (MODE == 0) {
                const float bb = slope2 * (float)(k0 + 4 * hi - t) - mrun;
#pragma unroll
                for (int r = 0; r < 16; ++r) { const float c = __builtin_fmaf(slope2, (float)((r & 3) + 8 * (r >> 2)), bb); p0[r] = c; p1[r] = __builtin_fmaf(slope2, 32.0f, c); }
            } else {
#pragma unroll
                for (int r = 0; r < 16; ++r) { p0[r] = 0.f; p1[r] = 0.f; }
            }
#pragma unroll
            for (int ds = 0; ds < 4; ++ds) {
                const bf16x8 k0f = *(const LAS bf16x8*)(sb + koff + ds * 32);
                const bf16x8 k1f = *(const LAS bf16x8*)(sb + koff + 32 * KSTR + ds * 32);
                p0 = MFMA32(k0f, qf[ds], p0); p1 = MFMA32(k1f, qf[ds], p1);
            }
            const bool diag = (MODE == 0) ? (k0 + 63 > tw0) : (k0 + 63 >= tw0);
            bf16x8 pf0, pf1, pf2, pf3;
            if (MODE == 0) {
                if (diag) {
#pragma unroll
                    for (int r = 0; r < 16; ++r) { const int key = k0 + crow(r, hi); if (key > t) p0[r] = -INFINITY; if (key + 32 > t) p1[r] = -INFINITY; }
                }
                float mx;
                { float a0 = max3f(p0[0], p0[1], p0[2]), a1 = max3f(p0[3], p0[4], p0[5]), a2 = max3f(p0[6], p0[7], p0[8]), a3 = max3f(p0[9], p0[10], p0[11]);
                  float a4 = max3f(p0[12], p0[13], p0[14]), a5 = max3f(p0[15], p1[0], p1[1]), a6 = max3f(p1[2], p1[3], p1[4]), a7 = max3f(p1[5], p1[6], p1[7]);
                  float a8 = max3f(p1[8], p1[9], p1[10]), a9 = max3f(p1[11], p1[12], p1[13]), a10 = max3f(p1[14], p1[15], a0);
                  a1 = max3f(a1, a2, a3); a4 = max3f(a4, a5, a6); a7 = max3f(a7, a8, a9);
                  mx = xhalf_max(max3f(max3f(a1, a4, a7), a10, a10)); }
                if (first || __any(mx > 6.0f)) {
                    const float dl = first ? mx : fmaxf(mx, 0.f);
#pragma unroll
                    for (int r = 0; r < 16; ++r) { p0[r] -= dl; p1[r] -= dl; }
                    mrun += dl;
                    if (!first) { const float alpha = __builtin_amdgcn_exp2f(-dl); lrun *= alpha;
#pragma unroll
                        for (int d = 0; d < NACC; ++d)
#pragma unroll
                            for (int r = 0; r < 16; ++r) o[d][r] *= alpha; }
                    first = false;
                }
#pragma unroll
                for (int r = 0; r < 16; ++r) { p0[r] = __builtin_amdgcn_exp2f(p0[r]); p1[r] = __builtin_amdgcn_exp2f(p1[r]); }
                { float s0 = p0[0] + p1[0], s1 = p0[1] + p1[1], s2 = p0[2] + p1[2], s3 = p0[3] + p1[3];
#pragma unroll
                  for (int r = 4; r < 16; r += 4) { s0 += p0[r] + p1[r]; s1 += p0[r + 1] + p1[r + 1]; s2 += p0[r + 2] + p1[r + 2]; s3 += p0[r + 3] + p1[r + 3]; }
                  lrun += (s0 + s1) + (s2 + s3); }
                pf0 = pack8(p0, 0); pf1 = pack8(p0, 8); pf2 = pack8(p1, 0); pf3 = pack8(p1, 8);
                wdone = __all(rowc - slope2 * (float)(t - k0 + 1) < mrun - 32.0f) != 0;
            } else {
                float ts = 0.f;
                f32x16 l0, l1;
#pragma unroll
                for (int r = 0; r < 16; ++r) {
                    { const float z = p0[r]; const float e = __builtin_amdgcn_exp2f(-fabsf(z)); const float sp = fmaxf(-z, 0.f) + __builtin_amdgcn_logf(1.0f + e);
                      const float lb = -sp; float lm = lb - z; if (diag && !(k0 + crow(r, hi) < t)) lm = 0.f; l0[r] = lm; ts += lm; p0[r] = lb + carry; }
                    { const float z = p1[r]; const float e = __builtin_amdgcn_exp2f(-fabsf(z)); const float sp = fmaxf(-z, 0.f) + __builtin_amdgcn_logf(1.0f + e);
                      const float lb = -sp; float lm = lb - z; if (diag && !(k0 + 32 + crow(r, hi) < t)) lm = 0.f; l1[r] = lm; ts += lm; p1[r] = lb + carry; }
                }
                const bf16x8 L0a = pack8(l0, 0), L0b = pack8(l0, 8), L1a = pack8(l1, 0), L1b = pack8(l1, 8);
                p0 = MFMA32(ut0, L0a, p0); p0 = MFMA32(ut1, L0b, p0); p0 = MFMA32(uone, L1a, p0); p0 = MFMA32(uone, L1b, p0);
                p1 = MFMA32(ut0, L1a, p1); p1 = MFMA32(ut1, L1b, p1);
#pragma unroll
                for (int r = 0; r < 16; ++r) {
                    float a0 = __builtin_amdgcn_exp2f(p0[r]), a1 = __builtin_amdgcn_exp2f(p1[r]);
                    if (diag) { if (!(k0 + crow(r, hi) < t)) a0 = 0.f; if (!(k0 + 32 + crow(r, hi) < t)) a1 = 0.f; }
                    p0[r] = a0; p1[r] = a1;
                }
                ts = xhalf_sum(ts);
                carry += ts;
                pf0 = pack8(p0, 0); pf1 = pack8(p0, 8); pf2 = pack8(p1, 0); pf3 = pack8(p1, 8);
                wdone = __all(carry < THR) != 0;
            }
#pragma unroll
            for (int d = 0; d < NDB; ++d) {
                const LAS unsigned char* vb = sb + 2 * SB2_KB + d * 32 * KSTR + koff;
                const bf16x8 v0 = *(const LAS bf16x8*)(vb), v1 = *(const LAS bf16x8*)(vb + 32), v2 = *(const LAS bf16x8*)(vb + 64), v3 = *(const LAS bf16x8*)(vb + 96);
                o[d] = MFMA32(v0, pf0, o[d]); o[d] = MFMA32(v1, pf1, o[d]); o[d] = MFMA32(v2, pf2, o[d]); o[d] = MFMA32(v3, pf3, o[d]);
            }
        }
        if (hasn) ATT_STORE(hh ^ 1, hh ^ 1);
        if (lane == 0) flags[hh * 8 + wid] = wdone ? 1u : 0u;
        __syncthreads();
        if (!hasn) { fin = true; break; }
        { const unsigned f = flags[hh * 8 + (lane & 7)]; if (__all(f != 0u)) { fin = true; break; } }
        --kt;
      }
      if (fin) break;
    }
#undef ATT_LOAD
#undef ATT_STORE
    if (MODE == 0) {
        const float inv = 1.0f / xhalf_sum(lrun);
        bf16* op = (bf16*)Of + (rowbase + t) * 1024 + ocol + 4 * hi;
#pragma unroll
        for (int d = 0; d < NDB; ++d)
#pragma unroll
            for (int g = 0; g < 4; ++g) { u32x2 w; w.x = pk_bf16(o[d][4 * g] * inv, o[d][4 * g + 1] * inv); w.y = pk_bf16(o[d][4 * g + 2] * inv, o[d][4 * g + 3] * inv); *(GAS u32x2*)(op + 32 * d + 8 * g) = w; }
    } else {
        LAS unsigned char* ost = lds + wid * (32 * KSTR);
        bf16* og = Ob + (rowbase + tw0) * 512 + ocol;
#pragma unroll
        for (int d = 0; d < NDB; ++d)
#pragma unroll
            for (int g = 0; g < 4; ++g) { u32x2 w; w.x = pk_bf16(o[d][4 * g], o[d][4 * g + 1]); w.y = pk_bf16(o[d][4 * g + 2], o[d][4 * g + 3]);
                *(LAS u32x2*)(ost + r32 * KSTR + (32 * d + 8 * g + 4 * hi) * 2) = w; }
#pragma unroll
        for (int i = 0; i < 4; ++i) { const int row = (lane >> 3) + 8 * i, ch = lane & 7;
            const u32x4 v = *(const LAS u32x4*)(ost + row * KSTR + ch * 16);
            *(GAS u32x4*)(og + (size_t)row * 512 + 8 * ch) = v; }
    }
}
#undef MFMA32
}

#define XB_TMO      128
#define XB_XCNT(j)  (256  + 64 * (j))
#define XB_XSUB(j)  (1280 + 64 * (j))
#define XB_XGEN(j)  (2304 + 64 * (j))
#define XB_TOP      3328
#define XB_TOPGEN   3392
#define XCD_BAR_WORDS 3456
#define XB_SPIN_CAP (1u << 18)

__device__ __forceinline__ unsigned xb_ld(unsigned* p)              { return __hip_atomic_load(p, __ATOMIC_RELAXED, __HIP_MEMORY_SCOPE_AGENT); }
__device__ __forceinline__ unsigned xb_add(unsigned* p, unsigned v) { return __hip_atomic_fetch_add(p, v, __ATOMIC_RELAXED, __HIP_MEMORY_SCOPE_AGENT); }
__device__ __forceinline__ unsigned xb_xcc_id() { return (unsigned)__builtin_amdgcn_s_getreg((3 << 11) | 20) & 0xFu; }
#define XB_SPIN(cond, bar) do { unsigned _sp = 0; while (cond) { __builtin_amdgcn_s_sleep(1); \
    if ((++_sp & 255u) == 0u) { if (xb_ld(&(bar)[XB_TMO])) break; if (_sp > XB_SPIN_CAP) { atomicAdd(&(bar)[XB_TMO], 1u); break; } } } } while (0)

struct XcdBarrier {
    unsigned* bar; unsigned x;
    volatile LAS unsigned* st;
};

__device__ __forceinline__ XcdBarrier xcd_barrier_post(unsigned* bar, volatile LAS unsigned* st) {
    XcdBarrier b; b.bar = bar; b.x = xb_xcc_id(); b.st = st;
    if (threadIdx.x == 0) (void)xb_add(&bar[XB_XCNT(b.x)], 1u);
    return b;
}
__device__ __forceinline__ void xcd_barrier_complete(unsigned* bar, unsigned x, unsigned& nloc, unsigned& nx) {
    const unsigned G = gridDim.x * gridDim.y * gridDim.z;
    unsigned sum, cnt, mine, sp = 0u;
    for (;;) {
        sum = 0u; cnt = 0u; mine = 0u;
#pragma unroll
        for (unsigned j = 0; j < 16; ++j) { const unsigned c = xb_ld(&bar[XB_XCNT(j)]); sum += c; cnt += (c > 0u) ? 1u : 0u; mine = (j == x) ? c : mine; }
        if (sum == G) break;
        __builtin_amdgcn_s_sleep(1);
        if ((++sp & 255u) == 0u) { if (xb_ld(&bar[XB_TMO])) break; if (sp > XB_SPIN_CAP) { atomicAdd(&bar[XB_TMO], 1u); break; } }
    }
    nloc = mine > 0u ? mine : 1u; nx = cnt > 0u ? cnt : 1u;
}

__device__ __forceinline__ void xcd_barrier(const XcdBarrier& b) {
    asm volatile("s_waitcnt vmcnt(0)" ::: "memory");
    __syncthreads();
    if (threadIdx.x == 0) {
        unsigned* bar = b.bar;
        __builtin_amdgcn_s_waitcnt(0);
        unsigned nloc = b.st[0], nx = b.st[1];
        if (nloc == 0u) { xcd_barrier_complete(bar, b.x, nloc, nx); b.st[0] = nloc; b.st[1] = nx; }
        const unsigned old = xb_add(&bar[XB_XSUB(b.x)], 1u);
        const unsigned gen = old / nloc;
        if (old + 1u == (gen + 1u) * nloc) {
            __builtin_amdgcn_fence(__ATOMIC_RELEASE, "agent");
            asm volatile("s_waitcnt vmcnt(0)" ::: "memory");
            const unsigned og = xb_add(&bar[XB_TOP], 1u);
            const unsigned tg = og / nx;
            if (og + 1u == (tg + 1u) * nx) xb_add(&bar[XB_TOPGEN], 1u);
            else XB_SPIN(xb_ld(&bar[XB_TOPGEN]) == tg, bar);
            __builtin_amdgcn_fence(__ATOMIC_ACQUIRE, "agent");
            xb_add(&bar[XB_XGEN(b.x)], 1u);
            asm volatile("s_waitcnt vmcnt(0)" ::: "memory");
        } else {
            XB_SPIN(xb_ld(&bar[XB_XGEN(b.x)]) == gen, bar);
            __builtin_amdgcn_fence(__ATOMIC_ACQUIRE, "agent");
            asm volatile("s_waitcnt vmcnt(0)" ::: "memory");
        }
    }
    __syncthreads();
}

#ifndef WGM_GU
#define WGM_GU 4
#endif
#ifndef WGM_N1K
#define WGM_N1K 4
#endif
#ifndef WGM_IN
#define WGM_IN 4
#endif
#ifndef PHASE_MASK
#define PHASE_MASK 0xFFFF
#endif
#define PH(n) (((PHASE_MASK) >> (n)) & 1)
#ifndef DUP_MASK
#define DUP_MASK 0
#endif
#ifndef ATT_DUP
#define ATT_DUP 0
#endif
#define REP(n) for (int rep_ = 0; rep_ < 1 + (((DUP_MASK) >> (n)) & 1); ++rep_)
#ifndef ATT_PASS_MASK
#define ATT_PASS_MASK 3
#endif
struct Args { const float* in[24]; float* out; unsigned char* ws; };

__device__ __forceinline__ void transpose_item(const float* __restrict__ W, int K, int N, bf16* __restrict__ WT, int mode, LAS float* scr, int item, int lane) {
    const int nblk = N / 32, kb = item / nblk, nb = item % nblk, k0 = 64 * kb, n0 = 32 * nb;
#pragma unroll
    for (int i = 0; i < 8; ++i) { const int kk = 8 * i + (lane >> 3), nq = 4 * (lane & 7);
        const f32x4 v = __builtin_nontemporal_load((const GAS f32x4*)(W + (size_t)(k0 + kk) * N + n0 + nq)); LAS float* d = scr + kk * 33 + nq; d[0] = v.x; d[1] = v.y; d[2] = v.z; d[3] = v.w; }
    asm volatile("s_waitcnt lgkmcnt(0)" ::: "memory");
    const int c = lane & 7;
#pragma unroll
    for (int j = 0; j < 4; ++j) { const int n = (lane >> 3) + 8 * j; const LAS float* s = scr + (8 * c) * 33 + n;
        u32x4 o; o.x = pk_bf16(s[0 * 33], s[1 * 33]); o.y = pk_bf16(s[2 * 33], s[3 * 33]); o.z = pk_bf16(s[4 * 33], s[5 * 33]); o.w = pk_bf16(s[6 * 33], s[7 * 33]);
        const int ng = n0 + n; const int nr = (mode == 0) ? ng : (256 * (ng >> 7) + (ng & 127) + (mode == 2 ? 128 : 0));
        *(GAS u32x4*)(WT + (size_t)nr * K + k0 + 8 * c) = o; }
    asm volatile("s_waitcnt lgkmcnt(0)" ::: "memory");
}

template <bool HAS_F, bool HAS_H, bool XIN_B = false, bool XOUT_B = false>
__device__ __forceinline__ void rowpass(const void* xin_, const bf16* __restrict__ Fb, void* xout_, bf16* __restrict__ H,
                                        const float* __restrict__ gpost, const float* __restrict__ modp, int gi  , float resw,
                                        const float* __restrict__ gpre, int sci, int shi, int gw, int lane) {
    constexpr int RPW = M / 2048;
    const int row_lo = gw * RPW; const int b = row_lo / SEQ;
    const float* mb = modp + (size_t)b * (NMOD * DM);
    f32x4 Cg[4], A[4], Sh[4];
#pragma unroll
    for (int j = 0; j < 4; ++j) { const int col = 256 * j + 4 * lane;
        if (HAS_F) { const f32x4 g = *(const GAS f32x4*)(mb + gi * DM + col), gp = *(const GAS f32x4*)(gpost + col); Cg[j] = g * gp * resw; }
        if (HAS_H) { const f32x4 s = *(const GAS f32x4*)(mb + sci * DM + col), gp = *(const GAS f32x4*)(gpre + col); A[j] = gp * (s + 1.0f); Sh[j] = *(const GAS f32x4*)(mb + shi * DM + col); } }
    const float* xin = (const float*)xin_; const bf16* xinb = (const bf16*)xin_; float* xout = (float*)xout_; bf16* xoutb = (bf16*)xout_;
#define RP_LDX(dst, r, j) do { if (XIN_B) { const u32x2 w_ = __builtin_nontemporal_load((const GAS u32x2*)(xinb + (size_t)(r) * DM + 256 * (j) + 4 * lane)); \
        dst = (f32x4){__uint_as_float(w_.x << 16), __uint_as_float(w_.x & 0xffff0000u), __uint_as_float(w_.y << 16), __uint_as_float(w_.y & 0xffff0000u)}; } \
      else dst = __builtin_nontemporal_load((const GAS f32x4*)(xin + (size_t)(r) * DM + 256 * (j) + 4 * lane)); } while (0)
    f32x4 xn[4]; u32x2 fn[4];
#pragma unroll
    for (int j = 0; j < 4; ++j) { RP_LDX(xn[j], row_lo, j); if (HAS_F) fn[j] = __builtin_nontemporal_load((const GAS u32x2*)(Fb + (size_t)row_lo * DM + 256 * j + 4 * lane)); }
    for (int row = row_lo; row < row_lo + RPW; ++row) {
        f32x4 x[4]; u32x2 fwv[4];
#pragma unroll
        for (int j = 0; j < 4; ++j) { x[j] = xn[j]; if (HAS_F) fwv[j] = fn[j]; }
        { const int rn = (row + 1 < row_lo + RPW) ? row + 1 : row;
#pragma unroll
          for (int j = 0; j < 4; ++j) { RP_LDX(xn[j], rn, j); if (HAS_F) fn[j] = __builtin_nontemporal_load((const GAS u32x2*)(Fb + (size_t)rn * DM + 256 * j + 4 * lane)); } }
        if (HAS_F) {
            f32x4 f[4]; float ss = 0.f;
#pragma unroll
            for (int j = 0; j < 4; ++j) { const u32x2 fw = fwv[j];
                f[j] = (f32x4){__uint_as_float(fw.x << 16), __uint_as_float(fw.x & 0xffff0000u), __uint_as_float(fw.y << 16), __uint_as_float(fw.y & 0xffff0000u)}; ss += (f[j].x * f[j].x + f[j].y * f[j].y) + (f[j].z * f[j].z + f[j].w * f[j].w); }
            const float rstd = 1.0f / sqrtf(wave_sum(ss) * (1.0f / DM) + RMS_EPS);
#pragma unroll
            for (int j = 0; j < 4; ++j) { x[j] = x[j] + f[j] * rstd * Cg[j];
                if (XOUT_B) { u32x2 w; w.x = pk_bf16(x[j].x, x[j].y); w.y = pk_bf16(x[j].z, x[j].w); *(GAS u32x2*)(xoutb + (size_t)row * DM + 256 * j + 4 * lane) = w;
                    x[j] = (f32x4){__uint_as_float(w.x << 16), __uint_as_float(w.x & 0xffff0000u), __uint_as_float(w.y << 16), __uint_as_float(w.y & 0xffff0000u)}; }
                else __builtin_nontemporal_store(x[j], (GAS f32x4*)(xout + (size_t)row * DM + 256 * j + 4 * lane)); }
        }
        if (HAS_H) {
            float ss = 0.f;
#pragma unroll
            for (int j = 0; j < 4; ++j) ss += (x[j].x * x[j].x + x[j].y * x[j].y) + (x[j].z * x[j].z + x[j].w * x[j].w);
            const float rstd = 1.0f / sqrtf(wave_sum(ss) * (1.0f / DM) + RMS_EPS);
#pragma unroll
            for (int j = 0; j < 4; ++j) { const f32x4 h = x[j] * rstd * A[j] + Sh[j]; u32x2 w; w.x = pk_bf16(h.x, h.y); w.y = pk_bf16(h.z, h.w);
                *(GAS u32x2*)(H + (size_t)row * DM + 256 * j + 4 * lane) = w; }
        }
    }
}
#undef RP_LDX

__device__ __forceinline__ void rowpass_attn(const float* __restrict__ Od, const bf16* __restrict__ Os, bf16* __restrict__ H, const float* __restrict__ subln,
                                             const float* __restrict__ sbeta, float lam, int gw, int lane) {
    constexpr int RPW = M / 2048;
    const int hd = lane >> 4, e0 = 8 * (lane & 15);
    const f32x4 sl0 = *(const GAS f32x4*)(subln + e0), sl1 = *(const GAS f32x4*)(subln + e0 + 4);
    const f32x4 be0 = *(const GAS f32x4*)(sbeta + 8 * lane), be1 = *(const GAS f32x4*)(sbeta + 8 * lane + 4);
#define RA_UNPK(W_, V_) do { V_[0] = __uint_as_float(W_.x << 16); V_[1] = __uint_as_float(W_.x & 0xffff0000u); V_[2] = __uint_as_float(W_.y << 16); V_[3] = __uint_as_float(W_.y & 0xffff0000u); \
        V_[4] = __uint_as_float(W_.z << 16); V_[5] = __uint_as_float(W_.z & 0xffff0000u); V_[6] = __uint_as_float(W_.w << 16); V_[7] = __uint_as_float(W_.w & 0xffff0000u); } while (0)
    const int row_lo = gw * RPW;
    u32x4 n0 = __builtin_nontemporal_load((const GAS u32x4*)((const bf16*)Od + (size_t)row_lo * 1024 + hd * 256 + e0)), n1 = __builtin_nontemporal_load((const GAS u32x4*)((const bf16*)Od + (size_t)row_lo * 1024 + hd * 256 + 128 + e0));
    u32x4 ns = __builtin_nontemporal_load((const GAS u32x4*)(Os + (size_t)row_lo * 512 + 8 * lane));
    for (int row = row_lo; row < row_lo + RPW; ++row) {
        const u32x4 w0 = n0, w1 = n1, ws = ns;
        { const int rn = (row + 1 < row_lo + RPW) ? row + 1 : row;
          n0 = __builtin_nontemporal_load((const GAS u32x4*)((const bf16*)Od + (size_t)rn * 1024 + hd * 256 + e0)); n1 = __builtin_nontemporal_load((const GAS u32x4*)((const bf16*)Od + (size_t)rn * 1024 + hd * 256 + 128 + e0));
          ns = __builtin_nontemporal_load((const GAS u32x4*)(Os + (size_t)rn * 512 + 8 * lane)); }
        float a0[8], a1[8], v[8], sv[8];
        RA_UNPK(w0, a0); RA_UNPK(w1, a1); RA_UNPK(ws, sv);
        float ss = 0.f, s2 = 0.f;
#pragma unroll
        for (int i = 0; i < 8; ++i) { v[i] = a0[i] - a1[i] * lam; ss += v[i] * v[i]; s2 += sv[i] * sv[i]; }
        ss = row16_sum(ss);
        const float rstd = 0.8f / sqrtf(ss * (1.0f / 128.0f) + RMS_EPS);
        u32x4 od; od.x = pk_bf16(v[0] * rstd * sl0.x, v[1] * rstd * sl0.y); od.y = pk_bf16(v[2] * rstd * sl0.z, v[3] * rstd * sl0.w);
        od.z = pk_bf16(v[4] * rstd * sl1.x, v[5] * rstd * sl1.y); od.w = pk_bf16(v[6] * rstd * sl1.z, v[7] * rstd * sl1.w);
        *(GAS u32x4*)(H + (size_t)row * 1024 + hd * 128 + e0) = od;
        const float rstd2 = 1.0f / sqrtf(wave_sum(s2) * (1.0f / 512.0f) + RMS_EPS);
        u32x4 o; o.x = pk_bf16(sv[0] * rstd2 * be0.x, sv[1] * rstd2 * be0.y); o.y = pk_bf16(sv[2] * rstd2 * be0.z, sv[3] * rstd2 * be0.w);
        o.z = pk_bf16(sv[4] * rstd2 * be1.x, sv[5] * rstd2 * be1.y); o.w = pk_bf16(sv[6] * rstd2 * be1.z, sv[7] * rstd2 * be1.w);
        *(GAS u32x4*)(H + (size_t)row * 1024 + 512 + 8 * lane) = o;
    }
#undef RA_UNPK
}

#define KAS __attribute__((address_space(4)))
__device__ __forceinline__ const float* karg(int i) { const KAS char* ka = (const KAS char*)__builtin_amdgcn_kernarg_segment_ptr(); return (const float*)(*(const volatile KAS unsigned long long*)(ka + 8 * i)); }
#define AIN(i) karg(i)
__device__ __forceinline__ int fresh_tid() { int t = threadIdx.x; asm volatile("" : "+v"(t)); return t; }
__global__ void __launch_bounds__(512) fwd_megakernel(Args args) {
    extern __shared__ __attribute__((aligned(16))) unsigned char lds_raw[];
    cg::grid_group grid = cg::this_grid();
    LAS unsigned char* lds = (LAS unsigned char*)lds_raw;
    const int wave = __builtin_amdgcn_readfirstlane((int)threadIdx.x >> 6);
#define tid (fresh_tid())
#define lane (fresh_tid() & 63)
    const int G = gridDim.x, bx = blockIdx.x;
    const int vcu = (G % 8 == 0) ? (bx % 8) * (G / 8) + bx / 8 : bx;
    const int gw = vcu * 8 + wave, NGW = G * 8;
    unsigned* ctlw = (unsigned*)((unsigned char*)karg(25) + WS_CTLW);
    volatile LAS unsigned* MISC = (volatile LAS unsigned*)(lds + GEMM_LDS);
    if (tid < 64) MISC[tid] = 0u;
    __syncthreads();
    XcdBarrier bar = xcd_barrier_post(ctlw, MISC + 8);
#define WSP(off) ((unsigned char*)karg(25) + (off))
#define ctl ((float*)WSP(WS_CTL))
#define modp (((float*)WSP(WS_CTL)) + 1024)
#define out ((float*)karg(24))
#define Wgu1 ((bf16*)WSP(WS_WGU1))
#define Wd1 ((bf16*)WSP(WS_WD1))
#define Win ((bf16*)WSP(WS_WIN))
#define Wout ((bf16*)WSP(WS_WOUT))
#define Wgu2 ((bf16*)WSP(WS_WGU2))
#define Wd2 ((bf16*)WSP(WS_WD2))
#define H ((bf16*)WSP(WS_H))
#define F ((float*)WSP(WS_F))
#define ACT ((bf16*)WSP(WS_ACT))
#define QK ((bf16*)WSP(WS_ACT))
#define VtD ((bf16*)WSP(WS_VTD))
#define VtS ((bf16*)WSP(WS_VTS))
#define Osb ((bf16*)WSP(WS_OSB))
#define XB ((bf16*)WSP(WS_XB))
    if (PH(0)) REP(0) {
        if (bx < 144) {
            LAS float* sc = (LAS float*)lds;
            LAS float* red = sc + 4096;
            const float* c = AIN(1);
            for (int i = tid; i < 4096; i += 512) { const float v = c[i]; sc[i] = v / (1.0f + __expf(-v)); }
            __syncthreads();
            const int col = bx * 64 + (tid & 63), kg = tid >> 6;
            const float* wp = AIN(2) + (size_t)(kg * 128) * (NMOD * DM) + col;
            float a0 = 0.f, a1 = 0.f, a2 = 0.f, a3 = 0.f;
#pragma unroll 8
            for (int k = 0; k < 128; ++k) { const float w = __builtin_nontemporal_load((const GAS float*)wp + (size_t)k * (NMOD * DM)); const int kk = kg * 128 + k;
                a0 += sc[kk] * w; a1 += sc[1024 + kk] * w; a2 += sc[2048 + kk] * w; a3 += sc[3072 + kk] * w; }
            red[(kg * 4 + 0) * 64 + (tid & 63)] = a0; red[(kg * 4 + 1) * 64 + (tid & 63)] = a1; red[(kg * 4 + 2) * 64 + (tid & 63)] = a2; red[(kg * 4 + 3) * 64 + (tid & 63)] = a3;
            __syncthreads();
            if (tid < 256) { const int b = tid >> 6, cc = tid & 63; float s = 0.f;
#pragma unroll
                for (int g = 0; g < 8; ++g) s += red[(g * 4 + b) * 64 + cc];
                modp[(size_t)b * (NMOD * DM) + bx * 64 + cc] = s + AIN(3)[bx * 64 + cc]; }
            __syncthreads();
        }
        if (bx == G - 1 && wave == 0) {
            const float s1 = wave_sum(AIN(13)[lane] * AIN(14)[lane]), s2 = wave_sum(AIN(15)[lane] * AIN(16)[lane]);
            if (lane == 0) ctl[0] = __expf(s1) - __expf(s2) + 0.2f;
        }
        LAS float* scr = (LAS float*)(lds + wave * 16384);
        constexpr int I_G = (DM / 64) * (DFF / 32), I_D = (DFF / 64) * (DM / 32), I_IN = (DM / 64) * (3 * DM / 32), I_OUT = (DM / 64) * (DM / 32);
        static_assert(I_G == I_D, "item counts");
        constexpr int NEARLY = 3 * I_G + I_IN;
        for (int itx = gw; itx < NEARLY; itx += NGW) {
            int r = itx;
            if (r < I_G) { transpose_item(AIN(6), DM, DFF, Wgu1, 1, scr, r, lane); continue; } r -= I_G;
            if (r < I_G) { transpose_item(AIN(7), DM, DFF, Wgu1, 2, scr, r, lane); continue; } r -= I_G;
            if (r < I_D) { transpose_item(AIN(8), DFF, DM, Wd1, 0, scr, r, lane); continue; } r -= I_D;
            transpose_item(AIN(11), DM, 3 * DM, Win, 0, scr, r, lane);
        }
    }
    if (G == 0x7ffffff0) grid.sync();
    xcd_barrier(bar);
#ifdef EXTRA_SYNCS
    for (int es = 0; es < EXTRA_SYNCS; ++es) xcd_barrier(bar);
#endif
    if (PH(1)) REP(1) rowpass<false, true>(AIN(0), nullptr, nullptr, H, nullptr, modp, 0, 0.f, AIN(4), 1, 0, gw, lane);
    xcd_barrier(bar);
    if (PH(2)) REP(2) { pg8::Gemm g{H, Wgu1, M, 2 * DFF, DM}; pg8::StaticOrder S; S.init(M, 2 * DFF, G, bx, WGM_GU); pg8::EpiSwiglu E{ACT, DFF};
      pg8::gemm_phase<pg8::EpiSwiglu, pg8::StaticOrder, true, true>(lds, g, S, E); }
    xcd_barrier(bar);
    if (PH(3)) REP(3) { pg8::Gemm g{ACT, Wd1, M, DM, DFF}; pg8::StaticOrder S; S.init(M, DM, G, bx, WGM_N1K, 1); pg8::EpiBf16Out E{(bf16*)F, DM};
      pg8::gemm_phase<pg8::EpiBf16Out, pg8::StaticOrder, true, true>(lds, g, S, E); }
    xcd_barrier(bar);
    if (PH(4)) REP(4) rowpass<true, true, false, true>(AIN(0), (const bf16*)F, XB, H, AIN(5), modp, 2, 0.5f, AIN(9), 4, 3, gw, lane);
    xcd_barrier(bar);
    if (PH(5)) REP(5) { pg8::Gemm g{H, Win, M, 3 * DM, DM}; pg8::StaticOrder S; S.init(M, 3 * DM, G, bx, WGM_IN); pg8::EpiProj E{QK, VtD, VtS, C2, SEQ, ctlw + CW_KINF};
      pg8::gemm_phase<pg8::EpiProj, pg8::StaticOrder, true, true>(lds, g, S, E); }
    xcd_barrier(bar);
    if (PH(6)) {
        const unsigned* kinfw = ctlw + CW_KINF;
        LAS unsigned* uslot = (LAS unsigned*)(lds + att::FLAG_OFF + 128);
        const unsigned myx = xb_xcc_id() & 7u;
        for (int qi = 0; qi < 8; ++qi) {
            const unsigned xq = (myx + (unsigned)qi) & 7u;
            unsigned* qctr = ctlw + CW_QUEUE + 64 * xq;
            for (;;) {
                if (tid == 0) *uslot = atomicAdd(qctr, 1u);
                __syncthreads();
                const unsigned u = *uslot;
                __syncthreads();
                if (u >= 128u) break;
                const int h = 3 - (int)(u >> 5), qb = 31 - (int)(u & 31), b = (int)(xq >> 1), vh = 2 * h + (int)(xq & 1);
                const float slope2 = 1.4426950408889634f * exp2f(-2.0f * (float)(h + 1));
                const float kinfa = __uint_as_float(kinfw[(b * 8 + vh) * 2]), kinfb = __uint_as_float(kinfw[(b * 8 + vh) * 2 + 1]);
                att::attn_unit<0, 128>(lds, QK, vh * 64, 512 + vh * 64, VtD + ((size_t)(b * 512 + h * 128)) * SEQ, (size_t)b * SEQ, qb, slope2, kinfa, kinfb, F, nullptr, vh * 128);
            }
        }
        {
            unsigned* qctr = ctlw + CW_QUEUE + 64 * 8;
            volatile LAS unsigned* sslot = MISC + 40; LAS unsigned* sflags = (LAS unsigned*)(lds + GEMM_LDS) + 44;
            for (;;) {
                if (tid == 0) sslot[0] = atomicAdd(qctr, 1u);
                __syncthreads();
                const unsigned u = sslot[0];
                __syncthreads();
                if (u >= 1024u) break;
                const int v = (int)u, qb = 63 - (v >> 4), b = (v & 15) >> 2, hp = v & 3;
                att::sb_unit2<1, 64>(lds, QK, 1024 + hp * 128, 1536 + hp * 128, VtS + ((size_t)(b * 512 + hp * 128)) * SEQ, sflags, (size_t)b * SEQ, qb, 0.f, 0.f, 0.f, nullptr, Osb, hp * 128);
            }
        }
        {
            constexpr int I_G2 = (DM / 64) * (DFF / 32), I_OUT2 = (DM / 64) * (DM / 32), NLATE = 3 * I_G2 + I_OUT2;
            unsigned* tq = ctlw + CW_QUEUE + 64 * 9;
            volatile LAS unsigned* tslot = MISC + 32;
            LAS float* scr = (LAS float*)(lds + wave * 16384);
            for (;;) {
                if (tid == 0) tslot[0] = atomicAdd(tq, 1u);
                __syncthreads();
                const unsigned ch = tslot[0];
                __syncthreads();
                if (ch * 8u >= (unsigned)NLATE) break;
                int r = (int)ch * 8 + wave;
                if (r < NLATE) {
                    if (r < I_OUT2) transpose_item(AIN(12), DM, DM, Wout, 0, scr, r, lane);
                    else { r -= I_OUT2;
                        if (r < I_G2) transpose_item(AIN(21), DM, DFF, Wgu2, 1, scr, r, lane);
                        else if (r < 2 * I_G2) transpose_item(AIN(22), DM, DFF, Wgu2, 2, scr, r - I_G2, lane);
                        else transpose_item(AIN(23), DFF, DM, Wd2, 0, scr, r - 2 * I_G2, lane); }
                }
            }
        }
    }
    xcd_barrier(bar);
    if (PH(7)) REP(7) rowpass_attn(F, Osb, H, AIN(17), AIN(18), ctl[0], gw, lane);
    xcd_barrier(bar);
    if (PH(8)) REP(8) { pg8::Gemm g{H, Wout, M, DM, DM}; pg8::StaticOrder S; S.init(M, DM, G, bx, WGM_N1K); pg8::EpiBf16Out E{(bf16*)F, DM};
      pg8::gemm_phase<pg8::EpiBf16Out, pg8::StaticOrder, true, true>(lds, g, S, E); }
    xcd_barrier(bar);
    if (PH(9)) REP(9) rowpass<true, true, true, true>(XB, (const bf16*)F, XB, H, AIN(10), modp, 5, 1.0f, AIN(19), 7, 6, gw, lane);
    xcd_barrier(bar);
    if (PH(10)) REP(10) { pg8::Gemm g{H, Wgu2, M, 2 * DFF, DM}; pg8::StaticOrder S; S.init(M, 2 * DFF, G, bx, WGM_GU); pg8::EpiSwiglu E{ACT, DFF};
      pg8::gemm_phase<pg8::EpiSwiglu, pg8::StaticOrder, true, true>(lds, g, S, E); }
    xcd_barrier(bar);
    if (PH(11)) REP(11) { pg8::Gemm g{ACT, Wd2, M, DM, DFF}; pg8::StaticOrder S; S.init(M, DM, G, bx, WGM_N1K, 1); pg8::EpiBf16Out E{(bf16*)F, DM};
      pg8::gemm_phase<pg8::EpiBf16Out, pg8::StaticOrder, true, true>(lds, g, S, E); }
    xcd_barrier(bar);
    if (PH(12)) REP(12) rowpass<true, false, true, false>(XB, (const bf16*)F, out, nullptr, AIN(20), modp, 8, 0.5f, nullptr, 0, 0, gw, lane);
}
#undef ctl
#undef modp
#undef out
#undef Wgu1
#undef Wd1
#undef Win
#undef Wout
#undef Wgu2
#undef Wd2
#undef H
#undef F
#undef ACT
#undef QK
#undef VtD
#undef VtS
#undef Osb
#undef XB

#undef tid
#undef lane
extern "C" void kernel_launch(void* const* d_in, const int* in_sizes, int n_in, void* d_out, int out_size, void* d_ws, size_t ws_size, hipStream_t stream) {
    static int grid = 0;
    if (grid == 0) {
        if (n_in != 24 || out_size != M * DM || ws_size < WS_END) { fprintf(stderr, "kernel_launch: unexpected shapes (n_in %d out %d ws %zu)\n", n_in, out_size, ws_size); grid = -1; return; }
        int dev = 0, cus = 0, per_cu = 0;
        hipGetDevice(&dev); hipDeviceGetAttribute(&cus, hipDeviceAttributeMultiprocessorCount, dev);
        if (hipFuncSetAttribute((const void*)fwd_megakernel, hipFuncAttributeMaxDynamicSharedMemorySize, LDS_BYTES) != hipSuccess) { fprintf(stderr, "kernel_launch: hipFuncSetAttribute failed\n"); grid = -1; return; }
        if (hipOccupancyMaxActiveBlocksPerMultiprocessor(&per_cu, (const void*)fwd_megakernel, 512, LDS_BYTES) != hipSuccess || per_cu < 1) { fprintf(stderr, "kernel_launch: occupancy query says %d blocks per CU\n", per_cu); per_cu = 1; }
        (void)hipGetLastError();
        if (cus < 256) { fprintf(stderr, "kernel_launch: built for a 256-CU device (got %d CUs)\n", cus); grid = -1; return; }
        grid = 256;
    }
    if (grid < 0) return;
    if (hipMemsetAsync((char*)d_ws + WS_CTLW, 0, CTLW_BYTES, stream) != hipSuccess) { fprintf(stderr, "kernel_launch: memset of the control words failed\n"); return; }
    Args a{};
    for (int i = 0; i < 24; ++i) a.in[i] = (const float*)d_in[i];
    a.out = (float*)d_out; a.ws = (unsigned char*)d_ws;
    void* kargs[] = {&a};
    hipError_t e = hipLaunchCooperativeKernel((const void*)fwd_megakernel, dim3(grid), dim3(512), kargs, LDS_BYTES, stream);
    if (e != hipSuccess) fprintf(stderr, "cooperative launch failed: %s (grid %d)\n", hipGetErrorString(e), grid);
}
```
